# Optimizing an MI355X kernel written in HIP

```python
import math
import jax, jax.numpy as jnp
from jax import lax
import numpy as np

D_MODEL = 1024
BATCH = 8
SEQ = 8192
DEPTH = 4

CHUNK = 64
N_PAST_CHUNKS = 8
N_MIXERS = 2
N_HEADS = 16
HEAD_DIM = 64
MIX_WIDTH = N_HEADS * HEAD_DIM
MAX_REL = 128
Q_BLOCK = 128
N_A_LAYERS = (DEPTH + N_MIXERS - 1) // N_MIXERS
N_B_LAYERS = DEPTH // N_MIXERS
LN_EPS = 1e-5
NEG_INF = -1e30
DEEPNORM_ALPHA = (2.0 * DEPTH) ** 0.25
DEEPNORM_BETA = (8.0 * DEPTH) ** -0.25

kernel_name = "hybrid_chunk_relpos_fox_deepnorm"


def layer_norm(x, g, b):
    xf = x.astype(jnp.float32)
    mu = jnp.mean(xf, axis=-1, keepdims=True)
    var = jnp.mean(jnp.square(xf - mu), axis=-1, keepdims=True)
    y = (xf - mu) * lax.rsqrt(var + LN_EPS) * g.astype(jnp.float32) + b.astype(jnp.float32)
    return y.astype(x.dtype)


def split_heads(t):
    b, s, _ = t.shape
    return t.reshape(b, s, N_HEADS, HEAD_DIM).transpose(0, 2, 1, 3)


def merge_heads(t):
    b, h, s, d = t.shape
    return t.transpose(0, 2, 1, 3).reshape(b, s, h * d)


def chunk_relpos_attention(q, k, v, rel_bias):
    b, h, s, d = q.shape
    n_chunks = s // CHUNK
    pad = N_PAST_CHUNKS * CHUNK
    band = (N_PAST_CHUNKS + 1) * CHUNK
    kp = jnp.pad(k, ((0, 0), (0, 0), (pad, 0), (0, 0)))
    vp = jnp.pad(v, ((0, 0), (0, 0), (pad, 0), (0, 0)))
    qi = jnp.arange(CHUNK)[:, None]
    kj = jnp.arange(band)[None, :]
    rel_idx = jnp.clip(qi - kj + pad, -MAX_REL, MAX_REL) + MAX_REL
    bias = rel_bias.astype(jnp.float32)[:, rel_idx]
    scale = 1.0 / math.sqrt(d)

    def one_chunk(c):
        start = c * CHUNK
        qc = lax.dynamic_slice_in_dim(q, start, CHUNK, axis=2)
        kc = lax.dynamic_slice_in_dim(kp, start, band, axis=2)
        vc = lax.dynamic_slice_in_dim(vp, start, band, axis=2)
        logits = jnp.einsum('bhqd,bhkd->bhqk', qc, kc).astype(jnp.float32) * scale + bias
        valid = (start - pad + jnp.arange(band)) >= 0
        logits = jnp.where(valid[None, None, None, :], logits, NEG_INF)
        p = jax.nn.softmax(logits, axis=-1).astype(v.dtype)
        return jnp.einsum('bhqk,bhkd->bhqd', p, vc)

    out = lax.map(one_chunk, jnp.arange(n_chunks))
    return out.transpose(1, 2, 0, 3, 4).reshape(b, h, s, d)


def forgetting_attention(q, k, v, log_f):
    b, h, s, d = q.shape
    n_blocks = s // Q_BLOCK
    cum_f = jnp.cumsum(log_f, axis=-1)
    q_blocks = q.reshape(b, h, n_blocks, Q_BLOCK, d).transpose(2, 0, 1, 3, 4)
    f_blocks = cum_f.reshape(b, h, n_blocks, Q_BLOCK).transpose(2, 0, 1, 3)
    kpos = jnp.arange(s)
    scale = 1.0 / math.sqrt(d)

    def one_block(args):
        qb, fb, blk = args
        qpos = blk * Q_BLOCK + jnp.arange(Q_BLOCK)
        logits = jnp.einsum('bhqd,bhkd->bhqk', qb, k).astype(jnp.float32) * scale
        logits = logits + fb[..., :, None] - cum_f[..., None, :]
        mask = kpos[None, :] <= qpos[:, None]
        logits = jnp.where(mask[None, None], logits, NEG_INF)
        p = jax.nn.softmax(logits, axis=-1).astype(v.dtype)
        return jnp.einsum('bhqk,bhkd->bhqd', p, v)

    out = lax.map(one_block, (q_blocks, f_blocks, jnp.arange(n_blocks)))
    return out.transpose(1, 2, 0, 3, 4).reshape(b, h, s, d)


def mixer_a(x, w_in, rel_bias, w_out):
    h = x @ w_in
    q, k, v, z = jnp.split(h, 4, axis=-1)
    o = merge_heads(chunk_relpos_attention(split_heads(q), split_heads(k), split_heads(v), rel_bias))
    return (o * jax.nn.silu(z)) @ w_out


def mixer_b(x, w_in, w_f, b_f, w_out):
    h = x @ w_in
    q, k, v, z = jnp.split(h, 4, axis=-1)
    log_f = jax.nn.log_sigmoid((x @ w_f + b_f).astype(jnp.float32))
    log_f = log_f.transpose(0, 2, 1)
    o = merge_heads(forgetting_attention(split_heads(q), split_heads(k), split_heads(v), log_f))
    return (o * jax.nn.silu(z)) @ w_out


def _in_proj(key, n):
    w = jax.random.normal(key, (n, D_MODEL, 4 * MIX_WIDTH), jnp.float32) * D_MODEL ** -0.5
    col_scale = jnp.concatenate([
        jnp.ones((2 * MIX_WIDTH,), jnp.float32),
        jnp.full((MIX_WIDTH,), DEEPNORM_BETA, jnp.float32),
        jnp.ones((MIX_WIDTH,), jnp.float32)])
    return w * col_scale


def _out_proj(key, n):
    return jax.random.normal(key, (n, MIX_WIDTH, D_MODEL), jnp.float32) * (MIX_WIDTH ** -0.5) * DEEPNORM_BETA


def setup_inputs(seed: int = 0) -> dict:
    key = jax.random.key(seed)
    ks = jax.random.split(key, 10)
    x = jax.random.normal(ks[0], (BATCH, SEQ, D_MODEL), jnp.float32)
    w_in_a = _in_proj(ks[1], N_A_LAYERS)
    rel_bias_a = jax.random.normal(ks[2], (N_A_LAYERS, N_HEADS, 2 * MAX_REL + 1), jnp.float32) * 0.1
    w_out_a = _out_proj(ks[3], N_A_LAYERS)
    w_in_b = _in_proj(ks[4], N_B_LAYERS)
    w_f_b = jax.random.normal(ks[5], (N_B_LAYERS, D_MODEL, N_HEADS), jnp.float32) * D_MODEL ** -0.5
    b_f_b = 2.0 + 0.5 * jax.random.normal(ks[6], (N_B_LAYERS, N_HEADS), jnp.float32)
    w_out_b = _out_proj(ks[7], N_B_LAYERS)
    ln_g = 1.0 + 0.05 * jax.random.normal(ks[8], (DEPTH, D_MODEL), jnp.float32)
    ln_b = 0.02 * jax.random.normal(ks[9], (DEPTH, D_MODEL), jnp.float32)
    return {"x": x, "w_in_a": w_in_a, "rel_bias_a": rel_bias_a, "w_out_a": w_out_a,
            "w_in_b": w_in_b, "w_f_b": w_f_b, "b_f_b": b_f_b, "w_out_b": w_out_b,
            "ln_g": ln_g, "ln_b": ln_b}


def reference(x, w_in_a, rel_bias_a, w_out_a, w_in_b, w_f_b, b_f_b, w_out_b, ln_g, ln_b):
    for i in range(DEPTH):
        j = i // N_MIXERS
        if i % N_MIXERS == 0:
            y = mixer_a(x, w_in_a[j], rel_bias_a[j], w_out_a[j])
        else:
            y = mixer_b(x, w_in_b[j], w_f_b[j], b_f_b[j], w_out_b[j])
        x = layer_norm(DEEPNORM_ALPHA * x + y, ln_g[i], ln_b[i])
    return x
```

```cpp
#include <hip/hip_runtime.h>
#include <hip/hip_cooperative_groups.h>
#include <cstdio>
#include <cstdint>
namespace cg = cooperative_groups;

typedef unsigned short bf16_t;
typedef short bf16x8 __attribute__((ext_vector_type(8)));
typedef float f32x4 __attribute__((ext_vector_type(4)));
typedef float f32x16 __attribute__((ext_vector_type(16)));
typedef unsigned u32x4 __attribute__((ext_vector_type(4)));
typedef unsigned u32x2 __attribute__((ext_vector_type(2)));

constexpr int DM = 1024, NB = 8, SEQ = 8192, MTOK = NB * SEQ, NH = 16, DEPTH = 4;
constexpr float LN_EPS = 1e-5f;
constexpr float ALPHA = 1.681792830507429f;
constexpr float LOG2E = 1.4426950408889634f;
constexpr int LDS_BYTES = 131072;

constexpr size_t WS_XB = 0;
constexpr size_t WS_QKVZ = WS_XB + (size_t)MTOK * 1024 * 2;
constexpr size_t WS_VT = WS_QKVZ + (size_t)MTOK * 4096 * 2;
constexpr size_t WS_G = WS_VT + (size_t)MTOK * 1024 * 2;
constexpr size_t WS_WIN = WS_G + (size_t)MTOK * 1024 * 2;
constexpr size_t WS_WOUT = WS_WIN + (size_t)DEPTH * 4096 * 1024 * 2;
constexpr size_t WS_F = WS_WOUT + (size_t)DEPTH * 1024 * 1024 * 2;
constexpr size_t WS_NRM = WS_F + (size_t)NB * NH * SEQ * 4;
constexpr size_t WS_CTR = WS_NRM + (size_t)2 * 1024 * 128 * 4;
constexpr size_t WS_END = WS_CTR + 256;

extern __shared__ __attribute__((aligned(16))) unsigned char g_shm[];

struct Params {
    const float* x; const float* w_in_a; const float* rel_bias_a; const float* w_out_a;
    const float* w_in_b; const float* w_f_b; const float* b_f_b; const float* w_out_b;
    const float* ln_g; const float* ln_b;
    float* out; unsigned char* ws;
};

typedef __bf16 bf16x2_t __attribute__((ext_vector_type(2)));
typedef float f32x2_t __attribute__((ext_vector_type(2)));
__device__ __forceinline__ unsigned cvt_pk_bf16(float lo, float hi) { const f32x2_t v = {lo, hi}; const bf16x2_t r = __builtin_convertvector(v, bf16x2_t); return __builtin_bit_cast(unsigned, r); }
__device__ __forceinline__ float ld_coh(const float* p) { return __hip_atomic_load(p, __ATOMIC_RELAXED, __HIP_MEMORY_SCOPE_AGENT); }
template <int CTRL> __device__ __forceinline__ float dpp_f(float v) { return __int_as_float(__builtin_amdgcn_update_dpp(0, __float_as_int(v), CTRL, 0xf, 0xf, false)); }
__device__ __forceinline__ float bf_lo(unsigned u) { return __uint_as_float(u << 16); }
__device__ __forceinline__ float bf_hi(unsigned u) { return __uint_as_float(u & 0xffff0000u); }

#define LAS __attribute__((address_space(3)))
constexpr int BK = 64, HALF = 128, HTB = HALF * BK * 2, GK = 1024;
__device__ __forceinline__ int lds_byte(int r, int c) { const int st = (r >> 4) * 2 + (c >> 5), rr = r & 15, cc = c & 31, ob = rr * 64 + cc * 2; return st * 1024 + (ob ^ (((ob >> 9) & 1) << 5)); }
__device__ __forceinline__ void stage_rc(int b, int& R, int& C) { const int st = b / 1024, sb = b % 1024, swz = sb ^ (((sb >> 9) & 1) << 5); R = (st >> 1) * 16 + swz / 64; C = (st & 1) * 32 + (swz % 64) / 2; }
__device__ __forceinline__ int perm32(int rho) { const int n = rho >> 4, i = rho & 15; return 8 * (i >> 2) + 4 * n + (i & 3); }

__device__ __forceinline__ void tile_map(int L, int nM, int nN, int& pm, int& pn) {
    const int nwg = nM * nN; int wgid = L;
    { const int q = nwg / 8, r = nwg % 8, xcd = wgid % 8, off = wgid / 8; wgid = (xcd < r ? xcd * (q + 1) : r * (q + 1) + (xcd - r) * q) + off; }
    const int nig = 8 * nN, gid = wgid / nig, fm = gid * 8, gsz = (nM - fm) < 8 ? (nM - fm) : 8;
    pm = fm + ((wgid % nig) % gsz); pn = (wgid % nig) / gsz;
}

struct Unit { int pm, pn; };
constexpr size_t TSTEP = (size_t)256 * GK * 2;
struct Sched {
    int mode;
    const char* XB; const char* W; int G, c;
    __device__ __forceinline__ bool next(int i, Unit& u) const {
        const long L = (long)i * G + c; if (L >= (mode == 0 ? 4096 : 1024)) return false;
        tile_map((int)L, 256, mode == 0 ? 16 : 4, u.pm, u.pn); return true;
    }
    __device__ __forceinline__ bool vt(const Unit& u) const { return mode == 0 && u.pn >= 8 && u.pn < 12; }
    __device__ __forceinline__ const char* pA(const Unit& u) const { return vt(u) ? W + (size_t)u.pn * TSTEP : XB + (size_t)u.pm * TSTEP; }
    __device__ __forceinline__ const char* pB(const Unit& u) const { return vt(u) ? XB + (size_t)u.pm * TSTEP : W + (size_t)u.pn * TSTEP; }
};
struct Epi {
    int mode; bf16_t* QKVZ; bf16_t* VT; const float* xin; float* of; float* nrm;
    __device__ __forceinline__ void operator()(const f32x4 (&acc)[2][2][4][2], const Unit& u, int wr, int wc, int fr, int fq) const {
        if (mode == 0) {
            bf16_t* ob; long ldo;
            if (u.pn >= 8 && u.pn < 12) { ob = VT + ((long)((u.pm >> 5) * 1024 + (u.pn - 8) * 256)) * SEQ + (u.pm & 31) * 256; ldo = SEQ; }
            else { ob = QKVZ + (long)u.pm * 256 * 4096 + u.pn * 256; ldo = 4096; }
            if (nrm && u.pn < 8) {
                const int which = u.pn >> 2, pnl = u.pn & 3;
#pragma unroll
                for (int ai = 0; ai < 2; ++ai)
#pragma unroll
                    for (int bj = 0; bj < 2; ++bj) {
                        float mx = 0.f;
#pragma unroll
                        for (int m = 0; m < 4; ++m) {
                            const f32x4 v0 = acc[ai][bj][m][0], v1 = acc[ai][bj][m][1];
                            float s = (v0[0] * v0[0] + v0[1] * v0[1]) + (v0[2] * v0[2] + v0[3] * v0[3]) + (v1[0] * v1[0] + v1[1] * v1[1]) + (v1[2] * v1[2] + v1[3] * v1[3]);
                            s += __shfl_xor(s, 16); s += __shfl_xor(s, 32);
                            mx = fmaxf(mx, s);
                        }
                        mx = fmaxf(mx, dpp_f<0xB1>(mx)); mx = fmaxf(mx, dpp_f<0x4E>(mx)); mx = fmaxf(mx, dpp_f<0x141>(mx)); mx = fmaxf(mx, dpp_f<0x140>(mx));
                        if (fr == 0 && fq == 0) nrm[((long)which * 1024 + (u.pm * 4 + 2 * ai + wr)) * 32 + pnl * 8 + 4 * bj + wc] = mx * 1.02f;
                    }
            }
#pragma unroll
            for (int ai = 0; ai < 2; ++ai)
#pragma unroll
                for (int m = 0; m < 4; ++m) {
                    bf16_t* rp = ob + (long)(ai * HALF + wr * 64 + m * 16 + fr) * ldo + wc * 32 + fq * 8;
#pragma unroll
                    for (int bj = 0; bj < 2; ++bj) {
                        const f32x4 v0 = acc[ai][bj][m][0], v1 = acc[ai][bj][m][1];
                        u32x4 w; w.x = cvt_pk_bf16(v0[0], v0[1]); w.y = cvt_pk_bf16(v0[2], v0[3]); w.z = cvt_pk_bf16(v1[0], v1[1]); w.w = cvt_pk_bf16(v1[2], v1[3]);
                        *(u32x4*)(rp + bj * HALF) = w;
                    }
                }
        } else {
            const long o = (long)u.pm * 256 * 1024 + u.pn * 256;
#pragma unroll
            for (int ai = 0; ai < 2; ++ai)
#pragma unroll
                for (int m = 0; m < 4; ++m) {
                    const long ro = o + (long)(ai * HALF + wr * 64 + m * 16 + fr) * 1024 + wc * 32 + fq * 8;
#pragma unroll
                    for (int bj = 0; bj < 2; ++bj)
#pragma unroll
                        for (int n = 0; n < 2; ++n) {
                            const f32x4 xv = *(const f32x4*)(xin + ro + bj * HALF + n * 4);
                            const f32x4 r = xv * ALPHA + acc[ai][bj][m][n];
                            *(f32x4*)(of + ro + bj * HALF + n * 4) = r;
                        }
                }
        }
    }
};

__device__ __forceinline__ void gemm_phase(LAS unsigned char* lds, const Sched& S, const Epi& E) {
    int tid = threadIdx.x; asm volatile("" : "+v"(tid));
    const int wid = __builtin_amdgcn_readfirstlane(tid >> 6), lane = tid & 63, wr = wid >> 2, wc = wid & 3, fr = lane & 15, fq = lane >> 4;
    constexpr int K = GK, nt = K / BK;
    unsigned voffA[2], voffB[2];
#pragma unroll
    for (int i = 0; i < 2; ++i) { int R, C; stage_rc(tid * 16 + i * 8192, R, C); const int Rb = (R & ~31) + perm32(R & 31);
        voffA[i] = (unsigned)(R * K + C) * 2u; voffB[i] = (unsigned)(Rb * K + C) * 2u; }
    constexpr size_t kstep = (size_t)(BK * 2);
    constexpr size_t hstep = (size_t)HALF * K * 2;
    const unsigned ldsw = (unsigned)wid * 1024u;
    const int aoff = lds_byte(wr * 64 + fr, fq * 8), boff = lds_byte(wc * 32 + fr, fq * 8);
#define PG8_SA(b, h) (((b) * 2 + (h)) * HTB)
#define PG8_SB(b, h) ((4 + (b) * 2 + (h)) * HTB)
#define PG8_STAGE(bufoff, gbase, voff) do { _Pragma("unroll") for (int _i = 0; _i < 2; ++_i) \
        __builtin_amdgcn_global_load_lds((const unsigned*)((const char*)(gbase) + (voff)[_i]), (LAS unsigned*)(lds + (bufoff) + ldsw + _i * 8192), 16, 0, 0); } while (0)
#define PG8_LDA(dst, b, h) do { _Pragma("unroll") for (int m = 0; m < 4; ++m) _Pragma("unroll") for (int k = 0; k < 2; ++k) dst[m][k] = *(const LAS bf16x8*)(lds + PG8_SA(b, h) + aoff + m * 2048 + k * 1024); } while (0)
#define PG8_LDB(dst, b, h) do { _Pragma("unroll") for (int n = 0; n < 2; ++n) _Pragma("unroll") for (int k = 0; k < 2; ++k) dst[n][k] = *(const LAS bf16x8*)(lds + PG8_SB(b, h) + boff + n * 2048 + k * 1024); } while (0)
#define PG8_MMA(ai, bj, At, Bt) do { __builtin_amdgcn_s_setprio(1); _Pragma("unroll") for (int m = 0; m < 4; ++m) _Pragma("unroll") for (int n = 0; n < 2; ++n) _Pragma("unroll") for (int k = 0; k < 2; ++k) \
        acc[ai][bj][m][n] = __builtin_amdgcn_mfma_f32_16x16x32_bf16(Bt[n][k], At[m][k], acc[ai][bj][m][n], 0, 0, 0); __builtin_amdgcn_s_setprio(0); } while (0)
#define PG8_WAIT_V(n) asm volatile("s_waitcnt vmcnt(" #n ")" ::: "memory")
#define PG8_WAIT_L(n) asm volatile("s_waitcnt lgkmcnt(" #n ")" ::: "memory")
#define PG8_BAR __builtin_amdgcn_s_barrier()
#define PG8_SCHED __builtin_amdgcn_sched_barrier(0)
    Unit cur, nxt; int ui = 0;
    if (!S.next(0, cur)) return;
    f32x4 acc[2][2][4][2];
#pragma unroll
    for (int a = 0; a < 2; ++a)
#pragma unroll
        for (int b = 0; b < 2; ++b)
#pragma unroll
            for (int m = 0; m < 4; ++m)
#pragma unroll
                for (int n = 0; n < 2; ++n) acc[a][b][m][n] = (f32x4){0.f, 0.f, 0.f, 0.f};
    bf16x8 At[4][2], B0[2][2], B1[2][2];
    const char* cA = S.pA(cur); const char* cB = S.pB(cur);
    PG8_STAGE(PG8_SB(0, 0), cB, voffB); PG8_STAGE(PG8_SB(0, 1), cB + hstep, voffB); PG8_STAGE(PG8_SA(0, 0), cA, voffA); PG8_STAGE(PG8_SA(0, 1), cA + hstep, voffA);
    if (wr == 1) PG8_BAR;
    PG8_WAIT_V(2); PG8_BAR;
    PG8_STAGE(PG8_SB(1, 0), cB + kstep, voffB); PG8_STAGE(PG8_SA(1, 0), cA + kstep, voffA); PG8_STAGE(PG8_SB(1, 1), cB + hstep + kstep, voffB);
    PG8_WAIT_V(6); PG8_BAR;
    for (;;) {
        const bool has_next = S.next(ui + 1, nxt);
        const char* nA = has_next ? S.pA(nxt) : cA; const char* nB = has_next ? S.pB(nxt) : cB;
        for (int t = 0; t < nt; t += 2) {
            const bool last = (t == nt - 2);
            const char* a1 = cA + (size_t)(t + 1) * kstep;
            const char* a2 = last ? nA : cA + (size_t)(t + 2) * kstep; const char* b2 = last ? nB : cB + (size_t)(t + 2) * kstep;
            const char* a3 = a2 + kstep; const char* b3 = b2 + kstep;
            PG8_LDB(B0, 0, 0); PG8_LDB(B1, 0, 1); PG8_SCHED; PG8_LDA(At, 0, 0); PG8_STAGE(PG8_SA(1, 1), a1 + hstep, voffA);
            PG8_WAIT_V(8); PG8_WAIT_L(0); PG8_BAR; PG8_MMA(0, 0, At, B0); PG8_MMA(0, 1, At, B1); PG8_BAR; PG8_SCHED;
            PG8_LDA(At, 0, 1); PG8_STAGE(PG8_SB(0, 0), b2, voffB); PG8_STAGE(PG8_SB(0, 1), b2 + hstep, voffB); PG8_STAGE(PG8_SA(0, 0), a2, voffA);
            PG8_WAIT_V(8); PG8_WAIT_L(0); PG8_BAR; PG8_MMA(1, 0, At, B0); PG8_MMA(1, 1, At, B1); PG8_BAR; PG8_SCHED;
            PG8_LDB(B0, 1, 0); PG8_LDB(B1, 1, 1); PG8_SCHED; PG8_LDA(At, 1, 0); PG8_STAGE(PG8_SA(0, 1), a2 + hstep, voffA);
            PG8_WAIT_V(8); PG8_WAIT_L(0); PG8_BAR; PG8_MMA(0, 0, At, B0); PG8_MMA(0, 1, At, B1); PG8_BAR; PG8_SCHED;
            PG8_LDA(At, 1, 1); PG8_STAGE(PG8_SB(1, 0), b3, voffB); PG8_STAGE(PG8_SB(1, 1), b3 + hstep, voffB); PG8_STAGE(PG8_SA(1, 0), a3, voffA);
            PG8_WAIT_V(8); PG8_WAIT_L(0); PG8_BAR; PG8_MMA(1, 0, At, B0); PG8_MMA(1, 1, At, B1); PG8_BAR; PG8_SCHED;
        }
        if (wr == 0) PG8_BAR;
        E(acc, cur, wr, wc, fr, fq);
        if (!has_next) break;
#pragma unroll
        for (int a = 0; a < 2; ++a)
#pragma unroll
            for (int b = 0; b < 2; ++b)
#pragma unroll
                for (int m = 0; m < 4; ++m)
#pragma unroll
                    for (int n = 0; n < 2; ++n) acc[a][b][m][n] = (f32x4){0.f, 0.f, 0.f, 0.f};
        cur = nxt; cA = nA; cB = nB; ++ui;
        if (wr == 1) PG8_BAR;
    }
    PG8_WAIT_V(0);
    PG8_BAR;
#undef PG8_SA
#undef PG8_SB
#undef PG8_STAGE
#undef PG8_LDA
#undef PG8_LDB
#undef PG8_MMA
}

constexpr int KROW = 144, VROW = 136;
constexpr int L_KB = 0, L_VB = 2 * 64 * KROW, L_FB = L_VB + 2 * 64 * VROW, L_RELB = L_FB + 512, L_OST = L_RELB + 1280, L_UW = L_OST + 8 * 32 * KROW, L_ATT_END = L_UW + 8 * 128 * 4;
static_assert(L_ATT_END <= LDS_BYTES, "lds");
constexpr float TH_DEFER = 8.0f;
constexpr float PRUNE_NAT = 60.0f;

template <int MODE>
__device__ __forceinline__ void attn_unit(const bf16_t* __restrict__ QKVZ, const bf16_t* __restrict__ VT, const float* __restrict__ aux,
                                          bf16_t* __restrict__ G, int b, int h, int qb, int jlo, const float* __restrict__ nrm) {
    unsigned char* lds = g_shm;
    int tid = threadIdx.x; asm volatile("" : "+v"(tid));
    const int w = tid >> 6, lane = tid & 63, q = lane & 31, hh = lane >> 5;
    const int r0 = qb * 256 + w * 32, t = r0 + q;
    const int jhi = qb * 4 + 3, cw = qb * 4 + (w >> 1);
    const int lrow = tid >> 3, lch = tid & 7;
    const bf16_t* kbase = QKVZ + ((long)(b * SEQ + lrow)) * 4096 + 1024 + h * 64 + lch * 8;
    const bf16_t* vbase = VT + ((long)((b * NH + h) * 64 + lrow)) * SEQ + lch * 8;
    const float* fbase = aux + (long)(b * NH + h) * SEQ;
    constexpr float SC = 0.125f * LOG2E;

    __syncthreads();
    bf16x8 qf[4];
    {
        const bf16_t* qp = QKVZ + ((long)(b * SEQ + t)) * 4096 + h * 64 + hh * 8;
#pragma unroll
        for (int ks = 0; ks < 4; ++ks) qf[ks] = *(const bf16x8*)(qp + ks * 16);
    }
    float Ft = 0.f;
    if (MODE == 1) Ft = fbase[t] * LOG2E;
    u32x4 k0r, v0r, k1r, v1r, k2r, v2r; float f0r = 0.f, f1r = 0.f, f2r = 0.f;
    k0r = *(const u32x4*)(kbase + (long)jhi * 64 * 4096);       v0r = *(const u32x4*)(vbase + jhi * 64);
    k1r = *(const u32x4*)(kbase + (long)(jhi - 1) * 64 * 4096); v1r = *(const u32x4*)(vbase + (jhi - 1) * 64);
    k2r = *(const u32x4*)(kbase + (long)(jhi - 2) * 64 * 4096); v2r = *(const u32x4*)(vbase + (jhi - 2) * 64);
    if (MODE == 1) { if (tid < 64) { f0r = fbase[jhi * 64 + tid]; f1r = fbase[(jhi - 1) * 64 + tid]; f2r = fbase[(jhi - 2) * 64 + tid]; } }
    u32x4 zpre[4];
#pragma unroll
    for (int i = 0; i < 4; ++i) zpre[i] = *(const u32x4*)(QKVZ + (long)(b * SEQ + r0 + (lane >> 3) + 8 * i) * 4096 + 3072 + h * 64 + (lane & 7) * 8);
    if (MODE == 1) {
        int* JL = (int*)(lds + L_RELB);
        const float* NQ = nrm + ((long)(b * 128)) * 32 + 2 * h;
        const float* NK = nrm + ((long)(1024 + b * 128)) * 32 + 2 * h;
        float Qa = 0.f, Qb = 0.f, Bd = 0.f;
#pragma unroll
        for (int i = 0; i < 4; ++i) { Qa = fmaxf(Qa, sqrtf(ld_coh(NQ + (4 * qb + i) * 32))); Qb = fmaxf(Qb, sqrtf(ld_coh(NQ + (4 * qb + i) * 32 + 1))); }
#pragma unroll
        for (int i = 0; i < 4; ++i) Bd = fmaxf(Bd, Qa * sqrtf(ld_coh(NK + (4 * qb + i) * 32)) + Qb * sqrtf(ld_coh(NK + (4 * qb + i) * 32 + 1)));
        if (tid == 0) *JL = 4 * qb;
        __syncthreads();
        if (tid < 4 * qb) {
            const float Bj = Qa * sqrtf(ld_coh(NK + tid * 32)) + Qb * sqrtf(ld_coh(NK + tid * 32 + 1));
            const float Dj = ld_coh(fbase + 256 * qb) - ld_coh(fbase + 64 * tid + 63);
            if (!((Bj + Bd) * 0.125f + Dj < -PRUNE_NAT)) atomicMin(JL, tid);
        }
        __syncthreads();
        jlo = *JL;
        float* UW = (float*)(lds + L_UW) + w * 128;
        const float qa = sqrtf(ld_coh(NQ + cw * 32)), qbb = sqrtf(ld_coh(NQ + cw * 32 + 1));
        const float Fr0 = ld_coh(fbase + r0);
        for (int jr = lane; jr < cw - jlo; jr += 64) {
            const int j = jlo + jr;
            const float ka = sqrtf(ld_coh(NK + j * 32)), kb = sqrtf(ld_coh(NK + j * 32 + 1));
            UW[jr] = (qa * ka + qbb * kb) * SC + (Fr0 - ld_coh(fbase + 64 * j + 63)) * LOG2E;
        }
    }
    if (MODE == 0) { if (tid < 257) ((float*)(lds + L_RELB))[tid] = aux[h * 257 + tid] * LOG2E; }

    f32x16 O0, O1;
#pragma unroll
    for (int i = 0; i < 16; ++i) { O0[i] = 0.f; O1[i] = 0.f; }
    float m_run = 0.f, l_run = 0.f, m_min = -1e30f;
    bool first = true;

    auto LOADT = [&](u32x4& kr, u32x4& vr, float& fr_, int jj) __attribute__((always_inline)) {
        if (jj >= jlo) {
            kr = *(const u32x4*)(kbase + (long)jj * 64 * 4096);
            vr = *(const u32x4*)(vbase + jj * 64);
            if (MODE == 1) { if (tid < 64) fr_ = fbase[jj * 64 + tid]; }
        }
    };
    auto STEP = [&](u32x4& kreg, u32x4& vreg, float& freg, int j) __attribute__((always_inline)) {
        const int buf = (jhi - j) & 1;
        unsigned char* KB = lds + L_KB + buf * 64 * KROW;
        unsigned char* VB = lds + L_VB + buf * 64 * VROW;
        float* FB = (float*)(lds + L_FB + buf * 256);
        *(u32x4*)(KB + lrow * KROW + lch * 16) = kreg;
        *(u32x2*)(VB + lrow * VROW + lch * 16) = (u32x2){vreg.x, vreg.y};
        *(u32x2*)(VB + lrow * VROW + lch * 16 + 8) = (u32x2){vreg.z, vreg.w};
        if (MODE == 1) { if (tid < 64) FB[tid] = freg * LOG2E; }
        __syncthreads();
        LOADT(kreg, vreg, freg, j - 3);
        bool active;
        if (MODE == 0) active = (j >= cw - 8 && j <= cw);
        else {
            active = (j <= cw);
            if (j < cw) { const float ub = ((const float*)(lds + L_UW))[w * 128 + (j - jlo)]; if (ub - m_min < -PRUNE_NAT * LOG2E) active = false; }
        }
        if (active) {
            f32x16 s0, s1;
#pragma unroll
            for (int i = 0; i < 16; ++i) { s0[i] = 0.f; s1[i] = 0.f; }
#pragma unroll
            for (int ks = 0; ks < 4; ++ks) {
                const bf16x8 k0 = *(const bf16x8*)(KB + q * KROW + (16 * ks + 8 * hh) * 2);
                const bf16x8 k1 = *(const bf16x8*)(KB + (32 + q) * KROW + (16 * ks + 8 * hh) * 2);
                s0 = __builtin_amdgcn_mfma_f32_32x32x16_bf16(k0, qf[ks], s0, 0, 0, 0);
                s1 = __builtin_amdgcn_mfma_f32_32x32x16_bf16(k1, qf[ks], s1, 0, 0, 0);
            }
            if (MODE == 0) {
                const float* RB = (const float*)(lds + L_RELB);
                if (r0 - (64 * j + 63) >= 128) {
                    const float cb = RB[256] - m_run;
#pragma unroll
                    for (int i = 0; i < 16; ++i) { s0[i] = s0[i] * SC + cb; s1[i] = s1[i] * SC + cb; }
                } else {
#pragma unroll
                    for (int i = 0; i < 16; ++i) {
                        const int kl = (i & 3) + 8 * (i >> 2) + 4 * hh;
                        int rel0 = t - (64 * j + kl), rel1 = rel0 - 32;
                        rel0 = rel0 < -128 ? -128 : (rel0 > 128 ? 128 : rel0);
                        rel1 = rel1 < -128 ? -128 : (rel1 > 128 ? 128 : rel1);
                        s0[i] = s0[i] * SC + (RB[rel0 + 128] - m_run);
                        s1[i] = s1[i] * SC + (RB[rel1 + 128] - m_run);
                    }
                }
            } else {
                const bool diag = (j == cw);
                const float base = Ft - m_run;
#pragma unroll
                for (int g = 0; g < 4; ++g) {
                    const f32x4 f0 = *(const f32x4*)(FB + 8 * g + 4 * hh);
                    const f32x4 f1 = *(const f32x4*)(FB + 32 + 8 * g + 4 * hh);
#pragma unroll
                    for (int e = 0; e < 4; ++e) {
                        const int i = 4 * g + e;
                        float x0 = s0[i] * SC + (base - f0[e]);
                        float x1 = s1[i] * SC + (base - f1[e]);
                        if (diag) {
                            const int sp = 64 * j + 8 * g + 4 * hh + e;
                            if (sp > t) x0 = -1e30f;
                            if (sp + 32 > t) x1 = -1e30f;
                        }
                        s0[i] = x0; s1[i] = x1;
                    }
                }
            }
            float mx = s0[0];
#pragma unroll
            for (int i = 1; i < 16; ++i) mx = fmaxf(mx, s0[i]);
#pragma unroll
            for (int i = 0; i < 16; ++i) mx = fmaxf(mx, s1[i]);
            if (first || __any(mx > TH_DEFER)) {
                mx = fmaxf(mx, __shfl_xor(mx, 32));
                float d;
                if (first) { d = mx; }
                else {
                    d = fmaxf(mx, 0.f);
                    const float al = __builtin_amdgcn_exp2f(-d);
                    l_run *= al;
#pragma unroll
                    for (int i = 0; i < 16; ++i) { O0[i] *= al; O1[i] *= al; }
                }
                m_run += d;
#pragma unroll
                for (int i = 0; i < 16; ++i) { s0[i] -= d; s1[i] -= d; }
                first = false;
                if (MODE == 1) {
                    float mm = m_run;
#pragma unroll
                    for (int o = 32; o >= 1; o >>= 1) mm = fminf(mm, __shfl_xor(mm, o));
                    m_min = mm;
                }
            }
            float ps = 0.f;
#pragma unroll
            for (int i = 0; i < 16; ++i) { s0[i] = __builtin_amdgcn_exp2f(s0[i]); s1[i] = __builtin_amdgcn_exp2f(s1[i]); ps += s0[i] + s1[i]; }
            l_run += ps;
#pragma unroll
            for (int s = 0; s < 4; ++s) {
                u32x4 pw;
                if (s < 2) { pw.x = cvt_pk_bf16(s0[8 * s + 0], s0[8 * s + 1]); pw.y = cvt_pk_bf16(s0[8 * s + 2], s0[8 * s + 3]); pw.z = cvt_pk_bf16(s0[8 * s + 4], s0[8 * s + 5]); pw.w = cvt_pk_bf16(s0[8 * s + 6], s0[8 * s + 7]); }
                else { const int sp = s - 2; pw.x = cvt_pk_bf16(s1[8 * sp + 0], s1[8 * sp + 1]); pw.y = cvt_pk_bf16(s1[8 * sp + 2], s1[8 * sp + 3]); pw.z = cvt_pk_bf16(s1[8 * sp + 4], s1[8 * sp + 5]); pw.w = cvt_pk_bf16(s1[8 * sp + 6], s1[8 * sp + 7]); }
                const bf16x8 pf = __builtin_bit_cast(bf16x8, pw);
                {
                    const u32x2 lo = *(const u32x2*)(VB + q * VROW + (16 * s + 4 * hh) * 2);
                    const u32x2 hi = *(const u32x2*)(VB + q * VROW + (16 * s + 8 + 4 * hh) * 2);
                    const bf16x8 vf = __builtin_bit_cast(bf16x8, ((u32x4){lo.x, lo.y, hi.x, hi.y}));
                    O0 = __builtin_amdgcn_mfma_f32_32x32x16_bf16(vf, pf, O0, 0, 0, 0);
                }
                {
                    const u32x2 lo = *(const u32x2*)(VB + (32 + q) * VROW + (16 * s + 4 * hh) * 2);
                    const u32x2 hi = *(const u32x2*)(VB + (32 + q) * VROW + (16 * s + 8 + 4 * hh) * 2);
                    const bf16x8 vf = __builtin_bit_cast(bf16x8, ((u32x4){lo.x, lo.y, hi.x, hi.y}));
                    O1 = __builtin_amdgcn_mfma_f32_32x32x16_bf16(vf, pf, O1, 0, 0, 0);
                }
            }
        }
    };
    for (int j = jhi; j >= jlo; j -= 3) {
        STEP(k0r, v0r, f0r, j);
        if (j - 1 >= jlo) STEP(k1r, v1r, f1r, j - 1);
        if (j - 2 >= jlo) STEP(k2r, v2r, f2r, j - 2);
    }
    const float lt = l_run + __shfl_xor(l_run, 32);
    const float inv = 1.0f / lt;
    unsigned char* OST = lds + L_OST + w * 32 * KROW;
#pragma unroll
    for (int g = 0; g < 4; ++g) {
        u32x2 w0, w1;
        w0.x = cvt_pk_bf16(O0[4 * g + 0] * inv, O0[4 * g + 1] * inv); w0.y = cvt_pk_bf16(O0[4 * g + 2] * inv, O0[4 * g + 3] * inv);
        w1.x = cvt_pk_bf16(O1[4 * g + 0] * inv, O1[4 * g + 1] * inv); w1.y = cvt_pk_bf16(O1[4 * g + 2] * inv, O1[4 * g + 3] * inv);
        *(u32x2*)(OST + q * KROW + (8 * g + 4 * hh) * 2) = w0;
        *(u32x2*)(OST + q * KROW + (32 + 8 * g + 4 * hh) * 2) = w1;
    }
    __syncthreads();
#pragma unroll
    for (int i = 0; i < 4; ++i) {
        const int row = (lane >> 3) + 8 * i, ch = lane & 7;
        const u32x4 o8 = *(const u32x4*)(OST + row * KROW + ch * 16);
        const long tok = (long)(b * SEQ + r0 + row);
        const u32x4 z8 = zpre[i];
        u32x4 r8;
#pragma unroll
        for (int e = 0; e < 4; ++e) {
            const unsigned ou = o8[e], zu = z8[e];
            const float z0 = bf_lo(zu), z1 = bf_hi(zu);
            const float g0 = bf_lo(ou) * z0 / (1.0f + __expf(-z0));
            const float g1 = bf_hi(ou) * z1 / (1.0f + __expf(-z1));
            r8[e] = cvt_pk_bf16(g0, g1);
        }
        *(u32x4*)(G + tok * 1024 + h * 64 + ch * 8) = r8;
    }
}

__device__ __forceinline__ void transpose_w(const float* __restrict__ src, int N, bf16_t* __restrict__ dst, int tile) {
    float* T = (float*)g_shm;
    int tid = threadIdx.x; asm volatile("" : "+v"(tid));
    const int ntn = N / 64, kt = tile / ntn, ntl = tile % ntn, k0 = kt * 64, n0 = ntl * 64;
    __syncthreads();
#pragma unroll
    for (int e = 0; e < 8; ++e) { const int idx = tid + 512 * e, kk = idx >> 6, nn = idx & 63; T[kk * 65 + nn] = src[(long)(k0 + kk) * N + n0 + nn]; }
    __syncthreads();
#pragma unroll
    for (int e = 0; e < 4; ++e) { const int idx = tid + 512 * e, nn = idx >> 5, kp = idx & 31;
        *(unsigned*)(dst + (long)(n0 + nn) * 1024 + k0 + 2 * kp) = cvt_pk_bf16(T[(2 * kp) * 65 + nn], T[(2 * kp + 1) * 65 + nn]); }
}

__device__ __forceinline__ float log_sigmoid(float z) { return fminf(z, 0.f) - log1pf(expf(-fabsf(z))); }

__device__ __forceinline__ void ln_phase(float* __restrict__ io, bf16_t* __restrict__ XB, const float* __restrict__ g, const float* __restrict__ bta,
                                         const float* __restrict__ wf, const float* __restrict__ bf, float* __restrict__ LOGF) {
    int tid = threadIdx.x; asm volatile("" : "+v"(tid));
    const int w = tid >> 6, lane = tid & 63;
    f32x4* WF = (f32x4*)g_shm;
    if (wf) {
        __syncthreads();
        for (int idx = tid; idx < 4096; idx += 512) {
            const int ln = idx & 63, hq = (idx >> 6) & 3, ie = idx >> 8, k = 4 * (ln + 64 * (ie >> 2)) + (ie & 3);
            WF[idx] = *(const f32x4*)(wf + k * 16 + 4 * hq);
        }
        __syncthreads();
    }
    f32x4 gv[4], bv[4];
#pragma unroll
    for (int i = 0; i < 4; ++i) { gv[i] = *(const f32x4*)(g + 4 * (lane + 64 * i)); bv[i] = *(const f32x4*)(bta + 4 * (lane + 64 * i)); }
    const int rstride = gridDim.x * 8;
    f32x4 nv[4];
    {
        const int row = blockIdx.x * 8 + w;
        if (row < MTOK) {
#pragma unroll
            for (int i = 0; i < 4; ++i) nv[i] = *(const f32x4*)(io + (long)row * 1024 + 4 * (lane + 64 * i));
        }
    }
    for (int row = blockIdx.x * 8 + w; row < MTOK; row += rstride) {
        float* rp = io + (long)row * 1024;
        f32x4 v[4];
#pragma unroll
        for (int i = 0; i < 4; ++i) v[i] = nv[i];
        if (row + rstride < MTOK) {
#pragma unroll
            for (int i = 0; i < 4; ++i) nv[i] = *(const f32x4*)(io + (long)(row + rstride) * 1024 + 4 * (lane + 64 * i));
        }
        float s = 0.f;
#pragma unroll
        for (int i = 0; i < 4; ++i) s += (v[i][0] + v[i][1]) + (v[i][2] + v[i][3]);
#pragma unroll
        for (int o = 32; o >= 1; o >>= 1) s += __shfl_xor(s, o);
        const float mu = s * (1.0f / 1024.0f);
        float qs = 0.f;
#pragma unroll
        for (int i = 0; i < 4; ++i) { v[i] = v[i] - mu; qs += (v[i][0] * v[i][0] + v[i][1] * v[i][1]) + (v[i][2] * v[i][2] + v[i][3] * v[i][3]); }
#pragma unroll
        for (int o = 32; o >= 1; o >>= 1) qs += __shfl_xor(qs, o);
        const float rstd = 1.0f / sqrtf(qs * (1.0f / 1024.0f) + LN_EPS);
#pragma unroll
        for (int i = 0; i < 4; ++i) {
            v[i] = v[i] * rstd * gv[i] + bv[i];
            *(f32x4*)(rp + 4 * (lane + 64 * i)) = v[i];
            u32x2 pk; pk.x = cvt_pk_bf16(v[i][0], v[i][1]); pk.y = cvt_pk_bf16(v[i][2], v[i][3]);
            *(u32x2*)(XB + (long)row * 1024 + 4 * (lane + 64 * i)) = pk;
        }
        if (wf) {
            float a[16];
#pragma unroll
            for (int c = 0; c < 16; ++c) a[c] = 0.f;
#pragma unroll
            for (int i = 0; i < 4; ++i)
#pragma unroll
                for (int e = 0; e < 4; ++e) {
                    const float xv = v[i][e];
#pragma unroll
                    for (int hq = 0; hq < 4; ++hq) {
                        const f32x4 w4 = WF[((i * 4 + e) * 4 + hq) * 64 + lane];
                        a[4 * hq + 0] += xv * w4[0]; a[4 * hq + 1] += xv * w4[1]; a[4 * hq + 2] += xv * w4[2]; a[4 * hq + 3] += xv * w4[3];
                    }
                }
#pragma unroll
            for (int i = 0; i < 8; ++i) { const bool up = (lane & 32) != 0; const float send = up ? a[i] : a[i + 8], keep = up ? a[i + 8] : a[i]; a[i] = keep + __shfl_xor(send, 32); }
#pragma unroll
            for (int i = 0; i < 4; ++i) { const bool up = (lane & 16) != 0; const float send = up ? a[i] : a[i + 4], keep = up ? a[i + 4] : a[i]; a[i] = keep + __shfl_xor(send, 16); }
#pragma unroll
            for (int i = 0; i < 2; ++i) { const bool up = (lane & 8) != 0; const float send = up ? a[i] : a[i + 2], keep = up ? a[i + 2] : a[i]; a[i] = keep + __shfl_xor(send, 8); }
            { const bool up = (lane & 4) != 0; const float send = up ? a[0] : a[1], keep = up ? a[1] : a[0]; a[0] = keep + __shfl_xor(send, 4); }
            a[0] += __shfl_xor(a[0], 2); a[0] += __shfl_xor(a[0], 1);
            if ((lane & 3) == 0) {
                const int hd = ((lane >> 5) & 1) * 8 + ((lane >> 4) & 1) * 4 + ((lane >> 3) & 1) * 2 + ((lane >> 2) & 1);
                const int bb = row / SEQ, ss = row % SEQ;
                LOGF[((long)(bb * NH + hd)) * SEQ + ss] = log_sigmoid(a[0] + bf[hd]);
            }
        }
    }
}

__device__ __forceinline__ void scan_phase(float* __restrict__ F) {
    float* red = (float*)g_shm;
    int tid = threadIdx.x; asm volatile("" : "+v"(tid));
    const int w = tid >> 6, lane = tid & 63;
    for (int bh = blockIdx.x; bh < NB * NH; bh += gridDim.x) {
        float* p = F + (long)bh * SEQ + tid * 16;
        f32x4 v[4];
#pragma unroll
        for (int i = 0; i < 4; ++i) v[i] = *(const f32x4*)(p + 4 * i);
        float run = 0.f;
#pragma unroll
        for (int i = 0; i < 4; ++i)
#pragma unroll
            for (int e = 0; e < 4; ++e) { run += v[i][e]; v[i][e] = run; }
        float inc = run;
#pragma unroll
        for (int o = 1; o < 64; o <<= 1) { const float y = __shfl_up(inc, o); if (lane >= o) inc += y; }
        __syncthreads();
        if (lane == 63) red[w] = inc;
        __syncthreads();
        float base = inc - run;
        for (int ww = 0; ww < w; ++ww) base += red[ww];
#pragma unroll
        for (int i = 0; i < 4; ++i) { v[i] = v[i] + base; *(f32x4*)(p + 4 * i) = v[i]; }
    }
}

__device__ __forceinline__ void grid_bar(unsigned* ctr, unsigned target) {
    __syncthreads();
    if (threadIdx.x == 0) {
        __builtin_amdgcn_fence(__ATOMIC_RELEASE, "agent");
        __hip_atomic_fetch_add(ctr, 1u, __ATOMIC_RELAXED, __HIP_MEMORY_SCOPE_AGENT);
        while (__hip_atomic_load(ctr, __ATOMIC_RELAXED, __HIP_MEMORY_SCOPE_AGENT) < target) __builtin_amdgcn_s_sleep(4);
        __builtin_amdgcn_fence(__ATOMIC_ACQUIRE, "agent");
    }
    __syncthreads();
}

__global__ void __launch_bounds__(512, 2) fwd_megakernel(Params p) {
    cg::grid_group grid = cg::this_grid();
    bf16_t* XB = (bf16_t*)(p.ws + WS_XB);
    bf16_t* QKVZ = (bf16_t*)(p.ws + WS_QKVZ);
    bf16_t* VT = (bf16_t*)(p.ws + WS_VT);
    bf16_t* G = (bf16_t*)(p.ws + WS_G);
    bf16_t* WIN = (bf16_t*)(p.ws + WS_WIN);
    bf16_t* WOUT = (bf16_t*)(p.ws + WS_WOUT);
    float* F = (float*)(p.ws + WS_F);
    float* NRM = (float*)(p.ws + WS_NRM);
    unsigned* CTR = (unsigned*)(p.ws + WS_CTR);
    unsigned bar_gen = 0;
#define GRID_BAR() do { ++bar_gen; grid_bar(CTR, bar_gen * gridDim.x); } while (0)
    const int tid = threadIdx.x;
    LAS unsigned char* lds = (LAS unsigned char*)g_shm;

    {
        const long nvec = (long)MTOK * 1024 / 8;
#pragma unroll 4
        for (long i = (long)blockIdx.x * 512 + tid; i < nvec; i += (long)gridDim.x * 512) {
            const f32x4 a = *(const f32x4*)(p.x + i * 8), c = *(const f32x4*)(p.x + i * 8 + 4);
            u32x4 o; o.x = cvt_pk_bf16(a[0], a[1]); o.y = cvt_pk_bf16(a[2], a[3]); o.z = cvt_pk_bf16(c[0], c[1]); o.w = cvt_pk_bf16(c[2], c[3]);
            *(u32x4*)(XB + i * 8) = o;
        }
        for (int u = blockIdx.x; u < DEPTH * 1280; u += gridDim.x) {
            const int l = u / 1280, tl = u % 1280;
            if (tl < 1024) {
                const float* src = ((l & 1) ? p.w_in_b : p.w_in_a) + (long)(l >> 1) * 1024 * 4096;
                transpose_w(src, 4096, WIN + (long)l * 4096 * 1024, tl);
            } else {
                const float* src = ((l & 1) ? p.w_out_b : p.w_out_a) + (long)(l >> 1) * 1024 * 1024;
                transpose_w(src, 1024, WOUT + (long)l * 1024 * 1024, tl - 1024);
            }
        }
    }
    grid.sync();

#pragma unroll 1
    for (int layer = 0; layer < DEPTH; ++layer) {
        const bool isB = (layer & 1) != 0;
        const bf16_t* Wi = WIN + (long)layer * 4096 * 1024;
        const bf16_t* Wo = WOUT + (long)layer * 1024 * 1024;
        if (isB) scan_phase(F);
        {
            Sched S; S.mode = 0; S.XB = (const char*)XB; S.W = (const char*)Wi; S.G = gridDim.x; S.c = blockIdx.x;
            Epi E; E.mode = 0; E.QKVZ = QKVZ; E.VT = VT; E.xin = nullptr; E.of = nullptr; E.nrm = isB ? NRM : nullptr;
            __syncthreads();
            gemm_phase(lds, S, E);
        }
        GRID_BAR();
        for (int u = blockIdx.x; u < 4096; u += gridDim.x) {
            const int c = u & 255, i = u >> 8, bh = i * 8 + (c & 7);
            int qb = c >> 3;
            if (isB && (i & 1)) qb = 31 - qb;
            const int b = bh >> 4, h = bh & 15;
            if (!isB) attn_unit<0>(QKVZ, VT, p.rel_bias_a + (long)(layer >> 1) * NH * 257, G, b, h, qb, (qb * 4 - 8) > 0 ? (qb * 4 - 8) : 0, nullptr);
            else attn_unit<1>(QKVZ, VT, F, G, b, h, qb, 0, NRM);
        }
        GRID_BAR();
        {
            Sched S; S.mode = 1; S.XB = (const char*)G; S.W = (const char*)Wo; S.G = gridDim.x; S.c = blockIdx.x;
            Epi E; E.mode = 1; E.QKVZ = nullptr; E.VT = nullptr; E.xin = (layer == 0) ? p.x : p.out; E.of = p.out; E.nrm = nullptr;
            __syncthreads();
            gemm_phase(lds, S, E);
        }
        GRID_BAR();
        {
            const bool nextB = (layer + 1 < DEPTH) && ((layer + 1) & 1);
            const int jn = (layer + 1) >> 1;
            ln_phase(p.out, XB, p.ln_g + layer * 1024, p.ln_b + layer * 1024,
                     nextB ? p.w_f_b + (long)jn * 1024 * 16 : nullptr, nextB ? p.b_f_b + jn * 16 : nullptr, F);
        }
        if (layer + 1 < DEPTH) GRID_BAR();
    }
}

extern "C" void kernel_launch(void* const* d_in, const int* in_sizes, int n_in, void* d_out, int out_size, void* d_ws, size_t ws_size, hipStream_t stream) {
    static int grid_blocks = 0;
    if (grid_blocks == 0) {
        if (ws_size < WS_END) { fprintf(stderr, "kernel_launch: workspace too small (%zu < %zu)\n", ws_size, (size_t)WS_END); grid_blocks = -1; return; }
        int dev = 0, cus = 0, per_cu = 0;
        hipGetDevice(&dev);
        hipDeviceGetAttribute(&cus, hipDeviceAttributeMultiprocessorCount, dev);
        hipFuncSetAttribute((const void*)fwd_megakernel, hipFuncAttributeMaxDynamicSharedMemorySize, LDS_BYTES);
        hipOccupancyMaxActiveBlocksPerMultiprocessor(&per_cu, (const void*)fwd_megakernel, 512, LDS_BYTES);
        if (per_cu < 1) { fprintf(stderr, "kernel_launch: occupancy query says %d blocks per CU\n", per_cu); per_cu = 1; }
        grid_blocks = cus * 1;
        (void)hipGetLastError();
    }
    if (grid_blocks < 0) return;
    if (hipMemsetAsync((char*)d_ws + WS_CTR, 0, 256, stream) != hipSuccess) { fprintf(stderr, "kernel_launch: memset of the barrier counter failed\n"); return; }
    Params p{};
    p.x = (const float*)d_in[0]; p.w_in_a = (const float*)d_in[1]; p.rel_bias_a = (const float*)d_in[2]; p.w_out_a = (const float*)d_in[3];
    p.w_in_b = (const float*)d_in[4]; p.w_f_b = (const float*)d_in[5]; p.b_f_b = (const float*)d_in[6]; p.w_out_b = (const float*)d_in[7];
    p.ln_g = (const float*)d_in[8]; p.ln_b = (const float*)d_in[9];
    p.out = (float*)d_out; p.ws = (unsigned char*)d_ws;
    void* args[] = {&p};
    hipError_t e = hipLaunchCooperativeKernel((const void*)fwd_megakernel, dim3(grid_blocks), dim3(512), args, LDS_BYTES, stream);
    if (e != hipSuccess) fprintf(stderr, "cooperative launch failed: %s (grid %d)\n", hipGetErrorString(e), grid_blocks);
}
```

```cpp
#include <hip/hip_runtime.h>
#include <hip/hip_cooperative_groups.h>
#include <cstdio>
#include <cstdint>
namespace cg = cooperative_groups;

typedef unsigned short bf16_t;
typedef short bf16x8 __attribute__((ext_vector_type(8)));
typedef float f32x4 __attribute__((ext_vector_type(4)));
typedef float f32x16 __attribute__((ext_vector_type(16)));
typedef unsigned u32x4 __attribute__((ext_vector_type(4)));
typedef unsigned u32x2 __attribute__((ext_vector_type(2)));

constexpr int DM = 1024, NB = 8, SEQ = 8192, MTOK = NB * SEQ, NH = 16, DEPTH = 4;
constexpr float LN_EPS = 1e-5f;
constexpr float ALPHA = 1.681792830507429f;
constexpr float LOG2E = 1.4426950408889634f;
constexpr int LDS_BYTES = 131072;

constexpr size_t WS_XB = 0;
constexpr size_t WS_QKVZ = WS_XB + (size_t)MTOK * 1024 * 2;
constexpr size_t WS_VT = WS_QKVZ + (size_t)MTOK * 4096 * 2;
constexpr size_t WS_G = WS_VT + (size_t)MTOK * 1024 * 2;
constexpr size_t WS_WIN = WS_G + (size_t)MTOK * 1024 * 2;
constexpr size_t WS_WOUT = WS_WIN + (size_t)DEPTH * 4096 * 1024 * 2;
constexpr size_t WS_F = WS_WOUT + (size_t)DEPTH * 1024 * 1024 * 2;
constexpr size_t WS_NRM = WS_F + (size_t)NB * NH * SEQ * 4;
constexpr size_t WS_CTR = WS_NRM + (size_t)2 * 1024 * 128 * 4;
constexpr size_t WS_END = WS_CTR + 256;

extern __shared__ __attribute__((aligned(16))) unsigned char g_shm[];

struct Params {
    const float* x; const float* w_in_a; const float* rel_bias_a; const float* w_out_a;
    const float* w_in_b; const float* w_f_b; const float* b_f_b; const float* w_out_b;
    const float* ln_g; const float* ln_b;
    float* out; unsigned char* ws;
};

typedef __bf16 bf16x2_t __attribute__((ext_vector_type(2)));
typedef float f32x2_t __attribute__((ext_vector_type(2)));
__device__ __forceinline__ unsigned cvt_pk_bf16(float lo, float hi) { const f32x2_t v = {lo, hi}; const bf16x2_t r = __builtin_convertvector(v, bf16x2_t); return __builtin_bit_cast(unsigned, r); }
__device__ __forceinline__ float ld_coh(const float* p) { return __hip_atomic_load(p, __ATOMIC_RELAXED, __HIP_MEMORY_SCOPE_AGENT); }
template <int CTRL> __device__ __forceinline__ float dpp_f(float v) { return __int_as_float(__builtin_amdgcn_update_dpp(0, __float_as_int(v), CTRL, 0xf, 0xf, false)); }
__device__ __forceinline__ float bf_lo(unsigned u) { return __uint_as_float(u << 16); }
__device__ __forceinline__ float bf_hi(unsigned u) { return __uint_as_float(u & 0xffff0000u); }

#define LAS __attribute__((address_space(3)))
constexpr int BK = 64, HALF = 128, HTB = HALF * BK * 2, GK = 1024;
__device__ __forceinline__ int lds_byte(int r, int c) { const int st = (r >> 4) * 2 + (c >> 5), rr = r & 15, cc = c & 31, ob = rr * 64 + cc * 2; return st * 1024 + (ob ^ (((ob >> 9) & 1) << 5)); }
__device__ __forceinline__ void stage_rc(int b, int& R, int& C) { const int st = b / 1024, sb = b % 1024, swz = sb ^ (((sb >> 9) & 1) << 5); R = (st >> 1) * 16 + swz / 64; C = (st & 1) * 32 + (swz % 64) / 2; }
__device__ __forceinline__ int perm32(int rho) { const int n = rho >> 4, i = rho & 15; return 8 * (i >> 2) + 4 * n + (i & 3); }

__device__ __forceinline__ void tile_map(int L, int nM, int nN, int& pm, int& pn) {
    const int nwg = nM * nN; int wgid = L;
    { const int q = nwg / 8, r = nwg % 8, xcd = wgid % 8, off = wgid / 8; wgid = (xcd < r ? xcd * (q + 1) : r * (q + 1) + (xcd - r) * q) + off; }
    const int nig = 8 * nN, gid = wgid / nig, fm = gid * 8, gsz = (nM - fm) < 8 ? (nM - fm) : 8;
    pm = fm + ((wgid % nig) % gsz); pn = (wgid % nig) / gsz;
}

struct Unit { int pm, pn; };
constexpr size_t TSTEP = (size_t)256 * GK * 2;
struct Sched {
    int mode;
    const char* XB; const char* W; int G, c;
    __device__ __forceinline__ bool next(int i, Unit& u) const {
        if (mode == 1) { const int panel = c + (i >> 2) * G; if (panel >= 256) return false; u.pm = panel; u.pn = i & 3; return true; }
        const long L = (long)i * G + c; if (L >= 4096) return false;
        tile_map((int)L, 256, 16, u.pm, u.pn); return true;
    }
    __device__ __forceinline__ bool vt(const Unit& u) const { return mode == 0 && u.pn >= 8 && u.pn < 12; }
    __device__ __forceinline__ const char* pA(const Unit& u) const { return vt(u) ? W + (size_t)u.pn * TSTEP : XB + (size_t)u.pm * TSTEP; }
    __device__ __forceinline__ const char* pB(const Unit& u) const { return vt(u) ? XB + (size_t)u.pm * TSTEP : W + (size_t)u.pn * TSTEP; }
};
struct Epi {
    int mode; bf16_t* QKVZ; bf16_t* VT; const float* xin; float* of; float* nrm;
    __device__ __forceinline__ void operator()(const f32x4 (&acc)[2][2][4][2], const Unit& u, int wr, int wc, int fr, int fq) const {
        if (mode == 0) {
            bf16_t* ob; long ldo;
            if (u.pn >= 8 && u.pn < 12) { ob = VT + ((long)((u.pm >> 5) * 1024 + (u.pn - 8) * 256)) * SEQ + (u.pm & 31) * 256; ldo = SEQ; }
            else { ob = QKVZ + (long)u.pm * 256 * 4096 + u.pn * 256; ldo = 4096; }
            if (nrm && u.pn < 8) {
                const int which = u.pn >> 2, pnl = u.pn & 3;
#pragma unroll
                for (int ai = 0; ai < 2; ++ai)
#pragma unroll
                    for (int bj = 0; bj < 2; ++bj) {
                        float mx = 0.f;
#pragma unroll
                        for (int m = 0; m < 4; ++m) {
                            const f32x4 v0 = acc[ai][bj][m][0], v1 = acc[ai][bj][m][1];
                            float s = (v0[0] * v0[0] + v0[1] * v0[1]) + (v0[2] * v0[2] + v0[3] * v0[3]) + (v1[0] * v1[0] + v1[1] * v1[1]) + (v1[2] * v1[2] + v1[3] * v1[3]);
                            s += __shfl_xor(s, 16); s += __shfl_xor(s, 32);
                            mx = fmaxf(mx, s);
                        }
                        mx = fmaxf(mx, dpp_f<0xB1>(mx)); mx = fmaxf(mx, dpp_f<0x4E>(mx)); mx = fmaxf(mx, dpp_f<0x141>(mx)); mx = fmaxf(mx, dpp_f<0x140>(mx));
                        if (fr == 0 && fq == 0) nrm[((long)which * 1024 + (u.pm * 4 + 2 * ai + wr)) * 32 + pnl * 8 + 4 * bj + wc] = mx * 1.02f;
                    }
            }
#pragma unroll
            for (int ai = 0; ai < 2; ++ai)
#pragma unroll
                for (int m = 0; m < 4; ++m) {
                    bf16_t* rp = ob + (long)(ai * HALF + wr * 64 + m * 16 + fr) * ldo + wc * 32 + fq * 8;
#pragma unroll
                    for (int bj = 0; bj < 2; ++bj) {
                        const f32x4 v0 = acc[ai][bj][m][0], v1 = acc[ai][bj][m][1];
                        u32x4 w; w.x = cvt_pk_bf16(v0[0], v0[1]); w.y = cvt_pk_bf16(v0[2], v0[3]); w.z = cvt_pk_bf16(v1[0], v1[1]); w.w = cvt_pk_bf16(v1[2], v1[3]);
                        *(u32x4*)(rp + bj * HALF) = w;
                    }
                }
        } else {
            const long o = (long)u.pm * 256 * 1024 + u.pn * 256;
#pragma unroll
            for (int ai = 0; ai < 2; ++ai)
#pragma unroll
                for (int m = 0; m < 4; ++m) {
                    const long ro = o + (long)(ai * HALF + wr * 64 + m * 16 + fr) * 1024 + wc * 32 + fq * 8;
#pragma unroll
                    for (int bj = 0; bj < 2; ++bj)
#pragma unroll
                        for (int n = 0; n < 2; ++n) {
                            const f32x4 xv = *(const f32x4*)(xin + ro + bj * HALF + n * 4);
                            const f32x4 r = xv * ALPHA + acc[ai][bj][m][n];
                            *(f32x4*)(of + ro + bj * HALF + n * 4) = r;
                        }
                }
        }
    }
};

__device__ __forceinline__ void gemm_phase(LAS unsigned char* lds, const Sched& S, const Epi& E) {
    int tid = threadIdx.x; asm volatile("" : "+v"(tid));
    const int wid = __builtin_amdgcn_readfirstlane(tid >> 6), lane = tid & 63, wr = wid >> 2, wc = wid & 3, fr = lane & 15, fq = lane >> 4;
    constexpr int K = GK, nt = K / BK;
    unsigned voffA[2], voffB[2];
#pragma unroll
    for (int i = 0; i < 2; ++i) { int R, C; stage_rc(tid * 16 + i * 8192, R, C); const int Rb = (R & ~31) + perm32(R & 31);
        voffA[i] = (unsigned)(R * K + C) * 2u; voffB[i] = (unsigned)(Rb * K + C) * 2u; }
    constexpr size_t kstep = (size_t)(BK * 2);
    constexpr size_t hstep = (size_t)HALF * K * 2;
    const unsigned ldsw = (unsigned)wid * 1024u;
    const int aoff = lds_byte(wr * 64 + fr, fq * 8), boff = lds_byte(wc * 32 + fr, fq * 8);
#define PG8_SA(b, h) (((b) * 2 + (h)) * HTB)
#define PG8_SB(b, h) ((4 + (b) * 2 + (h)) * HTB)
#define PG8_STAGE(bufoff, gbase, voff) do { _Pragma("unroll") for (int _i = 0; _i < 2; ++_i) \
        __builtin_amdgcn_global_load_lds((const unsigned*)((const char*)(gbase) + (voff)[_i]), (LAS unsigned*)(lds + (bufoff) + ldsw + _i * 8192), 16, 0, 0); } while (0)
#define PG8_LDA(dst, b, h) do { _Pragma("unroll") for (int m = 0; m < 4; ++m) _Pragma("unroll") for (int k = 0; k < 2; ++k) dst[m][k] = *(const LAS bf16x8*)(lds + PG8_SA(b, h) + aoff + m * 2048 + k * 1024); } while (0)
#define PG8_LDB(dst, b, h) do { _Pragma("unroll") for (int n = 0; n < 2; ++n) _Pragma("unroll") for (int k = 0; k < 2; ++k) dst[n][k] = *(const LAS bf16x8*)(lds + PG8_SB(b, h) + boff + n * 2048 + k * 1024); } while (0)
#define PG8_MMA(ai, bj, At, Bt) do { __builtin_amdgcn_s_setprio(1); _Pragma("unroll") for (int m = 0; m < 4; ++m) _Pragma("unroll") for (int n = 0; n < 2; ++n) _Pragma("unroll") for (int k = 0; k < 2; ++k) \
        acc[ai][bj][m][n] = __builtin_amdgcn_mfma_f32_16x16x32_bf16(Bt[n][k], At[m][k], acc[ai][bj][m][n], 0, 0, 0); __builtin_amdgcn_s_setprio(0); } while (0)
#define PG8_WAIT_V(n) asm volatile("s_waitcnt vmcnt(" #n ")" ::: "memory")
#define PG8_WAIT_L(n) asm volatile("s_waitcnt lgkmcnt(" #n ")" ::: "memory")
#define PG8_BAR __builtin_amdgcn_s_barrier()
#define PG8_SCHED __builtin_amdgcn_sched_barrier(0)
    Unit cur, nxt; int ui = 0;
    if (!S.next(0, cur)) return;
    f32x4 acc[2][2][4][2];
#pragma unroll
    for (int a = 0; a < 2; ++a)
#pragma unroll
        for (int b = 0; b < 2; ++b)
#pragma unroll
            for (int m = 0; m < 4; ++m)
#pragma unroll
                for (int n = 0; n < 2; ++n) acc[a][b][m][n] = (f32x4){0.f, 0.f, 0.f, 0.f};
    bf16x8 At[4][2], B0[2][2], B1[2][2];
    const char* cA = S.pA(cur); const char* cB = S.pB(cur);
    PG8_STAGE(PG8_SB(0, 0), cB, voffB); PG8_STAGE(PG8_SB(0, 1), cB + hstep, voffB); PG8_STAGE(PG8_SA(0, 0), cA, voffA); PG8_STAGE(PG8_SA(0, 1), cA + hstep, voffA);
    if (wr == 1) PG8_BAR;
    PG8_WAIT_V(2); PG8_BAR;
    PG8_STAGE(PG8_SB(1, 0), cB + kstep, voffB); PG8_STAGE(PG8_SA(1, 0), cA + kstep, voffA); PG8_STAGE(PG8_SB(1, 1), cB + hstep + kstep, voffB);
    PG8_WAIT_V(6); PG8_BAR;
    for (;;) {
        const bool has_next = S.next(ui + 1, nxt);
        const char* nA = has_next ? S.pA(nxt) : cA; const char* nB = has_next ? S.pB(nxt) : cB;
        for (int t = 0; t < nt; t += 2) {
            const bool last = (t == nt - 2);
            const char* a1 = cA + (size_t)(t + 1) * kstep;
            const char* a2 = last ? nA : cA + (size_t)(t + 2) * kstep; const char* b2 = last ? nB : cB + (size_t)(t + 2) * kstep;
            const char* a3 = a2 + kstep; const char* b3 = b2 + kstep;
            PG8_LDB(B0, 0, 0); PG8_LDB(B1, 0, 1); PG8_SCHED; PG8_LDA(At, 0, 0); PG8_STAGE(PG8_SA(1, 1), a1 + hstep, voffA);
            PG8_WAIT_V(8); PG8_WAIT_L(0); PG8_BAR; PG8_MMA(0, 0, At, B0); PG8_MMA(0, 1, At, B1); PG8_BAR; PG8_SCHED;
            PG8_LDA(At, 0, 1); PG8_STAGE(PG8_SB(0, 0), b2, voffB); PG8_STAGE(PG8_SB(0, 1), b2 + hstep, voffB); PG8_STAGE(PG8_SA(0, 0), a2, voffA);
            PG8_WAIT_V(8); PG8_WAIT_L(0); PG8_BAR; PG8_MMA(1, 0, At, B0); PG8_MMA(1, 1, At, B1); PG8_BAR; PG8_SCHED;
            PG8_LDB(B0, 1, 0); PG8_LDB(B1, 1, 1); PG8_SCHED; PG8_LDA(At, 1, 0); PG8_STAGE(PG8_SA(0, 1), a2 + hstep, voffA);
            PG8_WAIT_V(8); PG8_WAIT_L(0); PG8_BAR; PG8_MMA(0, 0, At, B0); PG8_MMA(0, 1, At, B1); PG8_BAR; PG8_SCHED;
            PG8_LDA(At, 1, 1); PG8_STAGE(PG8_SB(1, 0), b3, voffB); PG8_STAGE(PG8_SB(1, 1), b3 + hstep, voffB); PG8_STAGE(PG8_SA(1, 0), a3, voffA);
            PG8_WAIT_V(8); PG8_WAIT_L(0); PG8_BAR; PG8_MMA(1, 0, At, B0); PG8_MMA(1, 1, At, B1); PG8_BAR; PG8_SCHED;
        }
        if (wr == 0) PG8_BAR;
        E(acc, cur, wr, wc, fr, fq);
        if (!has_next) break;
#pragma unroll
        for (int a = 0; a < 2; ++a)
#pragma unroll
            for (int b = 0; b < 2; ++b)
#pragma unroll
                for (int m = 0; m < 4; ++m)
#pragma unroll
                    for (int n = 0; n < 2; ++n) acc[a][b][m][n] = (f32x4){0.f, 0.f, 0.f, 0.f};
        cur = nxt; cA = nA; cB = nB; ++ui;
        if (wr == 1) PG8_BAR;
    }
    PG8_WAIT_V(0);
    PG8_BAR;
#undef PG8_SA
#undef PG8_SB
#undef PG8_STAGE
#undef PG8_LDA
#undef PG8_LDB
#undef PG8_MMA
}

constexpr int KROW = 144, VROW = 136;
constexpr int L_KB = 0, L_VB = 2 * 64 * KROW, L_FB = L_VB + 2 * 64 * VROW, L_RELB = L_FB + 512, L_OST = L_RELB + 1280, L_UW = L_OST + 8 * 32 * KROW, L_ATT_END = L_UW + 8 * 128 * 4;
static_assert(L_ATT_END <= LDS_BYTES, "lds");
constexpr float TH_DEFER = 8.0f;
constexpr float PRUNE_NAT = 60.0f;

template <int MODE>
__device__ __forceinline__ void attn_unit(const bf16_t* __restrict__ QKVZ, const bf16_t* __restrict__ VT, const float* __restrict__ aux,
                                          bf16_t* __restrict__ G, int b, int h, int qb, int jlo, const float* __restrict__ nrm) {
    unsigned char* lds = g_shm;
    int tid = threadIdx.x; asm volatile("" : "+v"(tid));
    const int w = tid >> 6, lane = tid & 63, q = lane & 31, hh = lane >> 5;
    const int r0 = qb * 256 + w * 32, t = r0 + q;
    const int jhi = qb * 4 + 3, cw = qb * 4 + (w >> 1);
    const int lrow = tid >> 3, lch = tid & 7;
    const bf16_t* kbase = QKVZ + ((long)(b * SEQ + lrow)) * 4096 + 1024 + h * 64 + lch * 8;
    const bf16_t* vbase = VT + ((long)((b * NH + h) * 64 + lrow)) * SEQ + lch * 8;
    const float* fbase = aux + (long)(b * NH + h) * SEQ;
    constexpr float SC = 0.125f * LOG2E;

    __syncthreads();
    bf16x8 qf[4];
    {
        const bf16_t* qp = QKVZ + ((long)(b * SEQ + t)) * 4096 + h * 64 + hh * 8;
#pragma unroll
        for (int ks = 0; ks < 4; ++ks) qf[ks] = *(const bf16x8*)(qp + ks * 16);
    }
    float Ft = 0.f;
    if (MODE == 1) Ft = fbase[t] * LOG2E;
    u32x4 k0r, v0r, k1r, v1r, k2r, v2r; float f0r = 0.f, f1r = 0.f, f2r = 0.f;
    k0r = *(const u32x4*)(kbase + (long)jhi * 64 * 4096);       v0r = *(const u32x4*)(vbase + jhi * 64);
    k1r = *(const u32x4*)(kbase + (long)(jhi - 1) * 64 * 4096); v1r = *(const u32x4*)(vbase + (jhi - 1) * 64);
    k2r = *(const u32x4*)(kbase + (long)(jhi - 2) * 64 * 4096); v2r = *(const u32x4*)(vbase + (jhi - 2) * 64);
    if (MODE == 1) { if (tid < 64) { f0r = fbase[jhi * 64 + tid]; f1r = fbase[(jhi - 1) * 64 + tid]; f2r = fbase[(jhi - 2) * 64 + tid]; } }
    u32x4 zpre[4];
#pragma unroll
    for (int i = 0; i < 4; ++i) zpre[i] = *(const u32x4*)(QKVZ + (long)(b * SEQ + r0 + (lane >> 3) + 8 * i) * 4096 + 3072 + h * 64 + (lane & 7) * 8);
    if (MODE == 1) {
        int* JL = (int*)(lds + L_RELB);
        const float* NQ = nrm + ((long)(b * 128)) * 32 + 2 * h;
        const float* NK = nrm + ((long)(1024 + b * 128)) * 32 + 2 * h;
        float Qa = 0.f, Qb = 0.f, Bd = 0.f;
#pragma unroll
        for (int i = 0; i < 4; ++i) { Qa = fmaxf(Qa, sqrtf(ld_coh(NQ + (4 * qb + i) * 32))); Qb = fmaxf(Qb, sqrtf(ld_coh(NQ + (4 * qb + i) * 32 + 1))); }
#pragma unroll
        for (int i = 0; i < 4; ++i) Bd = fmaxf(Bd, Qa * sqrtf(ld_coh(NK + (4 * qb + i) * 32)) + Qb * sqrtf(ld_coh(NK + (4 * qb + i) * 32 + 1)));
        if (tid == 0) *JL = 4 * qb;
        __syncthreads();
        if (tid < 4 * qb) {
            const float Bj = Qa * sqrtf(ld_coh(NK + tid * 32)) + Qb * sqrtf(ld_coh(NK + tid * 32 + 1));
            const float Dj = ld_coh(fbase + 256 * qb) - ld_coh(fbase + 64 * tid + 63);
            if (!((Bj + Bd) * 0.125f + Dj < -PRUNE_NAT)) atomicMin(JL, tid);
        }
        __syncthreads();
        jlo = *JL;
        float* UW = (float*)(lds + L_UW) + w * 128;
        const float qa = sqrtf(ld_coh(NQ + cw * 32)), qbb = sqrtf(ld_coh(NQ + cw * 32 + 1));
        const float Fr0 = ld_coh(fbase + r0);
        for (int jr = lane; jr < cw - jlo; jr += 64) {
            const int j = jlo + jr;
            const float ka = sqrtf(ld_coh(NK + j * 32)), kb = sqrtf(ld_coh(NK + j * 32 + 1));
            UW[jr] = (qa * ka + qbb * kb) * SC + (Fr0 - ld_coh(fbase + 64 * j + 63)) * LOG2E;
        }
    }
    if (MODE == 0) { if (tid < 257) ((float*)(lds + L_RELB))[tid] = aux[h * 257 + tid] * LOG2E; }

    f32x16 O0, O1;
#pragma unroll
    for (int i = 0; i < 16; ++i) { O0[i] = 0.f; O1[i] = 0.f; }
    float m_run = 0.f, l_run = 0.f, m_min = -1e30f;
    bool first = true;

    auto LOADT = [&](u32x4& kr, u32x4& vr, float& fr_, int jj) __attribute__((always_inline)) {
        if (jj >= jlo) {
            kr = *(const u32x4*)(kbase + (long)jj * 64 * 4096);
            vr = *(const u32x4*)(vbase + jj * 64);
            if (MODE == 1) { if (tid < 64) fr_ = fbase[jj * 64 + tid]; }
        }
    };
    auto STEP = [&](u32x4& kreg, u32x4& vreg, float& freg, int j) __attribute__((always_inline)) {
        const int buf = (jhi - j) & 1;
        unsigned char* KB = lds + L_KB + buf * 64 * KROW;
        unsigned char* VB = lds + L_VB + buf * 64 * VROW;
        float* FB = (float*)(lds + L_FB + buf * 256);
        *(u32x4*)(KB + lrow * KROW + lch * 16) = kreg;
        *(u32x2*)(VB + lrow * VROW + lch * 16) = (u32x2){vreg.x, vreg.y};
        *(u32x2*)(VB + lrow * VROW + lch * 16 + 8) = (u32x2){vreg.z, vreg.w};
        if (MODE == 1) { if (tid < 64) FB[tid] = freg * LOG2E; }
        __syncthreads();
        LOADT(kreg, vreg, freg, j - 3);
        bool active;
        if (MODE == 0) active = (j >= cw - 8 && j <= cw);
        else {
            active = (j <= cw);
            if (j < cw) { const float ub = ((const float*)(lds + L_UW))[w * 128 + (j - jlo)]; if (ub - m_min < -PRUNE_NAT * LOG2E) active = false; }
        }
        if (active) {
            f32x16 s0, s1;
#pragma unroll
            for (int i = 0; i < 16; ++i) { s0[i] = 0.f; s1[i] = 0.f; }
#pragma unroll
            for (int ks = 0; ks < 4; ++ks) {
                const bf16x8 k0 = *(const bf16x8*)(KB + q * KROW + (16 * ks + 8 * hh) * 2);
                const bf16x8 k1 = *(const bf16x8*)(KB + (32 + q) * KROW + (16 * ks + 8 * hh) * 2);
                s0 = __builtin_amdgcn_mfma_f32_32x32x16_bf16(k0, qf[ks], s0, 0, 0, 0);
                s1 = __builtin_amdgcn_mfma_f32_32x32x16_bf16(k1, qf[ks], s1, 0, 0, 0);
            }
            if (MODE == 0) {
                const float* RB = (const float*)(lds + L_RELB);
                if (r0 - (64 * j + 63) >= 128) {
                    const float cb = RB[256] - m_run;
#pragma unroll
                    for (int i = 0; i < 16; ++i) { s0[i] = s0[i] * SC + cb; s1[i] = s1[i] * SC + cb; }
                } else {
#pragma unroll
                    for (int i = 0; i < 16; ++i) {
                        const int kl = (i & 3) + 8 * (i >> 2) + 4 * hh;
                        int rel0 = t - (64 * j + kl), rel1 = rel0 - 32;
                        rel0 = rel0 < -128 ? -128 : (rel0 > 128 ? 128 : rel0);
                        rel1 = rel1 < -128 ? -128 : (rel1 > 128 ? 128 : rel1);
                        s0[i] = s0[i] * SC + (RB[rel0 + 128] - m_run);
                        s1[i] = s1[i] * SC + (RB[rel1 + 128] - m_run);
                    }
                }
            } else {
                const bool diag = (j == cw);
                const float base = Ft - m_run;
#pragma unroll
                for (int g = 0; g < 4; ++g) {
                    const f32x4 f0 = *(const f32x4*)(FB + 8 * g + 4 * hh);
                    const f32x4 f1 = *(const f32x4*)(FB + 32 + 8 * g + 4 * hh);
#pragma unroll
                    for (int e = 0; e < 4; ++e) {
                        const int i = 4 * g + e;
                        float x0 = s0[i] * SC + (base - f0[e]);
                        float x1 = s1[i] * SC + (base - f1[e]);
                        if (diag) {
                            const int sp = 64 * j + 8 * g + 4 * hh + e;
                            if (sp > t) x0 = -1e30f;
                            if (sp + 32 > t) x1 = -1e30f;
                        }
                        s0[i] = x0; s1[i] = x1;
                    }
                }
            }
            float mx = s0[0];
#pragma unroll
            for (int i = 1; i < 16; ++i) mx = fmaxf(mx, s0[i]);
#pragma unroll
            for (int i = 0; i < 16; ++i) mx = fmaxf(mx, s1[i]);
            if (first || __any(mx > TH_DEFER)) {
                mx = fmaxf(mx, __shfl_xor(mx, 32));
                float d;
                if (first) { d = mx; }
                else {
                    d = fmaxf(mx, 0.f);
                    const float al = __builtin_amdgcn_exp2f(-d);
                    l_run *= al;
#pragma unroll
                    for (int i = 0; i < 16; ++i) { O0[i] *= al; O1[i] *= al; }
                }
                m_run += d;
#pragma unroll
                for (int i = 0; i < 16; ++i) { s0[i] -= d; s1[i] -= d; }
                first = false;
                if (MODE == 1) {
                    float mm = m_run;
#pragma unroll
                    for (int o = 32; o >= 1; o >>= 1) mm = fminf(mm, __shfl_xor(mm, o));
                    m_min = mm;
                }
            }
            float ps = 0.f;
#pragma unroll
            for (int i = 0; i < 16; ++i) { s0[i] = __builtin_amdgcn_exp2f(s0[i]); s1[i] = __builtin_amdgcn_exp2f(s1[i]); ps += s0[i] + s1[i]; }
            l_run += ps;
#pragma unroll
            for (int s = 0; s < 4; ++s) {
                u32x4 pw;
                if (s < 2) { pw.x = cvt_pk_bf16(s0[8 * s + 0], s0[8 * s + 1]); pw.y = cvt_pk_bf16(s0[8 * s + 2], s0[8 * s + 3]); pw.z = cvt_pk_bf16(s0[8 * s + 4], s0[8 * s + 5]); pw.w = cvt_pk_bf16(s0[8 * s + 6], s0[8 * s + 7]); }
                else { const int sp = s - 2; pw.x = cvt_pk_bf16(s1[8 * sp + 0], s1[8 * sp + 1]); pw.y = cvt_pk_bf16(s1[8 * sp + 2], s1[8 * sp + 3]); pw.z = cvt_pk_bf16(s1[8 * sp + 4], s1[8 * sp + 5]); pw.w = cvt_pk_bf16(s1[8 * sp + 6], s1[8 * sp + 7]); }
                const bf16x8 pf = __builtin_bit_cast(bf16x8, pw);
                {
                    const u32x2 lo = *(const u32x2*)(VB + q * VROW + (16 * s + 4 * hh) * 2);
                    const u32x2 hi = *(const u32x2*)(VB + q * VROW + (16 * s + 8 + 4 * hh) * 2);
                    const bf16x8 vf = __builtin_bit_cast(bf16x8, ((u32x4){lo.x, lo.y, hi.x, hi.y}));
                    O0 = __builtin_amdgcn_mfma_f32_32x32x16_bf16(vf, pf, O0, 0, 0, 0);
                }
                {
                    const u32x2 lo = *(const u32x2*)(VB + (32 + q) * VROW + (16 * s + 4 * hh) * 2);
                    const u32x2 hi = *(const u32x2*)(VB + (32 + q) * VROW + (16 * s + 8 + 4 * hh) * 2);
                    const bf16x8 vf = __builtin_bit_cast(bf16x8, ((u32x4){lo.x, lo.y, hi.x, hi.y}));
                    O1 = __builtin_amdgcn_mfma_f32_32x32x16_bf16(vf, pf, O1, 0, 0, 0);
                }
            }
        }
    };
    for (int j = jhi; j >= jlo; j -= 3) {
        STEP(k0r, v0r, f0r, j);
        if (j - 1 >= jlo) STEP(k1r, v1r, f1r, j - 1);
        if (j - 2 >= jlo) STEP(k2r, v2r, f2r, j - 2);
    }
    const float lt = l_run + __shfl_xor(l_run, 32);
    const float inv = 1.0f / lt;
    unsigned char* OST = lds + L_OST + w * 32 * KROW;
#pragma unroll
    for (int g = 0; g < 4; ++g) {
        u32x2 w0, w1;
        w0.x = cvt_pk_bf16(O0[4 * g + 0] * inv, O0[4 * g + 1] * inv); w0.y = cvt_pk_bf16(O0[4 * g + 2] * inv, O0[4 * g + 3] * inv);
        w1.x = cvt_pk_bf16(O1[4 * g + 0] * inv, O1[4 * g + 1] * inv); w1.y = cvt_pk_bf16(O1[4 * g + 2] * inv, O1[4 * g + 3] * inv);
        *(u32x2*)(OST + q * KROW + (8 * g + 4 * hh) * 2) = w0;
        *(u32x2*)(OST + q * KROW + (32 + 8 * g + 4 * hh) * 2) = w1;
    }
    __syncthreads();
#pragma unroll
    for (int i = 0; i < 4; ++i) {
        const int row = (lane >> 3) + 8 * i, ch = lane & 7;
        const u32x4 o8 = *(const u32x4*)(OST + row * KROW + ch * 16);
        const long tok = (long)(b * SEQ + r0 + row);
        const u32x4 z8 = zpre[i];
        u32x4 r8;
#pragma unroll
        for (int e = 0; e < 4; ++e) {
            const unsigned ou = o8[e], zu = z8[e];
            const float z0 = bf_lo(zu), z1 = bf_hi(zu);
            const float g0 = bf_lo(ou) * z0 / (1.0f + __expf(-z0));
            const float g1 = bf_hi(ou) * z1 / (1.0f + __expf(-z1));
            r8[e] = cvt_pk_bf16(g0, g1);
        }
        *(u32x4*)(G + tok * 1024 + h * 64 + ch * 8) = r8;
    }
}

__device__ __forceinline__ void transpose_w(const float* __restrict__ src, int N, bf16_t* __restrict__ dst, int tile) {
    float* T = (float*)g_shm;
    int tid = threadIdx.x; asm volatile("" : "+v"(tid));
    const int ntn = N / 64, kt = tile / ntn, ntl = tile % ntn, k0 = kt * 64, n0 = ntl * 64;
    __syncthreads();
#pragma unroll
    for (int e = 0; e < 8; ++e) { const int idx = tid + 512 * e, kk = idx >> 6, nn = idx & 63; T[kk * 65 + nn] = src[(long)(k0 + kk) * N + n0 + nn]; }
    __syncthreads();
#pragma unroll
    for (int e = 0; e < 4; ++e) { const int idx = tid + 512 * e, nn = idx >> 5, kp = idx & 31;
        *(unsigned*)(dst + (long)(n0 + nn) * 1024 + k0 + 2 * kp) = cvt_pk_bf16(T[(2 * kp) * 65 + nn], T[(2 * kp + 1) * 65 + nn]); }
}

__device__ __forceinline__ float log_sigmoid(float z) { return fminf(z, 0.f) - log1pf(expf(-fabsf(z))); }

__device__ __forceinline__ void ln_phase(float* __restrict__ io, bf16_t* __restrict__ XB, const float* __restrict__ g, const float* __restrict__ bta,
                                         const float* __restrict__ wf, const float* __restrict__ bf, float* __restrict__ LOGF) {
    int tid = threadIdx.x; asm volatile("" : "+v"(tid));
    const int w = tid >> 6, lane = tid & 63;
    f32x4* WF = (f32x4*)g_shm;
    if (wf) {
        __syncthreads();
        for (int idx = tid; idx < 4096; idx += 512) {
            const int ln = idx & 63, hq = (idx >> 6) & 3, ie = idx >> 8, k = 4 * (ln + 64 * (ie >> 2)) + (ie & 3);
            WF[idx] = *(const f32x4*)(wf + k * 16 + 4 * hq);
        }
        __syncthreads();
    }
    f32x4 gv[4], bv[4];
#pragma unroll
    for (int i = 0; i < 4; ++i) { gv[i] = *(const f32x4*)(g + 4 * (lane + 64 * i)); bv[i] = *(const f32x4*)(bta + 4 * (lane + 64 * i)); }
    const int G_ = gridDim.x, c_ = blockIdx.x;
    const int nri = (c_ < 256) ? ((256 - c_ + G_ - 1) / G_) * 32 : 0;
    auto row_of = [&](int ri) __attribute__((always_inline)) { return (c_ + (ri >> 5) * G_) * 256 + w + 8 * (ri & 31); };
    f32x4 nv[4];
    if (nri > 0) {
        const int row = row_of(0);
#pragma unroll
        for (int i = 0; i < 4; ++i) nv[i] = *(const f32x4*)(io + (long)row * 1024 + 4 * (lane + 64 * i));
    }
    for (int ri = 0; ri < nri; ++ri) {
        const int row = row_of(ri);
        float* rp = io + (long)row * 1024;
        f32x4 v[4];
#pragma unroll
        for (int i = 0; i < 4; ++i) v[i] = nv[i];
        if (ri + 1 < nri) {
            const int nrow = row_of(ri + 1);
#pragma unroll
            for (int i = 0; i < 4; ++i) nv[i] = *(const f32x4*)(io + (long)nrow * 1024 + 4 * (lane + 64 * i));
        }
        float s = 0.f;
#pragma unroll
        for (int i = 0; i < 4; ++i) s += (v[i][0] + v[i][1]) + (v[i][2] + v[i][3]);
#pragma unroll
        for (int o = 32; o >= 1; o >>= 1) s += __shfl_xor(s, o);
        const float mu = s * (1.0f / 1024.0f);
        float qs = 0.f;
#pragma unroll
        for (int i = 0; i < 4; ++i) { v[i] = v[i] - mu; qs += (v[i][0] * v[i][0] + v[i][1] * v[i][1]) + (v[i][2] * v[i][2] + v[i][3] * v[i][3]); }
#pragma unroll
        for (int o = 32; o >= 1; o >>= 1) qs += __shfl_xor(qs, o);
        const float rstd = 1.0f / sqrtf(qs * (1.0f / 1024.0f) + LN_EPS);
#pragma unroll
        for (int i = 0; i < 4; ++i) {
            v[i] = v[i] * rstd * gv[i] + bv[i];
            *(f32x4*)(rp + 4 * (lane + 64 * i)) = v[i];
            if (XB) { u32x2 pk; pk.x = cvt_pk_bf16(v[i][0], v[i][1]); pk.y = cvt_pk_bf16(v[i][2], v[i][3]);
                *(u32x2*)(XB + (long)row * 1024 + 4 * (lane + 64 * i)) = pk; }
        }
        if (wf) {
            float a[16];
#pragma unroll
            for (int c = 0; c < 16; ++c) a[c] = 0.f;
#pragma unroll
            for (int i = 0; i < 4; ++i)
#pragma unroll
                for (int e = 0; e < 4; ++e) {
                    const float xv = v[i][e];
#pragma unroll
                    for (int hq = 0; hq < 4; ++hq) {
                        const f32x4 w4 = WF[((i * 4 + e) * 4 + hq) * 64 + lane];
                        a[4 * hq + 0] += xv * w4[0]; a[4 * hq + 1] += xv * w4[1]; a[4 * hq + 2] += xv * w4[2]; a[4 * hq + 3] += xv * w4[3];
                    }
                }
#pragma unroll
            for (int i = 0; i < 8; ++i) { const bool up = (lane & 32) != 0; const float send = up ? a[i] : a[i + 8], keep = up ? a[i + 8] : a[i]; a[i] = keep + __shfl_xor(send, 32); }
#pragma unroll
            for (int i = 0; i < 4; ++i) { const bool up = (lane & 16) != 0; const float send = up ? a[i] : a[i + 4], keep = up ? a[i + 4] : a[i]; a[i] = keep + __shfl_xor(send, 16); }
#pragma unroll
            for (int i = 0; i < 2; ++i) { const bool up = (lane & 8) != 0; const float send = up ? a[i] : a[i + 2], keep = up ? a[i + 2] : a[i]; a[i] = keep + __shfl_xor(send, 8); }
            { const bool up = (lane & 4) != 0; const float send = up ? a[0] : a[1], keep = up ? a[1] : a[0]; a[0] = keep + __shfl_xor(send, 4); }
            a[0] += __shfl_xor(a[0], 2); a[0] += __shfl_xor(a[0], 1);
            if ((lane & 3) == 0) {
                const int hd = ((lane >> 5) & 1) * 8 + ((lane >> 4) & 1) * 4 + ((lane >> 3) & 1) * 2 + ((lane >> 2) & 1);
                const int bb = row / SEQ, ss = row % SEQ;
                LOGF[((long)(bb * NH + hd)) * SEQ + ss] = log_sigmoid(a[0] + bf[hd]);
            }
        }
    }
}

__device__ __forceinline__ void scan_phase(float* __restrict__ F) {
    float* red = (float*)g_shm;
    int tid = threadIdx.x; asm volatile("" : "+v"(tid));
    const int w = tid >> 6, lane = tid & 63;
    for (int bh = blockIdx.x; bh < NB * NH; bh += gridDim.x) {
        float* p = F + (long)bh * SEQ + tid * 16;
        f32x4 v[4];
#pragma unroll
        for (int i = 0; i < 4; ++i) v[i] = *(const f32x4*)(p + 4 * i);
        float run = 0.f;
#pragma unroll
        for (int i = 0; i < 4; ++i)
#pragma unroll
            for (int e = 0; e < 4; ++e) { run += v[i][e]; v[i][e] = run; }
        float inc = run;
#pragma unroll
        for (int o = 1; o < 64; o <<= 1) { const float y = __shfl_up(inc, o); if (lane >= o) inc += y; }
        __syncthreads();
        if (lane == 63) red[w] = inc;
        __syncthreads();
        float base = inc - run;
        for (int ww = 0; ww < w; ++ww) base += red[ww];
#pragma unroll
        for (int i = 0; i < 4; ++i) { v[i] = v[i] + base; *(f32x4*)(p + 4 * i) = v[i]; }
    }
}

__device__ __forceinline__ void grid_bar(unsigned* ctr, unsigned target) {
    __syncthreads();
    if (threadIdx.x == 0) {
        __builtin_amdgcn_fence(__ATOMIC_RELEASE, "agent");
        __hip_atomic_fetch_add(ctr, 1u, __ATOMIC_RELAXED, __HIP_MEMORY_SCOPE_AGENT);
        while (__hip_atomic_load(ctr, __ATOMIC_RELAXED, __HIP_MEMORY_SCOPE_AGENT) < target) __builtin_amdgcn_s_sleep(4);
        __builtin_amdgcn_fence(__ATOMIC_ACQUIRE, "agent");
    }
    __syncthreads();
}

__global__ void __launch_bounds__(512, 2) fwd_megakernel(Params p) {
    cg::grid_group grid = cg::this_grid();
    bf16_t* XB = (bf16_t*)(p.ws + WS_XB);
    bf16_t* QKVZ = (bf16_t*)(p.ws + WS_QKVZ);
    bf16_t* VT = (bf16_t*)(p.ws + WS_VT);
    bf16_t* G = (bf16_t*)(p.ws + WS_G);
    bf16_t* WIN = (bf16_t*)(p.ws + WS_WIN);
    bf16_t* WOUT = (bf16_t*)(p.ws + WS_WOUT);
    float* F = (float*)(p.ws + WS_F);
    float* NRM = (float*)(p.ws + WS_NRM);
    unsigned* CTR = (unsigned*)(p.ws + WS_CTR);
    unsigned bar_gen = 0;
#define GRID_BAR() do { ++bar_gen; grid_bar(CTR, bar_gen * gridDim.x); } while (0)
    const int tid = threadIdx.x;
    LAS unsigned char* lds = (LAS unsigned char*)g_shm;

    {
        const long nvec = (long)MTOK * 1024 / 8;
#pragma unroll 4
        for (long i = (long)blockIdx.x * 512 + tid; i < nvec; i += (long)gridDim.x * 512) {
            const f32x4 a = *(const f32x4*)(p.x + i * 8), c = *(const f32x4*)(p.x + i * 8 + 4);
            u32x4 o; o.x = cvt_pk_bf16(a[0], a[1]); o.y = cvt_pk_bf16(a[2], a[3]); o.z = cvt_pk_bf16(c[0], c[1]); o.w = cvt_pk_bf16(c[2], c[3]);
            *(u32x4*)(XB + i * 8) = o;
        }
        for (int u = blockIdx.x; u < DEPTH * 1280; u += gridDim.x) {
            const int l = u / 1280, tl = u % 1280;
            if (tl < 1024) {
                const float* src = ((l & 1) ? p.w_in_b : p.w_in_a) + (long)(l >> 1) * 1024 * 4096;
                transpose_w(src, 4096, WIN + (long)l * 4096 * 1024, tl);
            } else {
                const float* src = ((l & 1) ? p.w_out_b : p.w_out_a) + (long)(l >> 1) * 1024 * 1024;
                transpose_w(src, 1024, WOUT + (long)l * 1024 * 1024, tl - 1024);
            }
        }
    }
    grid.sync();

#pragma unroll 1
    for (int layer = 0; layer < DEPTH; ++layer) {
        const bool isB = (layer & 1) != 0;
        const bf16_t* Wi = WIN + (long)layer * 4096 * 1024;
        const bf16_t* Wo = WOUT + (long)layer * 1024 * 1024;
        if (isB) scan_phase(F);
        {
            Sched S; S.mode = 0; S.XB = (const char*)XB; S.W = (const char*)Wi; S.G = gridDim.x; S.c = blockIdx.x;
            Epi E; E.mode = 0; E.QKVZ = QKVZ; E.VT = VT; E.xin = nullptr; E.of = nullptr; E.nrm = isB ? NRM : nullptr;
            __syncthreads();
            gemm_phase(lds, S, E);
        }
        GRID_BAR();
        for (int u = blockIdx.x; u < 4096; u += gridDim.x) {
            const int c = u & 255, i = u >> 8, bh = i * 8 + (c & 7);
            int qb = c >> 3;
            if (isB && (i & 1)) qb = 31 - qb;
            const int b = bh >> 4, h = bh & 15;
            if (!isB) attn_unit<0>(QKVZ, VT, p.rel_bias_a + (long)(layer >> 1) * NH * 257, G, b, h, qb, (qb * 4 - 8) > 0 ? (qb * 4 - 8) : 0, nullptr);
            else attn_unit<1>(QKVZ, VT, F, G, b, h, qb, 0, NRM);
        }
        GRID_BAR();
        {
            Sched S; S.mode = 1; S.XB = (const char*)G; S.W = (const char*)Wo; S.G = gridDim.x; S.c = blockIdx.x;
            Epi E; E.mode = 1; E.QKVZ = nullptr; E.VT = nullptr; E.xin = (layer == 0) ? p.x : p.out; E.of = p.out; E.nrm = nullptr;
            __syncthreads();
            gemm_phase(lds, S, E);
        }
        __syncthreads();
        {
            const bool nextB = (layer + 1 < DEPTH) && ((layer + 1) & 1);
            const int jn = (layer + 1) >> 1;
            ln_phase(p.out, (layer + 1 < DEPTH) ? XB : nullptr, p.ln_g + layer * 1024, p.ln_b + layer * 1024,
                     nextB ? p.w_f_b + (long)jn * 1024 * 16 : nullptr, nextB ? p.b_f_b + jn * 16 : nullptr, F);
        }
        if (layer + 1 < DEPTH) GRID_BAR();
    }
}

extern "C" void kernel_launch(void* const* d_in, const int* in_sizes, int n_in, void* d_out, int out_size, void* d_ws, size_t ws_size, hipStream_t stream) {
    static int grid_blocks = 0;
    if (grid_blocks == 0) {
        if (ws_size < WS_END) { fprintf(stderr, "kernel_launch: workspace too small (%zu < %zu)\n", ws_size, (size_t)WS_END); grid_blocks = -1; return; }
        int dev = 0, cus = 0, per_cu = 0;
        hipGetDevice(&dev);
        hipDeviceGetAttribute(&cus, hipDeviceAttributeMultiprocessorCount, dev);
        hipFuncSetAttribute((const void*)fwd_megakernel, hipFuncAttributeMaxDynamicSharedMemorySize, LDS_BYTES);
        hipOccupancyMaxActiveBlocksPerMultiprocessor(&per_cu, (const void*)fwd_megakernel, 512, LDS_BYTES);
        if (per_cu < 1) { fprintf(stderr, "kernel_launch: occupancy query says %d blocks per CU\n", per_cu); per_cu = 1; }
        grid_blocks = cus * 1;
        (void)hipGetLastError();
    }
    if (grid_blocks < 0) return;
    if (hipMemsetAsync((char*)d_ws + WS_CTR, 0, 256, stream) != hipSuccess) { fprintf(stderr, "kernel_launch: memset of the barrier counter failed\n"); return; }
    Params p{};
    p.x = (const float*)d_in[0]; p.w_in_a = (const float*)d_in[1]; p.rel_bias_a = (const float*)d_in[2]; p.w_out_a = (const float*)d_in[3];
    p.w_in_b = (const float*)d_in[4]; p.w_f_b = (const float*)d_in[5]; p.b_f_b = (const float*)d_in[6]; p.w_out_b = (const float*)d_in[7];
    p.ln_g = (const float*)d_in[8]; p.ln_b = (const float*)d_in[9];
    p.out = (float*)d_out; p.ws = (unsigned char*)d_ws;
    void* args[] = {&p};
    hipError_t e = hipLaunchCooperativeKernel((const void*)fwd_megakernel, dim3(grid_blocks), dim3(512), args, LDS_BYTES, stream);
    if (e != hipSuccess) fprintf(stderr, "cooperative launch failed: %s (grid %d)\n", hipGetErrorString(e), grid_blocks);
}
```

```cpp
#include <hip/hip_runtime.h>
#include <hip/hip_cooperative_groups.h>
#include <cstdio>
#include <cstdint>
namespace cg = cooperative_groups;

typedef unsigned short bf16_t;
typedef short bf16x8 __attribute__((ext_vector_type(8)));
typedef float f32x4 __attribute__((ext_vector_type(4)));
typedef float f32x16 __attribute__((ext_vector_type(16)));
typedef unsigned u32x4 __attribute__((ext_vector_type(4)));
typedef unsigned u32x2 __attribute__((ext_vector_type(2)));

constexpr int DM = 1024, NB = 8, SEQ = 8192, MTOK = NB * SEQ, NH = 16, DEPTH = 4;
constexpr float LN_EPS = 1e-5f;
constexpr float ALPHA = 1.681792830507429f;
constexpr float LOG2E = 1.4426950408889634f;
constexpr int LDS_BYTES = 131072;

constexpr size_t WS_XB = 0;
constexpr size_t WS_QKVZ = WS_XB + (size_t)MTOK * 1024 * 2;
constexpr size_t WS_VT = WS_QKVZ + (size_t)MTOK * 4096 * 2;
constexpr size_t WS_G = WS_VT + (size_t)MTOK * 1024 * 2;
constexpr size_t WS_WIN = WS_G + (size_t)MTOK * 1024 * 2;
constexpr size_t WS_WOUT = WS_WIN + (size_t)DEPTH * 4096 * 1024 * 2;
constexpr size_t WS_F = WS_WOUT + (size_t)DEPTH * 1024 * 1024 * 2;
constexpr size_t WS_NRM = WS_F + (size_t)NB * NH * SEQ * 4;
constexpr size_t WS_CTR = WS_NRM + (size_t)2 * 1024 * 128 * 4;
constexpr size_t WS_END = WS_CTR + 256;

extern __shared__ __attribute__((aligned(16))) unsigned char g_shm[];

struct Params {
    const float* x; const float* w_in_a; const float* rel_bias_a; const float* w_out_a;
    const float* w_in_b; const float* w_f_b; const float* b_f_b; const float* w_out_b;
    const float* ln_g; const float* ln_b;
    float* out; unsigned char* ws;
};

typedef __bf16 bf16x2_t __attribute__((ext_vector_type(2)));
typedef float f32x2_t __attribute__((ext_vector_type(2)));
__device__ __forceinline__ unsigned cvt_pk_bf16(float lo, float hi) { const f32x2_t v = {lo, hi}; const bf16x2_t r = __builtin_convertvector(v, bf16x2_t); return __builtin_bit_cast(unsigned, r); }
__device__ __forceinline__ float ld_coh(const float* p) { return __hip_atomic_load(p, __ATOMIC_RELAXED, __HIP_MEMORY_SCOPE_AGENT); }
template <int CTRL> __device__ __forceinline__ float dpp_f(float v) { return __int_as_float(__builtin_amdgcn_update_dpp(0, __float_as_int(v), CTRL, 0xf, 0xf, false)); }
__device__ __forceinline__ float bf_lo(unsigned u) { return __uint_as_float(u << 16); }
__device__ __forceinline__ float bf_hi(unsigned u) { return __uint_as_float(u & 0xffff0000u); }

#define LAS __attribute__((address_space(3)))
constexpr int BK = 64, HALF = 128, HTB = HALF * BK * 2, GK = 1024;
__device__ __forceinline__ int lds_byte(int r, int c) { const int st = (r >> 4) * 2 + (c >> 5), rr = r & 15, cc = c & 31, ob = rr * 64 + cc * 2; return st * 1024 + (ob ^ (((ob >> 9) & 1) << 5)); }
__device__ __forceinline__ void stage_rc(int b, int& R, int& C) { const int st = b / 1024, sb = b % 1024, swz = sb ^ (((sb >> 9) & 1) << 5); R = (st >> 1) * 16 + swz / 64; C = (st & 1) * 32 + (swz % 64) / 2; }
__device__ __forceinline__ int perm32(int rho) { const int n = rho >> 4, i = rho & 15; return 8 * (i >> 2) + 4 * n + (i & 3); }

__device__ __forceinline__ void tile_map(int L, int nM, int nN, int& pm, int& pn) {
    const int nwg = nM * nN; int wgid = L;
    { const int q = nwg / 8, r = nwg % 8, xcd = wgid % 8, off = wgid / 8; wgid = (xcd < r ? xcd * (q + 1) : r * (q + 1) + (xcd - r) * q) + off; }
    const int nig = 8 * nN, gid = wgid / nig, fm = gid * 8, gsz = (nM - fm) < 8 ? (nM - fm) : 8;
    pm = fm + ((wgid % nig) % gsz); pn = (wgid % nig) / gsz;
}

struct Unit { int pm, pn; };
constexpr size_t TSTEP = (size_t)256 * GK * 2;
struct Sched {
    int mode;
    const char* XB; const char* W; int G, c;
    __device__ __forceinline__ bool next(int i, Unit& u) const {
        if (mode == 1) { const int panel = c + (i >> 2) * G; if (panel >= 256) return false; u.pm = panel; u.pn = i & 3; return true; }
        const long L = (long)i * G + c; if (L >= 4096) return false;
        tile_map((int)L, 256, 16, u.pm, u.pn); return true;
    }
    __device__ __forceinline__ bool vt(const Unit& u) const { return mode == 0 && u.pn >= 8 && u.pn < 12; }
    __device__ __forceinline__ const char* pA(const Unit& u) const { return vt(u) ? W + (size_t)u.pn * TSTEP : XB + (size_t)u.pm * TSTEP; }
    __device__ __forceinline__ const char* pB(const Unit& u) const { return vt(u) ? XB + (size_t)u.pm * TSTEP : W + (size_t)u.pn * TSTEP; }
};
struct Epi {
    int mode; bf16_t* QKVZ; bf16_t* VT; const float* xin; float* of; float* nrm;
    __device__ __forceinline__ void operator()(const f32x4 (&acc)[2][2][4][2], const Unit& u, int wr, int wc, int fr, int fq) const {
        if (mode == 0) {
            bf16_t* ob; long ldo;
            if (u.pn >= 8 && u.pn < 12) { ob = VT + ((long)((u.pm >> 5) * 1024 + (u.pn - 8) * 256)) * SEQ + (u.pm & 31) * 256; ldo = SEQ; }
            else { ob = QKVZ + (long)u.pm * 256 * 4096 + u.pn * 256; ldo = 4096; }
            if (nrm && u.pn < 8) {
                const int which = u.pn >> 2, pnl = u.pn & 3;
#pragma unroll
                for (int ai = 0; ai < 2; ++ai)
#pragma unroll
                    for (int bj = 0; bj < 2; ++bj) {
                        float mx = 0.f;
#pragma unroll
                        for (int m = 0; m < 4; ++m) {
                            const f32x4 v0 = acc[ai][bj][m][0], v1 = acc[ai][bj][m][1];
                            float s = (v0[0] * v0[0] + v0[1] * v0[1]) + (v0[2] * v0[2] + v0[3] * v0[3]) + (v1[0] * v1[0] + v1[1] * v1[1]) + (v1[2] * v1[2] + v1[3] * v1[3]);
                            s += __shfl_xor(s, 16); s += __shfl_xor(s, 32);
                            mx = fmaxf(mx, s);
                        }
                        mx = fmaxf(mx, dpp_f<0xB1>(mx)); mx = fmaxf(mx, dpp_f<0x4E>(mx)); mx = fmaxf(mx, dpp_f<0x141>(mx)); mx = fmaxf(mx, dpp_f<0x140>(mx));
                        if (fr == 0 && fq == 0) nrm[((long)which * 1024 + (u.pm * 4 + 2 * ai + wr)) * 32 + pnl * 8 + 4 * bj + wc] = mx * 1.02f;
                    }
            }
#pragma unroll
            for (int ai = 0; ai < 2; ++ai)
#pragma unroll
                for (int m = 0; m < 4; ++m) {
                    bf16_t* rp = ob + (long)(ai * HALF + wr * 64 + m * 16 + fr) * ldo + wc * 32 + fq * 8;
#pragma unroll
                    for (int bj = 0; bj < 2; ++bj) {
                        const f32x4 v0 = acc[ai][bj][m][0], v1 = acc[ai][bj][m][1];
                        u32x4 w; w.x = cvt_pk_bf16(v0[0], v0[1]); w.y = cvt_pk_bf16(v0[2], v0[3]); w.z = cvt_pk_bf16(v1[0], v1[1]); w.w = cvt_pk_bf16(v1[2], v1[3]);
                        *(u32x4*)(rp + bj * HALF) = w;
                    }
                }
        } else {
            const long o = (long)u.pm * 256 * 1024 + u.pn * 256;
#pragma unroll
            for (int ai = 0; ai < 2; ++ai)
#pragma unroll
                for (int m = 0; m < 4; ++m) {
                    const long ro = o + (long)(ai * HALF + wr * 64 + m * 16 + fr) * 1024 + wc * 32 + fq * 8;
#pragma unroll
                    for (int bj = 0; bj < 2; ++bj)
#pragma unroll
                        for (int n = 0; n < 2; ++n) {
                            const f32x4 xv = *(const f32x4*)(xin + ro + bj * HALF + n * 4);
                            const f32x4 r = xv * ALPHA + acc[ai][bj][m][n];
                            *(f32x4*)(of + ro + bj * HALF + n * 4) = r;
                        }
                }
        }
    }
};

__device__ __forceinline__ void gemm_phase(LAS unsigned char* lds, const Sched& S, const Epi& E) {
    int tid = threadIdx.x; asm volatile("" : "+v"(tid));
    const int wid = __builtin_amdgcn_readfirstlane(tid >> 6), lane = tid & 63, wr = wid >> 2, wc = wid & 3, fr = lane & 15, fq = lane >> 4;
    constexpr int K = GK, nt = K / BK;
    unsigned voffA[2], voffB[2];
#pragma unroll
    for (int i = 0; i < 2; ++i) { int R, C; stage_rc(tid * 16 + i * 8192, R, C); const int Rb = (R & ~31) + perm32(R & 31);
        voffA[i] = (unsigned)(R * K + C) * 2u; voffB[i] = (unsigned)(Rb * K + C) * 2u; }
    constexpr size_t kstep = (size_t)(BK * 2);
    constexpr size_t hstep = (size_t)HALF * K * 2;
    const unsigned ldsw = (unsigned)wid * 1024u;
    const int aoff = lds_byte(wr * 64 + fr, fq * 8), boff = lds_byte(wc * 32 + fr, fq * 8);
#define PG8_SA(b, h) (((b) * 2 + (h)) * HTB)
#define PG8_SB(b, h) ((4 + (b) * 2 + (h)) * HTB)
#define PG8_STAGE(bufoff, gbase, voff) do { _Pragma("unroll") for (int _i = 0; _i < 2; ++_i) \
        __builtin_amdgcn_global_load_lds((const unsigned*)((const char*)(gbase) + (voff)[_i]), (LAS unsigned*)(lds + (bufoff) + ldsw + _i * 8192), 16, 0, 0); } while (0)
#define PG8_LDA(dst, b, h) do { _Pragma("unroll") for (int m = 0; m < 4; ++m) _Pragma("unroll") for (int k = 0; k < 2; ++k) dst[m][k] = *(const LAS bf16x8*)(lds + PG8_SA(b, h) + aoff + m * 2048 + k * 1024); } while (0)
#define PG8_LDB(dst, b, h) do { _Pragma("unroll") for (int n = 0; n < 2; ++n) _Pragma("unroll") for (int k = 0; k < 2; ++k) dst[n][k] = *(const LAS bf16x8*)(lds + PG8_SB(b, h) + boff + n * 2048 + k * 1024); } while (0)
#define PG8_MMA(ai, bj, At, Bt) do { __builtin_amdgcn_s_setprio(1); _Pragma("unroll") for (int m = 0; m < 4; ++m) _Pragma("unroll") for (int n = 0; n < 2; ++n) _Pragma("unroll") for (int k = 0; k < 2; ++k) \
        acc[ai][bj][m][n] = __builtin_amdgcn_mfma_f32_16x16x32_bf16(Bt[n][k], At[m][k], acc[ai][bj][m][n], 0, 0, 0); __builtin_amdgcn_s_setprio(0); } while (0)
#define PG8_WAIT_V(n) asm volatile("s_waitcnt vmcnt(" #n ")" ::: "memory")
#define PG8_WAIT_L(n) asm volatile("s_waitcnt lgkmcnt(" #n ")" ::: "memory")
#define PG8_BAR __builtin_amdgcn_s_barrier()
#define PG8_SCHED __builtin_amdgcn_sched_barrier(0)
    Unit cur, nxt; int ui = 0;
    if (!S.next(0, cur)) return;
    f32x4 acc[2][2][4][2];
#pragma unroll
    for (int a = 0; a < 2; ++a)
#pragma unroll
        for (int b = 0; b < 2; ++b)
#pragma unroll
            for (int m = 0; m < 4; ++m)
#pragma unroll
                for (int n = 0; n < 2; ++n) acc[a][b][m][n] = (f32x4){0.f, 0.f, 0.f, 0.f};
    bf16x8 At[4][2], B0[2][2], B1[2][2];
    const char* cA = S.pA(cur); const char* cB = S.pB(cur);
    PG8_STAGE(PG8_SB(0, 0), cB, voffB); PG8_STAGE(PG8_SB(0, 1), cB + hstep, voffB); PG8_STAGE(PG8_SA(0, 0), cA, voffA); PG8_STAGE(PG8_SA(0, 1), cA + hstep, voffA);
    if (wr == 1) PG8_BAR;
    PG8_WAIT_V(2); PG8_BAR;
    PG8_STAGE(PG8_SB(1, 0), cB + kstep, voffB); PG8_STAGE(PG8_SA(1, 0), cA + kstep, voffA); PG8_STAGE(PG8_SB(1, 1), cB + hstep + kstep, voffB);
    PG8_WAIT_V(6); PG8_BAR;
    for (;;) {
        const bool has_next = S.next(ui + 1, nxt);
        const char* nA = has_next ? S.pA(nxt) : cA; const char* nB = has_next ? S.pB(nxt) : cB;
        for (int t = 0; t < nt; t += 2) {
            const bool last = (t == nt - 2);
            const char* a1 = cA + (size_t)(t + 1) * kstep;
            const char* a2 = last ? nA : cA + (size_t)(t + 2) * kstep; const char* b2 = last ? nB : cB + (size_t)(t + 2) * kstep;
            const char* a3 = a2 + kstep; const char* b3 = b2 + kstep;
            PG8_LDB(B0, 0, 0); PG8_LDB(B1, 0, 1); PG8_SCHED; PG8_LDA(At, 0, 0); PG8_STAGE(PG8_SA(1, 1), a1 + hstep, voffA);
            PG8_WAIT_V(8); PG8_WAIT_L(0); PG8_BAR; PG8_MMA(0, 0, At, B0); PG8_MMA(0, 1, At, B1); PG8_BAR; PG8_SCHED;
            PG8_LDA(At, 0, 1); PG8_STAGE(PG8_SB(0, 0), b2, voffB); PG8_STAGE(PG8_SB(0, 1), b2 + hstep, voffB); PG8_STAGE(PG8_SA(0, 0), a2, voffA);
            PG8_WAIT_V(8); PG8_WAIT_L(0); PG8_BAR; PG8_MMA(1, 0, At, B0); PG8_MMA(1, 1, At, B1); PG8_BAR; PG8_SCHED;
            PG8_LDB(B0, 1, 0); PG8_LDB(B1, 1, 1); PG8_SCHED; PG8_LDA(At, 1, 0); PG8_STAGE(PG8_SA(0, 1), a2 + hstep, voffA);
            PG8_WAIT_V(8); PG8_WAIT_L(0); PG8_BAR; PG8_MMA(0, 0, At, B0); PG8_MMA(0, 1, At, B1); PG8_BAR; PG8_SCHED;
            PG8_LDA(At, 1, 1); PG8_STAGE(PG8_SB(1, 0), b3, voffB); PG8_STAGE(PG8_SB(1, 1), b3 + hstep, voffB); PG8_STAGE(PG8_SA(1, 0), a3, voffA);
            PG8_WAIT_V(8); PG8_WAIT_L(0); PG8_BAR; PG8_MMA(1, 0, At, B0); PG8_MMA(1, 1, At, B1); PG8_BAR; PG8_SCHED;
        }
        if (wr == 0) PG8_BAR;
        E(acc, cur, wr, wc, fr, fq);
        if (!has_next) break;
#pragma unroll
        for (int a = 0; a < 2; ++a)
#pragma unroll
            for (int b = 0; b < 2; ++b)
#pragma unroll
                for (int m = 0; m < 4; ++m)
#pragma unroll
                    for (int n = 0; n < 2; ++n) acc[a][b][m][n] = (f32x4){0.f, 0.f, 0.f, 0.f};
        cur = nxt; cA = nA; cB = nB; ++ui;
        if (wr == 1) PG8_BAR;
    }
    PG8_WAIT_V(0);
    PG8_BAR;
#undef PG8_SA
#undef PG8_SB
#undef PG8_STAGE
#undef PG8_LDA
#undef PG8_LDB
#undef PG8_MMA
}

constexpr int KROW = 144, VROW = 136;
constexpr int L_KB = 0, L_VB = 2 * 64 * KROW, L_FB = L_VB + 2 * 64 * VROW, L_RELB = L_FB + 512, L_OST = L_RELB + 1280, L_UW = L_OST + 8 * 32 * KROW, L_ATT_END = L_UW + 8 * 128 * 4;
static_assert(L_ATT_END <= LDS_BYTES, "lds");
constexpr float TH_DEFER = 8.0f;
constexpr float PRUNE_NAT = 60.0f;

template <int MODE>
__device__ __forceinline__ void attn_unit(const bf16_t* __restrict__ QKVZ, const bf16_t* __restrict__ VT, const float* __restrict__ aux,
                                          bf16_t* __restrict__ G, int b, int h, int qb, int jlo, const float* __restrict__ nrm) {
    unsigned char* lds = g_shm;
    int tid = threadIdx.x; asm volatile("" : "+v"(tid));
    const int w = tid >> 6, lane = tid & 63, q = lane & 31, hh = lane >> 5;
    const int r0 = qb * 256 + w * 32, t = r0 + q;
    const int jhi = qb * 4 + 3, cw = qb * 4 + (w >> 1);
    const int lrow = tid >> 3, lch = tid & 7;
    const bf16_t* kbase = QKVZ + ((long)(b * SEQ + lrow)) * 4096 + 1024 + h * 64 + lch * 8;
    const bf16_t* vbase = VT + ((long)((b * NH + h) * 64 + lrow)) * SEQ + lch * 8;
    const float* fbase = aux + (long)(b * NH + h) * SEQ;
    constexpr float SC = 0.125f * LOG2E;

    __syncthreads();
    bf16x8 qf[4];
    {
        const bf16_t* qp = QKVZ + ((long)(b * SEQ + t)) * 4096 + h * 64 + hh * 8;
#pragma unroll
        for (int ks = 0; ks < 4; ++ks) qf[ks] = *(const bf16x8*)(qp + ks * 16);
    }
    float Ft = 0.f;
    if (MODE == 1) Ft = fbase[t] * LOG2E;
    u32x4 k0r, v0r, k1r, v1r, k2r, v2r; float f0r = 0.f, f1r = 0.f, f2r = 0.f;
    k0r = *(const u32x4*)(kbase + (long)jhi * 64 * 4096);       v0r = *(const u32x4*)(vbase + jhi * 64);
    k1r = *(const u32x4*)(kbase + (long)(jhi - 1) * 64 * 4096); v1r = *(const u32x4*)(vbase + (jhi - 1) * 64);
    k2r = *(const u32x4*)(kbase + (long)(jhi - 2) * 64 * 4096); v2r = *(const u32x4*)(vbase + (jhi - 2) * 64);
    if (MODE == 1) { if (tid < 64) { f0r = fbase[jhi * 64 + tid]; f1r = fbase[(jhi - 1) * 64 + tid]; f2r = fbase[(jhi - 2) * 64 + tid]; } }
    u32x4 zpre[4];
#pragma unroll
    for (int i = 0; i < 4; ++i) zpre[i] = *(const u32x4*)(QKVZ + (long)(b * SEQ + r0 + (lane >> 3) + 8 * i) * 4096 + 3072 + h * 64 + (lane & 7) * 8);
    if (MODE == 1) {
        int* JL = (int*)(lds + L_RELB);
        const float* NQ = nrm + ((long)(b * 128)) * 32 + 2 * h;
        const float* NK = nrm + ((long)(1024 + b * 128)) * 32 + 2 * h;
        float Qa = 0.f, Qb = 0.f, Bd = 0.f;
#pragma unroll
        for (int i = 0; i < 4; ++i) { Qa = fmaxf(Qa, sqrtf(ld_coh(NQ + (4 * qb + i) * 32))); Qb = fmaxf(Qb, sqrtf(ld_coh(NQ + (4 * qb + i) * 32 + 1))); }
#pragma unroll
        for (int i = 0; i < 4; ++i) Bd = fmaxf(Bd, Qa * sqrtf(ld_coh(NK + (4 * qb + i) * 32)) + Qb * sqrtf(ld_coh(NK + (4 * qb + i) * 32 + 1)));
        if (tid == 0) *JL = 4 * qb;
        __syncthreads();
        if (tid < 4 * qb) {
            const float Bj = Qa * sqrtf(ld_coh(NK + tid * 32)) + Qb * sqrtf(ld_coh(NK + tid * 32 + 1));
            const float Dj = ld_coh(fbase + 256 * qb) - ld_coh(fbase + 64 * tid + 63);
            if (!((Bj + Bd) * 0.125f + Dj < -PRUNE_NAT)) atomicMin(JL, tid);
        }
        __syncthreads();
        jlo = *JL;
        float* UW = (float*)(lds + L_UW) + w * 128;
        const float qa = sqrtf(ld_coh(NQ + cw * 32)), qbb = sqrtf(ld_coh(NQ + cw * 32 + 1));
        const float Fr0 = ld_coh(fbase + r0);
        for (int jr = lane; jr < cw - jlo; jr += 64) {
            const int j = jlo + jr;
            const float ka = sqrtf(ld_coh(NK + j * 32)), kb = sqrtf(ld_coh(NK + j * 32 + 1));
            UW[jr] = (qa * ka + qbb * kb) * SC + (Fr0 - ld_coh(fbase + 64 * j + 63)) * LOG2E;
        }
    }
    if (MODE == 0) { if (tid < 257) ((float*)(lds + L_RELB))[tid] = aux[h * 257 + tid] * LOG2E; }

    f32x16 O0, O1;
#pragma unroll
    for (int i = 0; i < 16; ++i) { O0[i] = 0.f; O1[i] = 0.f; }
    float m_run = 0.f, l_run = 0.f, m_min = -1e30f;
    bool first = true;

    auto LOADT = [&](u32x4& kr, u32x4& vr, float& fr_, int jj) __attribute__((always_inline)) {
        if (jj >= jlo) {
            kr = *(const u32x4*)(kbase + (long)jj * 64 * 4096);
            vr = *(const u32x4*)(vbase + jj * 64);
            if (MODE == 1) { if (tid < 64) fr_ = fbase[jj * 64 + tid]; }
        }
    };
    auto STEP = [&](u32x4& kreg, u32x4& vreg, float& freg, int j) __attribute__((always_inline)) {
        const int buf = (jhi - j) & 1;
        unsigned char* KB = lds + L_KB + buf * 64 * KROW;
        unsigned char* VB = lds + L_VB + buf * 64 * VROW;
        float* FB = (float*)(lds + L_FB + buf * 256);
        *(u32x4*)(KB + lrow * KROW + lch * 16) = kreg;
        *(u32x2*)(VB + lrow * VROW + lch * 16) = (u32x2){vreg.x, vreg.y};
        *(u32x2*)(VB + lrow * VROW + lch * 16 + 8) = (u32x2){vreg.z, vreg.w};
        if (MODE == 1) { if (tid < 64) FB[tid] = freg * LOG2E; }
        __syncthreads();
        LOADT(kreg, vreg, freg, j - 3);
        bool active;
        if (MODE == 0) active = (j >= cw - 8 && j <= cw);
        else {
            active = (j <= cw);
            if (j < cw) { const float ub = ((const float*)(lds + L_UW))[w * 128 + (j - jlo)]; if (ub - m_min < -PRUNE_NAT * LOG2E) active = false; }
        }
        if (active) {
            f32x16 s0, s1;
#pragma unroll
            for (int i = 0; i < 16; ++i) { s0[i] = 0.f; s1[i] = 0.f; }
#pragma unroll
            for (int ks = 0; ks < 4; ++ks) {
                const bf16x8 k0 = *(const bf16x8*)(KB + q * KROW + (16 * ks + 8 * hh) * 2);
                const bf16x8 k1 = *(const bf16x8*)(KB + (32 + q) * KROW + (16 * ks + 8 * hh) * 2);
                s0 = __builtin_amdgcn_mfma_f32_32x32x16_bf16(k0, qf[ks], s0, 0, 0, 0);
                s1 = __builtin_amdgcn_mfma_f32_32x32x16_bf16(k1, qf[ks], s1, 0, 0, 0);
            }
            if (MODE == 0) {
                const float* RB = (const float*)(lds + L_RELB);
                if (r0 - (64 * j + 63) >= 128) {
                    const float cb = RB[256] - m_run;
#pragma unroll
                    for (int i = 0; i < 16; ++i) { s0[i] = s0[i] * SC + cb; s1[i] = s1[i] * SC + cb; }
                } else {
#pragma unroll
                    for (int i = 0; i < 16; ++i) {
                        const int kl = (i & 3) + 8 * (i >> 2) + 4 * hh;
                        int rel0 = t - (64 * j + kl), rel1 = rel0 - 32;
                        rel0 = rel0 < -128 ? -128 : (rel0 > 128 ? 128 : rel0);
                        rel1 = rel1 < -128 ? -128 : (rel1 > 128 ? 128 : rel1);
                        s0[i] = s0[i] * SC + (RB[rel0 + 128] - m_run);
                        s1[i] = s1[i] * SC + (RB[rel1 + 128] - m_run);
                    }
                }
            } else {
                const bool diag = (j == cw);
                const float base = Ft - m_run;
#pragma unroll
                for (int g = 0; g < 4; ++g) {
                    const f32x4 f0 = *(const f32x4*)(FB + 8 * g + 4 * hh);
                    const f32x4 f1 = *(const f32x4*)(FB + 32 + 8 * g + 4 * hh);
#pragma unroll
                    for (int e = 0; e < 4; ++e) {
                        const int i = 4 * g + e;
                        float x0 = s0[i] * SC + (base - f0[e]);
                        float x1 = s1[i] * SC + (base - f1[e]);
                        if (diag) {
                            const int sp = 64 * j + 8 * g + 4 * hh + e;
                            if (sp > t) x0 = -1e30f;
                            if (sp + 32 > t) x1 = -1e30f;
                        }
                        s0[i] = x0; s1[i] = x1;
                    }
                }
            }
            float mx = s0[0];
#pragma unroll
            for (int i = 1; i < 16; ++i) mx = fmaxf(mx, s0[i]);
#pragma unroll
            for (int i = 0; i < 16; ++i) mx = fmaxf(mx, s1[i]);
            if (first || __any(mx > TH_DEFER)) {
                mx = fmaxf(mx, __shfl_xor(mx, 32));
                float d;
                if (first) { d = mx; }
                else {
                    d = fmaxf(mx, 0.f);
                    const float al = __builtin_amdgcn_exp2f(-d);
                    l_run *= al;
#pragma unroll
                    for (int i = 0; i < 16; ++i) { O0[i] *= al; O1[i] *= al; }
                }
                m_run += d;
#pragma unroll
                for (int i = 0; i < 16; ++i) { s0[i] -= d; s1[i] -= d; }
                first = false;
                if (MODE == 1) {
                    float mm = m_run;
#pragma unroll
                    for (int o = 32; o >= 1; o >>= 1) mm = fminf(mm, __shfl_xor(mm, o));
                    m_min = mm;
                }
            }
            float ps = 0.f;
#pragma unroll
            for (int i = 0; i < 16; ++i) { s0[i] = __builtin_amdgcn_exp2f(s0[i]); s1[i] = __builtin_amdgcn_exp2f(s1[i]); ps += s0[i] + s1[i]; }
            l_run += ps;
#pragma unroll
            for (int s = 0; s < 4; ++s) {
                u32x4 pw;
                if (s < 2) { pw.x = cvt_pk_bf16(s0[8 * s + 0], s0[8 * s + 1]); pw.y = cvt_pk_bf16(s0[8 * s + 2], s0[8 * s + 3]); pw.z = cvt_pk_bf16(s0[8 * s + 4], s0[8 * s + 5]); pw.w = cvt_pk_bf16(s0[8 * s + 6], s0[8 * s + 7]); }
                else { const int sp = s - 2; pw.x = cvt_pk_bf16(s1[8 * sp + 0], s1[8 * sp + 1]); pw.y = cvt_pk_bf16(s1[8 * sp + 2], s1[8 * sp + 3]); pw.z = cvt_pk_bf16(s1[8 * sp + 4], s1[8 * sp + 5]); pw.w = cvt_pk_bf16(s1[8 * sp + 6], s1[8 * sp + 7]); }
                const bf16x8 pf = __builtin_bit_cast(bf16x8, pw);
                {
                    const u32x2 lo = *(const u32x2*)(VB + q * VROW + (16 * s + 4 * hh) * 2);
                    const u32x2 hi = *(const u32x2*)(VB + q * VROW + (16 * s + 8 + 4 * hh) * 2);
                    const bf16x8 vf = __builtin_bit_cast(bf16x8, ((u32x4){lo.x, lo.y, hi.x, hi.y}));
                    O0 = __builtin_amdgcn_mfma_f32_32x32x16_bf16(vf, pf, O0, 0, 0, 0);
                }
                {
                    const u32x2 lo = *(const u32x2*)(VB + (32 + q) * VROW + (16 * s + 4 * hh) * 2);
                    const u32x2 hi = *(const u32x2*)(VB + (32 + q) * VROW + (16 * s + 8 + 4 * hh) * 2);
                    const bf16x8 vf = __builtin_bit_cast(bf16x8, ((u32x4){lo.x, lo.y, hi.x, hi.y}));
                    O1 = __builtin_amdgcn_mfma_f32_32x32x16_bf16(vf, pf, O1, 0, 0, 0);
                }
            }
        }
    };
    for (int j = jhi; j >= jlo; j -= 3) {
        STEP(k0r, v0r, f0r, j);
        if (j - 1 >= jlo) STEP(k1r, v1r, f1r, j - 1);
        if (j - 2 >= jlo) STEP(k2r, v2r, f2r, j - 2);
    }
    const float lt = l_run + __shfl_xor(l_run, 32);
    const float inv = 1.0f / lt;
    unsigned char* OST = lds + L_OST + w * 32 * KROW;
#pragma unroll
    for (int g = 0; g < 4; ++g) {
        u32x2 w0, w1;
        w0.x = cvt_pk_bf16(O0[4 * g + 0] * inv, O0[4 * g + 1] * inv); w0.y = cvt_pk_bf16(O0[4 * g + 2] * inv, O0[4 * g + 3] * inv);
        w1.x = cvt_pk_bf16(O1[4 * g + 0] * inv, O1[4 * g + 1] * inv); w1.y = cvt_pk_bf16(O1[4 * g + 2] * inv, O1[4 * g + 3] * inv);
        *(u32x2*)(OST + q * KROW + (8 * g + 4 * hh) * 2) = w0;
        *(u32x2*)(OST + q * KROW + (32 + 8 * g + 4 * hh) * 2) = w1;
    }
    __syncthreads();
#pragma unroll
    for (int i = 0; i < 4; ++i) {
        const int row = (lane >> 3) + 8 * i, ch = lane & 7;
        const u32x4 o8 = *(const u32x4*)(OST + row * KROW + ch * 16);
        const long tok = (long)(b * SEQ + r0 + row);
        const u32x4 z8 = zpre[i];
        u32x4 r8;
#pragma unroll
        for (int e = 0; e < 4; ++e) {
            const unsigned ou = o8[e], zu = z8[e];
            const float z0 = bf_lo(zu), z1 = bf_hi(zu);
            const float g0 = bf_lo(ou) * z0 / (1.0f + __expf(-z0));
            const float g1 = bf_hi(ou) * z1 / (1.0f + __expf(-z1));
            r8[e] = cvt_pk_bf16(g0, g1);
        }
        *(u32x4*)(G + tok * 1024 + h * 64 + ch * 8) = r8;
    }
}

__device__ __forceinline__ void transpose_w(const float* __restrict__ src, int N, bf16_t* __restrict__ dst, int tile) {
    float* T = (float*)g_shm;
    int tid = threadIdx.x; asm volatile("" : "+v"(tid));
    const int ntn = N / 64, kt = tile / ntn, ntl = tile % ntn, k0 = kt * 64, n0 = ntl * 64;
    __syncthreads();
#pragma unroll
    for (int e = 0; e < 8; ++e) { const int idx = tid + 512 * e, kk = idx >> 6, nn = idx & 63; T[kk * 65 + nn] = src[(long)(k0 + kk) * N + n0 + nn]; }
    __syncthreads();
#pragma unroll
    for (int e = 0; e < 4; ++e) { const int idx = tid + 512 * e, nn = idx >> 5, kp = idx & 31;
        *(unsigned*)(dst + (long)(n0 + nn) * 1024 + k0 + 2 * kp) = cvt_pk_bf16(T[(2 * kp) * 65 + nn], T[(2 * kp + 1) * 65 + nn]); }
}

__device__ __forceinline__ float log_sigmoid(float z) { return fminf(z, 0.f) - log1pf(expf(-fabsf(z))); }

__device__ __forceinline__ void ln_phase(float* __restrict__ io, bf16_t* __restrict__ XB, const float* __restrict__ g, const float* __restrict__ bta,
                                         const float* __restrict__ wf, const float* __restrict__ bf, float* __restrict__ LOGF) {
    int tid = threadIdx.x; asm volatile("" : "+v"(tid));
    const int w = tid >> 6, lane = tid & 63;
    f32x4* WF = (f32x4*)g_shm;
    if (wf) {
        __syncthreads();
        for (int idx = tid; idx < 4096; idx += 512) {
            const int ln = idx & 63, hq = (idx >> 6) & 3, ie = idx >> 8, k = 4 * (ln + 64 * (ie >> 2)) + (ie & 3);
            WF[idx] = *(const f32x4*)(wf + k * 16 + 4 * hq);
        }
        __syncthreads();
    }
    f32x4 gv[4], bv[4];
#pragma unroll
    for (int i = 0; i < 4; ++i) { gv[i] = *(const f32x4*)(g + 4 * (lane + 64 * i)); bv[i] = *(const f32x4*)(bta + 4 * (lane + 64 * i)); }
    const int G_ = gridDim.x, c_ = blockIdx.x;
    const int nri = (c_ < 256) ? ((256 - c_ + G_ - 1) / G_) * 32 : 0;
    auto row_of = [&](int ri) __attribute__((always_inline)) { return (c_ + (ri >> 5) * G_) * 256 + w + 8 * (ri & 31); };
    f32x4 nv[4];
    if (nri > 0) {
        const int row = row_of(0);
#pragma unroll
        for (int i = 0; i < 4; ++i) nv[i] = *(const f32x4*)(io + (long)row * 1024 + 4 * (lane + 64 * i));
    }
    for (int ri = 0; ri < nri; ++ri) {
        const int row = row_of(ri);
        float* rp = io + (long)row * 1024;
        f32x4 v[4];
#pragma unroll
        for (int i = 0; i < 4; ++i) v[i] = nv[i];
        if (ri + 1 < nri) {
            const int nrow = row_of(ri + 1);
#pragma unroll
            for (int i = 0; i < 4; ++i) nv[i] = *(const f32x4*)(io + (long)nrow * 1024 + 4 * (lane + 64 * i));
        }
        float s = 0.f;
#pragma unroll
        for (int i = 0; i < 4; ++i) s += (v[i][0] + v[i][1]) + (v[i][2] + v[i][3]);
#pragma unroll
        for (int o = 32; o >= 1; o >>= 1) s += __shfl_xor(s, o);
        const float mu = s * (1.0f / 1024.0f);
        float qs = 0.f;
#pragma unroll
        for (int i = 0; i < 4; ++i) { v[i] = v[i] - mu; qs += (v[i][0] * v[i][0] + v[i][1] * v[i][1]) + (v[i][2] * v[i][2] + v[i][3] * v[i][3]); }
#pragma unroll
        for (int o = 32; o >= 1; o >>= 1) qs += __shfl_xor(qs, o);
        const float rstd = 1.0f / sqrtf(qs * (1.0f / 1024.0f) + LN_EPS);
#pragma unroll
        for (int i = 0; i < 4; ++i) {
            v[i] = v[i] * rstd * gv[i] + bv[i];
            *(f32x4*)(rp + 4 * (lane + 64 * i)) = v[i];
            if (XB) { u32x2 pk; pk.x = cvt_pk_bf16(v[i][0], v[i][1]); pk.y = cvt_pk_bf16(v[i][2], v[i][3]);
                *(u32x2*)(XB + (long)row * 1024 + 4 * (lane + 64 * i)) = pk; }
        }
        if (wf) {
            float a[16];
#pragma unroll
            for (int c = 0; c < 16; ++c) a[c] = 0.f;
#pragma unroll
            for (int i = 0; i < 4; ++i)
#pragma unroll
                for (int e = 0; e < 4; ++e) {
                    const float xv = v[i][e];
#pragma unroll
                    for (int hq = 0; hq < 4; ++hq) {
                        const f32x4 w4 = WF[((i * 4 + e) * 4 + hq) * 64 + lane];
                        a[4 * hq + 0] += xv * w4[0]; a[4 * hq + 1] += xv * w4[1]; a[4 * hq + 2] += xv * w4[2]; a[4 * hq + 3] += xv * w4[3];
                    }
                }
#pragma unroll
            for (int i = 0; i < 8; ++i) { const bool up = (lane & 32) != 0; const float send = up ? a[i] : a[i + 8], keep = up ? a[i + 8] : a[i]; a[i] = keep + __shfl_xor(send, 32); }
#pragma unroll
            for (int i = 0; i < 4; ++i) { const bool up = (lane & 16) != 0; const float send = up ? a[i] : a[i + 4], keep = up ? a[i + 4] : a[i]; a[i] = keep + __shfl_xor(send, 16); }
#pragma unroll
            for (int i = 0; i < 2; ++i) { const bool up = (lane & 8) != 0; const float send = up ? a[i] : a[i + 2], keep = up ? a[i + 2] : a[i]; a[i] = keep + __shfl_xor(send, 8); }
            { const bool up = (lane & 4) != 0; const float send = up ? a[0] : a[1], keep = up ? a[1] : a[0]; a[0] = keep + __shfl_xor(send, 4); }
            a[0] += __shfl_xor(a[0], 2); a[0] += __shfl_xor(a[0], 1);
            if ((lane & 3) == 0) {
                const int hd = ((lane >> 5) & 1) * 8 + ((lane >> 4) & 1) * 4 + ((lane >> 3) & 1) * 2 + ((lane >> 2) & 1);
                const int bb = row / SEQ, ss = row % SEQ;
                LOGF[((long)(bb * NH + hd)) * SEQ + ss] = log_sigmoid(a[0] + bf[hd]);
            }
        }
    }
}

__device__ __forceinline__ void scan_phase(float* __restrict__ F) {
    float* red = (float*)g_shm;
    int tid = threadIdx.x; asm volatile("" : "+v"(tid));
    const int w = tid >> 6, lane = tid & 63;
    for (int bh = blockIdx.x; bh < NB * NH; bh += gridDim.x) {
        float* p = F + (long)bh * SEQ + tid * 16;
        f32x4 v[4];
#pragma unroll
        for (int i = 0; i < 4; ++i) v[i] = *(const f32x4*)(p + 4 * i);
        float run = 0.f;
#pragma unroll
        for (int i = 0; i < 4; ++i)
#pragma unroll
            for (int e = 0; e < 4; ++e) { run += v[i][e]; v[i][e] = run; }
        float inc = run;
#pragma unroll
        for (int o = 1; o < 64; o <<= 1) { const float y = __shfl_up(inc, o); if (lane >= o) inc += y; }
        __syncthreads();
        if (lane == 63) red[w] = inc;
        __syncthreads();
        float base = inc - run;
        for (int ww = 0; ww < w; ++ww) base += red[ww];
#pragma unroll
        for (int i = 0; i < 4; ++i) { v[i] = v[i] + base; *(f32x4*)(p + 4 * i) = v[i]; }
    }
}

__device__ __forceinline__ void grid_bar(unsigned* ctr, unsigned target) {
    __syncthreads();
    if (threadIdx.x == 0) {
        __builtin_amdgcn_fence(__ATOMIC_RELEASE, "agent");
        __hip_atomic_fetch_add(ctr, 1u, __ATOMIC_RELAXED, __HIP_MEMORY_SCOPE_AGENT);
        while (__hip_atomic_load(ctr, __ATOMIC_RELAXED, __HIP_MEMORY_SCOPE_AGENT) < target) __builtin_amdgcn_s_sleep(4);
        __builtin_amdgcn_fence(__ATOMIC_ACQUIRE, "agent");
    }
    __syncthreads();
}

__global__ void __launch_bounds__(512, 2) fwd_megakernel(Params p) {
    cg::grid_group grid = cg::this_grid();
    bf16_t* XB = (bf16_t*)(p.ws + WS_XB);
    bf16_t* QKVZ = (bf16_t*)(p.ws + WS_QKVZ);
    bf16_t* VT = (bf16_t*)(p.ws + WS_VT);
    bf16_t* G = (bf16_t*)(p.ws + WS_G);
    bf16_t* WIN = (bf16_t*)(p.ws + WS_WIN);
    bf16_t* WOUT = (bf16_t*)(p.ws + WS_WOUT);
    float* F = (float*)(p.ws + WS_F);
    float* NRM = (float*)(p.ws + WS_NRM);
    unsigned* CTR = (unsigned*)(p.ws + WS_CTR);
    unsigned bar_gen = 0;
#define GRID_BAR() do { ++bar_gen; grid_bar(CTR, bar_gen * gridDim.x); } while (0)
    const int tid = threadIdx.x;
    LAS unsigned char* lds = (LAS unsigned char*)g_shm;

    if (blockIdx.x == 0 && tid == 0) __hip_atomic_store(CTR, 0u, __ATOMIC_RELAXED, __HIP_MEMORY_SCOPE_AGENT);
    {
        const long nvec = (long)MTOK * 1024 / 8;
#pragma unroll 4
        for (long i = (long)blockIdx.x * 512 + tid; i < nvec; i += (long)gridDim.x * 512) {
            const f32x4 a = *(const f32x4*)(p.x + i * 8), c = *(const f32x4*)(p.x + i * 8 + 4);
            u32x4 o; o.x = cvt_pk_bf16(a[0], a[1]); o.y = cvt_pk_bf16(a[2], a[3]); o.z = cvt_pk_bf16(c[0], c[1]); o.w = cvt_pk_bf16(c[2], c[3]);
            *(u32x4*)(XB + i * 8) = o;
        }
        for (int u = blockIdx.x; u < DEPTH * 1280; u += gridDim.x) {
            const int l = u / 1280, tl = u % 1280;
            if (tl < 1024) {
                const float* src = ((l & 1) ? p.w_in_b : p.w_in_a) + (long)(l >> 1) * 1024 * 4096;
                transpose_w(src, 4096, WIN + (long)l * 4096 * 1024, tl);
            } else {
                const float* src = ((l & 1) ? p.w_out_b : p.w_out_a) + (long)(l >> 1) * 1024 * 1024;
                transpose_w(src, 1024, WOUT + (long)l * 1024 * 1024, tl - 1024);
            }
        }
    }
    grid.sync();

#pragma unroll 1
    for (int layer = 0; layer < DEPTH; ++layer) {
        const bool isB = (layer & 1) != 0;
        const bf16_t* Wi = WIN + (long)layer * 4096 * 1024;
        const bf16_t* Wo = WOUT + (long)layer * 1024 * 1024;
        if (isB) scan_phase(F);
        {
            Sched S; S.mode = 0; S.XB = (const char*)XB; S.W = (const char*)Wi; S.G = gridDim.x; S.c = blockIdx.x;
            Epi E; E.mode = 0; E.QKVZ = QKVZ; E.VT = VT; E.xin = nullptr; E.of = nullptr; E.nrm = isB ? NRM : nullptr;
            __syncthreads();
            gemm_phase(lds, S, E);
        }
        GRID_BAR();
        for (int u = blockIdx.x; u < 4096; u += gridDim.x) {
            const int c = u & 255, i = u >> 8, bh = i * 8 + (c & 7);
            int qb = c >> 3;
            if (isB && (i & 1)) qb = 31 - qb;
            const int b = bh >> 4, h = bh & 15;
            if (!isB) attn_unit<0>(QKVZ, VT, p.rel_bias_a + (long)(layer >> 1) * NH * 257, G, b, h, qb, (qb * 4 - 8) > 0 ? (qb * 4 - 8) : 0, nullptr);
            else attn_unit<1>(QKVZ, VT, F, G, b, h, qb, 0, NRM);
        }
        GRID_BAR();
        {
            Sched S; S.mode = 1; S.XB = (const char*)G; S.W = (const char*)Wo; S.G = gridDim.x; S.c = blockIdx.x;
            Epi E; E.mode = 1; E.QKVZ = nullptr; E.VT = nullptr; E.xin = (layer == 0) ? p.x : p.out; E.of = p.out; E.nrm = nullptr;
            __syncthreads();
            gemm_phase(lds, S, E);
        }
        __syncthreads();
        {
            const bool nextB = (layer + 1 < DEPTH) && ((layer + 1) & 1);
            const int jn = (layer + 1) >> 1;
            ln_phase(p.out, (layer + 1 < DEPTH) ? XB : nullptr, p.ln_g + layer * 1024, p.ln_b + layer * 1024,
                     nextB ? p.w_f_b + (long)jn * 1024 * 16 : nullptr, nextB ? p.b_f_b + jn * 16 : nullptr, F);
        }
        if (layer + 1 < DEPTH) GRID_BAR();
    }
}

extern "C" void kernel_launch(void* const* d_in, const int* in_sizes, int n_in, void* d_out, int out_size, void* d_ws, size_t ws_size, hipStream_t stream) {
    static int grid_blocks = 0;
    if (grid_blocks == 0) {
        if (ws_size < WS_END) { fprintf(stderr, "kernel_launch: workspace too small (%zu < %zu)\n", ws_size, (size_t)WS_END); grid_blocks = -1; return; }
        int dev = 0, cus = 0, per_cu = 0;
        hipGetDevice(&dev);
        hipDeviceGetAttribute(&cus, hipDeviceAttributeMultiprocessorCount, dev);
        hipFuncSetAttribute((const void*)fwd_megakernel, hipFuncAttributeMaxDynamicSharedMemorySize, LDS_BYTES);
        hipOccupancyMaxActiveBlocksPerMultiprocessor(&per_cu, (const void*)fwd_megakernel, 512, LDS_BYTES);
        if (per_cu < 1) { fprintf(stderr, "kernel_launch: occupancy query says %d blocks per CU\n", per_cu); per_cu = 1; }
        grid_blocks = cus * 1;
        (void)hipGetLastError();
    }
    if (grid_blocks < 0) return;
    Params p{};
    p.x = (const float*)d_in[0]; p.w_in_a = (const float*)d_in[1]; p.rel_bias_a = (const float*)d_in[2]; p.w_out_a = (const float*)d_in[3];
    p.w_in_b = (const float*)d_in[4]; p.w_f_b = (const float*)d_in[5]; p.b_f_b = (const float*)d_in[6]; p.w_out_b = (const float*)d_in[7];
    p.ln_g = (const float*)d_in[8]; p.ln_b = (const float*)d_in[9];
    p.out = (float*)d_out; p.ws = (unsigned char*)d_ws;
    void* args[] = {&p};
    hipError_t e = hipLaunchCooperativeKernel((const void*)fwd_megakernel, dim3(grid_blocks), dim3(512), args, LDS_BYTES, stream);
    if (e != hipSuccess) fprintf(stderr, "cooperative launch failed: %s (grid %d)\n", hipGetErrorString(e), grid_blocks);
}
```

```cpp
#include <hip/hip_runtime.h>
#include <hip/hip_cooperative_groups.h>
#include <cstdio>
#include <cstdint>
namespace cg = cooperative_groups;

typedef unsigned short bf16_t;
typedef short bf16x8 __attribute__((ext_vector_type(8)));
typedef float f32x4 __attribute__((ext_vector_type(4)));
typedef float f32x16 __attribute__((ext_vector_type(16)));
typedef unsigned u32x4 __attribute__((ext_vector_type(4)));
typedef unsigned u32x2 __attribute__((ext_vector_type(2)));

constexpr int DM = 1024, NB = 8, SEQ = 8192, MTOK = NB * SEQ, NH = 16, DEPTH = 4;
constexpr float LN_EPS = 1e-5f;
constexpr float ALPHA = 1.681792830507429f;
constexpr float LOG2E = 1.4426950408889634f;
constexpr int LDS_BYTES = 131072;

constexpr size_t WS_XB = 0;
constexpr size_t WS_QKVZ = WS_XB + (size_t)MTOK * 1024 * 2;
constexpr size_t WS_VT = WS_QKVZ + (size_t)MTOK * 4096 * 2;
constexpr size_t WS_G = WS_VT + (size_t)MTOK * 1024 * 2;
constexpr size_t WS_WIN = WS_G + (size_t)MTOK * 1024 * 2;
constexpr size_t WS_WOUT = WS_WIN + (size_t)DEPTH * 4096 * 1024 * 2;
constexpr size_t WS_F = WS_WOUT + (size_t)DEPTH * 1024 * 1024 * 2;
constexpr size_t WS_NRM = WS_F + (size_t)NB * NH * SEQ * 4;
constexpr size_t WS_CTR = WS_NRM + (size_t)2 * 1024 * 128 * 4;
constexpr size_t WS_END = WS_CTR + 256;

extern __shared__ __attribute__((aligned(16))) unsigned char g_shm[];

struct Params {
    const float* x; const float* w_in_a; const float* rel_bias_a; const float* w_out_a;
    const float* w_in_b; const float* w_f_b; const float* b_f_b; const float* w_out_b;
    const float* ln_g; const float* ln_b;
    float* out; unsigned char* ws;
};

typedef __bf16 bf16x2_t __attribute__((ext_vector_type(2)));
typedef float f32x2_t __attribute__((ext_vector_type(2)));
__device__ __forceinline__ unsigned cvt_pk_bf16(float lo, float hi) { const f32x2_t v = {lo, hi}; const bf16x2_t r = __builtin_convertvector(v, bf16x2_t); return __builtin_bit_cast(unsigned, r); }
__device__ __forceinline__ float ld_coh(const float* p) { return __hip_atomic_load(p, __ATOMIC_RELAXED, __HIP_MEMORY_SCOPE_AGENT); }
template <int CTRL> __device__ __forceinline__ float dpp_f(float v) { return __int_as_float(__builtin_amdgcn_update_dpp(0, __float_as_int(v), CTRL, 0xf, 0xf, false)); }
__device__ __forceinline__ float bf_lo(unsigned u) { return __uint_as_float(u << 16); }
__device__ __forceinline__ float bf_hi(unsigned u) { return __uint_as_float(u & 0xffff0000u); }

#define LAS __attribute__((address_space(3)))
constexpr int BK = 64, HALF = 128, HTB = HALF * BK * 2, GK = 1024;
__device__ __forceinline__ int lds_byte(int r, int c) { const int st = (r >> 4) * 2 + (c >> 5), rr = r & 15, cc = c & 31, ob = rr * 64 + cc * 2; return st * 1024 + (ob ^ (((ob >> 9) & 1) << 5)); }
__device__ __forceinline__ void stage_rc(int b, int& R, int& C) { const int st = b / 1024, sb = b % 1024, swz = sb ^ (((sb >> 9) & 1) << 5); R = (st >> 1) * 16 + swz / 64; C = (st & 1) * 32 + (swz % 64) / 2; }
__device__ __forceinline__ int perm32(int rho) { const int n = rho >> 4, i = rho & 15; return 8 * (i >> 2) + 4 * n + (i & 3); }

__device__ __forceinline__ void tile_map(int L, int nM, int nN, int& pm, int& pn) {
    const int nwg = nM * nN; int wgid = L;
    { const int q = nwg / 8, r = nwg % 8, xcd = wgid % 8, off = wgid / 8; wgid = (xcd < r ? xcd * (q + 1) : r * (q + 1) + (xcd - r) * q) + off; }
    const int nig = 8 * nN, gid = wgid / nig, fm = gid * 8, gsz = (nM - fm) < 8 ? (nM - fm) : 8;
    pm = fm + ((wgid % nig) % gsz); pn = (wgid % nig) / gsz;
}

struct Unit { int pm, pn; };
constexpr size_t TSTEP = (size_t)256 * GK * 2;
struct Sched {
    int mode;
    const char* XB; const char* W; int G, c;
    __device__ __forceinline__ bool next(int i, Unit& u) const {
        if (mode == 1) { const int panel = c + (i >> 2) * G; if (panel >= 256) return false; u.pm = panel; u.pn = i & 3; return true; }
        const long L = (long)i * G + c; if (L >= 4096) return false;
        tile_map((int)L, 256, 16, u.pm, u.pn); return true;
    }
    __device__ __forceinline__ bool vt(const Unit& u) const { return mode == 0 && u.pn >= 8 && u.pn < 12; }
    __device__ __forceinline__ const char* pA(const Unit& u) const { return vt(u) ? W + (size_t)u.pn * TSTEP : XB + (size_t)u.pm * TSTEP; }
    __device__ __forceinline__ const char* pB(const Unit& u) const { return vt(u) ? XB + (size_t)u.pm * TSTEP : W + (size_t)u.pn * TSTEP; }
};
struct Epi {
    int mode; bf16_t* QKVZ; bf16_t* VT; const float* xin; float* of; float* nrm;
    __device__ __forceinline__ void operator()(const f32x4 (&acc)[2][2][4][2], const Unit& u, int wr, int wc, int fr, int fq) const {
        if (mode == 0) {
            bf16_t* ob; long ldo;
            if (u.pn >= 8 && u.pn < 12) { ob = VT + ((long)((u.pm >> 5) * 1024 + (u.pn - 8) * 256)) * SEQ + (u.pm & 31) * 256; ldo = SEQ; }
            else { ob = QKVZ + (long)u.pm * 256 * 4096 + u.pn * 256; ldo = 4096; }
            if (nrm && u.pn < 8) {
                const int which = u.pn >> 2, pnl = u.pn & 3;
#pragma unroll
                for (int ai = 0; ai < 2; ++ai)
#pragma unroll
                    for (int bj = 0; bj < 2; ++bj) {
                        float mx = 0.f;
#pragma unroll
                        for (int m = 0; m < 4; ++m) {
                            const f32x4 v0 = acc[ai][bj][m][0], v1 = acc[ai][bj][m][1];
                            float s = (v0[0] * v0[0] + v0[1] * v0[1]) + (v0[2] * v0[2] + v0[3] * v0[3]) + (v1[0] * v1[0] + v1[1] * v1[1]) + (v1[2] * v1[2] + v1[3] * v1[3]);
                            s += __shfl_xor(s, 16); s += __shfl_xor(s, 32);
                            mx = fmaxf(mx, s);
                        }
                        mx = fmaxf(mx, dpp_f<0xB1>(mx)); mx = fmaxf(mx, dpp_f<0x4E>(mx)); mx = fmaxf(mx, dpp_f<0x141>(mx)); mx = fmaxf(mx, dpp_f<0x140>(mx));
                        if (fr == 0 && fq == 0) nrm[((long)which * 1024 + (u.pm * 4 + 2 * ai + wr)) * 32 + pnl * 8 + 4 * bj + wc] = mx * 1.02f;
                    }
            }
#pragma unroll
            for (int ai = 0; ai < 2; ++ai)
#pragma unroll
                for (int m = 0; m < 4; ++m) {
                    bf16_t* rp = ob + (long)(ai * HALF + wr * 64 + m * 16 + fr) * ldo + wc * 32 + fq * 8;
#pragma unroll
                    for (int bj = 0; bj < 2; ++bj) {
                        const f32x4 v0 = acc[ai][bj][m][0], v1 = acc[ai][bj][m][1];
                        u32x4 w; w.x = cvt_pk_bf16(v0[0], v0[1]); w.y = cvt_pk_bf16(v0[2], v0[3]); w.z = cvt_pk_bf16(v1[0], v1[1]); w.w = cvt_pk_bf16(v1[2], v1[3]);
                        *(u32x4*)(rp + bj * HALF) = w;
                    }
                }
        } else {
            const long o = (long)u.pm * 256 * 1024 + u.pn * 256;
#pragma unroll
            for (int ai = 0; ai < 2; ++ai)
#pragma unroll
                for (int m = 0; m < 4; ++m) {
                    const long ro = o + (long)(ai * HALF + wr * 64 + m * 16 + fr) * 1024 + wc * 32 + fq * 8;
#pragma unroll
                    for (int bj = 0; bj < 2; ++bj)
#pragma unroll
                        for (int n = 0; n < 2; ++n) {
                            const f32x4 xv = *(const f32x4*)(xin + ro + bj * HALF + n * 4);
                            const f32x4 r = xv * ALPHA + acc[ai][bj][m][n];
                            *(f32x4*)(of + ro + bj * HALF + n * 4) = r;
                        }
                }
        }
    }
};

__device__ __forceinline__ void gemm_phase(LAS unsigned char* lds, const Sched& S, const Epi& E) {
    int tid = threadIdx.x; asm volatile("" : "+v"(tid));
    const int wid = __builtin_amdgcn_readfirstlane(tid >> 6), lane = tid & 63, wr = wid >> 2, wc = wid & 3, fr = lane & 15, fq = lane >> 4;
    constexpr int K = GK, nt = K / BK;
    unsigned voffA[2], voffB[2];
#pragma unroll
    for (int i = 0; i < 2; ++i) { int R, C; stage_rc(tid * 16 + i * 8192, R, C); const int Rb = (R & ~31) + perm32(R & 31);
        voffA[i] = (unsigned)(R * K + C) * 2u; voffB[i] = (unsigned)(Rb * K + C) * 2u; }
    constexpr size_t kstep = (size_t)(BK * 2);
    constexpr size_t hstep = (size_t)HALF * K * 2;
    const unsigned ldsw = (unsigned)wid * 1024u;
    const int aoff = lds_byte(wr * 64 + fr, fq * 8), boff = lds_byte(wc * 32 + fr, fq * 8);
#define PG8_SA(b, h) (((b) * 2 + (h)) * HTB)
#define PG8_SB(b, h) ((4 + (b) * 2 + (h)) * HTB)
#define PG8_STAGE(bufoff, gbase, voff) do { _Pragma("unroll") for (int _i = 0; _i < 2; ++_i) \
        __builtin_amdgcn_global_load_lds((const unsigned*)((const char*)(gbase) + (voff)[_i]), (LAS unsigned*)(lds + (bufoff) + ldsw + _i * 8192), 16, 0, 0); } while (0)
#define PG8_LDA(dst, b, h) do { _Pragma("unroll") for (int m = 0; m < 4; ++m) _Pragma("unroll") for (int k = 0; k < 2; ++k) dst[m][k] = *(const LAS bf16x8*)(lds + PG8_SA(b, h) + aoff + m * 2048 + k * 1024); } while (0)
#define PG8_LDB(dst, b, h) do { _Pragma("unroll") for (int n = 0; n < 2; ++n) _Pragma("unroll") for (int k = 0; k < 2; ++k) dst[n][k] = *(const LAS bf16x8*)(lds + PG8_SB(b, h) + boff + n * 2048 + k * 1024); } while (0)
#define PG8_MMA(ai, bj, At, Bt) do { __builtin_amdgcn_s_setprio(1); _Pragma("unroll") for (int m = 0; m < 4; ++m) _Pragma("unroll") for (int n = 0; n < 2; ++n) _Pragma("unroll") for (int k = 0; k < 2; ++k) \
        acc[ai][bj][m][n] = __builtin_amdgcn_mfma_f32_16x16x32_bf16(Bt[n][k], At[m][k], acc[ai][bj][m][n], 0, 0, 0); __builtin_amdgcn_s_setprio(0); } while (0)
#define PG8_WAIT_V(n) asm volatile("s_waitcnt vmcnt(" #n ")" ::: "memory")
#define PG8_WAIT_L(n) asm volatile("s_waitcnt lgkmcnt(" #n ")" ::: "memory")
#define PG8_BAR __builtin_amdgcn_s_barrier()
#define PG8_SCHED __builtin_amdgcn_sched_barrier(0)
    Unit cur, nxt; int ui = 0;
    if (!S.next(0, cur)) return;
    f32x4 acc[2][2][4][2];
#pragma unroll
    for (int a = 0; a < 2; ++a)
#pragma unroll
        for (int b = 0; b < 2; ++b)
#pragma unroll
            for (int m = 0; m < 4; ++m)
#pragma unroll
                for (int n = 0; n < 2; ++n) acc[a][b][m][n] = (f32x4){0.f, 0.f, 0.f, 0.f};
    bf16x8 At[4][2], B0[2][2], B1[2][2];
    const char* cA = S.pA(cur); const char* cB = S.pB(cur);
    PG8_STAGE(PG8_SB(0, 0), cB, voffB); PG8_STAGE(PG8_SB(0, 1), cB + hstep, voffB); PG8_STAGE(PG8_SA(0, 0), cA, voffA); PG8_STAGE(PG8_SA(0, 1), cA + hstep, voffA);
    if (wr == 1) PG8_BAR;
    PG8_WAIT_V(2); PG8_BAR;
    PG8_STAGE(PG8_SB(1, 0), cB + kstep, voffB); PG8_STAGE(PG8_SA(1, 0), cA + kstep, voffA); PG8_STAGE(PG8_SB(1, 1), cB + hstep + kstep, voffB);
    PG8_WAIT_V(6); PG8_BAR;
    for (;;) {
        const bool has_next = S.next(ui + 1, nxt);
        const char* nA = has_next ? S.pA(nxt) : cA; const char* nB = has_next ? S.pB(nxt) : cB;
        for (int t = 0; t < nt; t += 2) {
            const bool last = (t == nt - 2);
            const char* a1 = cA + (size_t)(t + 1) * kstep;
            const char* a2 = last ? nA : cA + (size_t)(t + 2) * kstep; const char* b2 = last ? nB : cB + (size_t)(t + 2) * kstep;
            const char* a3 = a2 + kstep; const char* b3 = b2 + kstep;
            PG8_LDB(B0, 0, 0); PG8_LDB(B1, 0, 1); PG8_SCHED; PG8_LDA(At, 0, 0); PG8_STAGE(PG8_SA(1, 1), a1 + hstep, voffA);
            PG8_WAIT_V(8); PG8_WAIT_L(0); PG8_BAR; PG8_MMA(0, 0, At, B0); PG8_MMA(0, 1, At, B1); PG8_BAR; PG8_SCHED;
            PG8_LDA(At, 0, 1); PG8_STAGE(PG8_SB(0, 0), b2, voffB); PG8_STAGE(PG8_SB(0, 1), b2 + hstep, voffB); PG8_STAGE(PG8_SA(0, 0), a2, voffA);
            PG8_WAIT_V(8); PG8_WAIT_L(0); PG8_BAR; PG8_MMA(1, 0, At, B0); PG8_MMA(1, 1, At, B1); PG8_BAR; PG8_SCHED;
            PG8_LDB(B0, 1, 0); PG8_LDB(B1, 1, 1); PG8_SCHED; PG8_LDA(At, 1, 0); PG8_STAGE(PG8_SA(0, 1), a2 + hstep, voffA);
            PG8_WAIT_V(8); PG8_WAIT_L(0); PG8_BAR; PG8_MMA(0, 0, At, B0); PG8_MMA(0, 1, At, B1); PG8_BAR; PG8_SCHED;
            PG8_LDA(At, 1, 1); PG8_STAGE(PG8_SB(1, 0), b3, voffB); PG8_STAGE(PG8_SB(1, 1), b3 + hstep, voffB); PG8_STAGE(PG8_SA(1, 0), a3, voffA);
            PG8_WAIT_V(8); PG8_WAIT_L(0); PG8_BAR; PG8_MMA(1, 0, At, B0); PG8_MMA(1, 1, At, B1); PG8_BAR; PG8_SCHED;
        }
        if (wr == 0) PG8_BAR;
        E(acc, cur, wr, wc, fr, fq);
        if (!has_next) break;
#pragma unroll
        for (int a = 0; a < 2; ++a)
#pragma unroll
            for (int b = 0; b < 2; ++b)
#pragma unroll
                for (int m = 0; m < 4; ++m)
#pragma unroll
                    for (int n = 0; n < 2; ++n) acc[a][b][m][n] = (f32x4){0.f, 0.f, 0.f, 0.f};
        cur = nxt; cA = nA; cB = nB; ++ui;
        if (wr == 1) PG8_BAR;
    }
    PG8_WAIT_V(0);
    PG8_BAR;
#undef PG8_SA
#undef PG8_SB
#undef PG8_STAGE
#undef PG8_LDA
#undef PG8_LDB
#undef PG8_MMA
}

constexpr int KROW = 144, VROW = 136;
constexpr int L_KB = 0, L_VB = 2 * 64 * KROW, L_FB = L_VB + 2 * 64 * VROW, L_RELB = L_FB + 512, L_OST = L_RELB + 1280, L_UW = L_OST + 8 * 32 * KROW, L_ATT_END = L_UW + 8 * 128 * 4;
static_assert(L_ATT_END <= LDS_BYTES, "lds");
constexpr float TH_DEFER = 8.0f;
constexpr float PRUNE_NAT = 60.0f;

template <int MODE>
__device__ __forceinline__ void attn_unit(const bf16_t* __restrict__ QKVZ, const bf16_t* __restrict__ VT, const float* __restrict__ aux,
                                          bf16_t* __restrict__ G, int b, int h, int qb, int jlo, const float* __restrict__ nrm) {
    unsigned char* lds = g_shm;
    int tid = threadIdx.x; asm volatile("" : "+v"(tid));
    const int w = tid >> 6, lane = tid & 63, q = lane & 31, hh = lane >> 5;
    const int r0 = qb * 256 + w * 32, t = r0 + q;
    const int jhi = qb * 4 + 3, cw = qb * 4 + (w >> 1);
    const int lrow = tid >> 3, lch = tid & 7;
    const bf16_t* kbase = QKVZ + ((long)(b * SEQ + lrow)) * 4096 + 1024 + h * 64 + lch * 8;
    const bf16_t* vbase = VT + ((long)((b * NH + h) * 64 + lrow)) * SEQ + lch * 8;
    const float* fbase = aux + (long)(b * NH + h) * SEQ;
    constexpr float SC = 0.125f * LOG2E;

    __syncthreads();
    bf16x8 qf[4];
    {
        const bf16_t* qp = QKVZ + ((long)(b * SEQ + t)) * 4096 + h * 64 + hh * 8;
#pragma unroll
        for (int ks = 0; ks < 4; ++ks) qf[ks] = *(const bf16x8*)(qp + ks * 16);
    }
    float Ft = 0.f;
    if (MODE == 1) Ft = fbase[t] * LOG2E;
    u32x4 k0r, v0r, k1r, v1r, k2r, v2r; float f0r = 0.f, f1r = 0.f, f2r = 0.f;
    k0r = *(const u32x4*)(kbase + (long)jhi * 64 * 4096);       v0r = *(const u32x4*)(vbase + jhi * 64);
    k1r = *(const u32x4*)(kbase + (long)(jhi - 1) * 64 * 4096); v1r = *(const u32x4*)(vbase + (jhi - 1) * 64);
    k2r = *(const u32x4*)(kbase + (long)(jhi - 2) * 64 * 4096); v2r = *(const u32x4*)(vbase + (jhi - 2) * 64);
    if (MODE == 1) { if (tid < 64) { f0r = fbase[jhi * 64 + tid]; f1r = fbase[(jhi - 1) * 64 + tid]; f2r = fbase[(jhi - 2) * 64 + tid]; } }
    u32x4 zpre[4];
#pragma unroll
    for (int i = 0; i < 4; ++i) zpre[i] = *(const u32x4*)(QKVZ + (long)(b * SEQ + r0 + (lane >> 3) + 8 * i) * 4096 + 3072 + h * 64 + (lane & 7) * 8);
    if (MODE == 1) {
        int* JL = (int*)(lds + L_RELB);
        const float* NQ = nrm + ((long)(b * 128)) * 32 + 2 * h;
        const float* NK = nrm + ((long)(1024 + b * 128)) * 32 + 2 * h;
        float Qa = 0.f, Qb = 0.f, Bd = 0.f;
#pragma unroll
        for (int i = 0; i < 4; ++i) { Qa = fmaxf(Qa, sqrtf(ld_coh(NQ + (4 * qb + i) * 32))); Qb = fmaxf(Qb, sqrtf(ld_coh(NQ + (4 * qb + i) * 32 + 1))); }
#pragma unroll
        for (int i = 0; i < 4; ++i) Bd = fmaxf(Bd, Qa * sqrtf(ld_coh(NK + (4 * qb + i) * 32)) + Qb * sqrtf(ld_coh(NK + (4 * qb + i) * 32 + 1)));
        if (tid == 0) *JL = 4 * qb;
        __syncthreads();
        if (tid < 4 * qb) {
            const float Bj = Qa * sqrtf(ld_coh(NK + tid * 32)) + Qb * sqrtf(ld_coh(NK + tid * 32 + 1));
            const float Dj = ld_coh(fbase + 256 * qb) - ld_coh(fbase + 64 * tid + 63);
            if (!((Bj + Bd) * 0.125f + Dj < -PRUNE_NAT)) atomicMin(JL, tid);
        }
        __syncthreads();
        jlo = *JL;
        float* UW = (float*)(lds + L_UW) + w * 128;
        const float qa = sqrtf(ld_coh(NQ + cw * 32)), qbb = sqrtf(ld_coh(NQ + cw * 32 + 1));
        const float Fr0 = ld_coh(fbase + r0);
        for (int jr = lane; jr < cw - jlo; jr += 64) {
            const int j = jlo + jr;
            const float ka = sqrtf(ld_coh(NK + j * 32)), kb = sqrtf(ld_coh(NK + j * 32 + 1));
            UW[jr] = (qa * ka + qbb * kb) * SC + (Fr0 - ld_coh(fbase + 64 * j + 63)) * LOG2E;
        }
    }
    if (MODE == 0) { if (tid < 288) { int rl = 192 - tid; rl = rl < -128 ? -128 : (rl > 128 ? 128 : rl); ((float*)(lds + L_RELB))[tid] = aux[h * 257 + rl + 128] * LOG2E; } }

    f32x16 O0, O1;
#pragma unroll
    for (int i = 0; i < 16; ++i) { O0[i] = 0.f; O1[i] = 0.f; }
    float m_run = 0.f, l_run = 0.f, m_min = -1e30f;
    bool first = true;

    auto LOADT = [&](u32x4& kr, u32x4& vr, float& fr_, int jj) __attribute__((always_inline)) {
        if (jj >= jlo) {
            kr = *(const u32x4*)(kbase + (long)jj * 64 * 4096);
            vr = *(const u32x4*)(vbase + jj * 64);
            if (MODE == 1) { if (tid < 64) fr_ = fbase[jj * 64 + tid]; }
        }
    };
    auto STEP = [&](u32x4& kreg, u32x4& vreg, float& freg, int j) __attribute__((always_inline)) {
        const int buf = (jhi - j) & 1;
        unsigned char* KB = lds + L_KB + buf * 64 * KROW;
        unsigned char* VB = lds + L_VB + buf * 64 * VROW;
        float* FB = (float*)(lds + L_FB + buf * 256);
        *(u32x4*)(KB + lrow * KROW + lch * 16) = kreg;
        *(u32x2*)(VB + lrow * VROW + lch * 16) = (u32x2){vreg.x, vreg.y};
        *(u32x2*)(VB + lrow * VROW + lch * 16 + 8) = (u32x2){vreg.z, vreg.w};
        if (MODE == 1) { if (tid < 64) FB[tid] = freg * LOG2E; }
        __syncthreads();
        LOADT(kreg, vreg, freg, j - 3);
        bool active;
        if (MODE == 0) active = (j >= cw - 8 && j <= cw);
        else {
            active = (j <= cw);
            if (j < cw) { const float ub = ((const float*)(lds + L_UW))[w * 128 + (j - jlo)]; if (ub - m_min < -PRUNE_NAT * LOG2E) active = false; }
        }
        if (active) {
            f32x16 s0, s1;
#pragma unroll
            for (int i = 0; i < 16; ++i) { s0[i] = 0.f; s1[i] = 0.f; }
#pragma unroll
            for (int ks = 0; ks < 4; ++ks) {
                const bf16x8 k0 = *(const bf16x8*)(KB + q * KROW + (16 * ks + 8 * hh) * 2);
                const bf16x8 k1 = *(const bf16x8*)(KB + (32 + q) * KROW + (16 * ks + 8 * hh) * 2);
                s0 = __builtin_amdgcn_mfma_f32_32x32x16_bf16(k0, qf[ks], s0, 0, 0, 0);
                s1 = __builtin_amdgcn_mfma_f32_32x32x16_bf16(k1, qf[ks], s1, 0, 0, 0);
            }
            if (MODE == 0) {
                const float* RB = (const float*)(lds + L_RELB);
                if (r0 - (64 * j + 63) >= 128) {
                    const float cb = RB[64] - m_run;
#pragma unroll
                    for (int i = 0; i < 16; ++i) { s0[i] = s0[i] * SC + cb; s1[i] = s1[i] * SC + cb; }
                } else {
                    const float* Rp = RB + (192 - (t - 64 * j - 4 * hh));
#pragma unroll
                    for (int i = 0; i < 16; ++i) {
                        s0[i] = s0[i] * SC + (Rp[(i & 3) + 8 * (i >> 2)] - m_run);
                        s1[i] = s1[i] * SC + (Rp[(i & 3) + 8 * (i >> 2) + 32] - m_run);
                    }
                }
            } else {
                const bool diag = (j == cw);
                const float base = Ft - m_run;
#pragma unroll
                for (int g = 0; g < 4; ++g) {
                    const f32x4 f0 = *(const f32x4*)(FB + 8 * g + 4 * hh);
                    const f32x4 f1 = *(const f32x4*)(FB + 32 + 8 * g + 4 * hh);
#pragma unroll
                    for (int e = 0; e < 4; ++e) {
                        const int i = 4 * g + e;
                        float x0 = s0[i] * SC + (base - f0[e]);
                        float x1 = s1[i] * SC + (base - f1[e]);
                        if (diag) {
                            const int sp = 64 * j + 8 * g + 4 * hh + e;
                            if (sp > t) x0 = -1e30f;
                            if (sp + 32 > t) x1 = -1e30f;
                        }
                        s0[i] = x0; s1[i] = x1;
                    }
                }
            }
            float mx = s0[0];
#pragma unroll
            for (int i = 1; i < 16; ++i) mx = fmaxf(mx, s0[i]);
#pragma unroll
            for (int i = 0; i < 16; ++i) mx = fmaxf(mx, s1[i]);
            if (first || __any(mx > TH_DEFER)) {
                mx = fmaxf(mx, __shfl_xor(mx, 32));
                float d;
                if (first) { d = mx; }
                else {
                    d = fmaxf(mx, 0.f);
                    const float al = __builtin_amdgcn_exp2f(-d);
                    l_run *= al;
#pragma unroll
                    for (int i = 0; i < 16; ++i) { O0[i] *= al; O1[i] *= al; }
                }
                m_run += d;
#pragma unroll
                for (int i = 0; i < 16; ++i) { s0[i] -= d; s1[i] -= d; }
                first = false;
                if (MODE == 1) {
                    float mm = m_run;
#pragma unroll
                    for (int o = 32; o >= 1; o >>= 1) mm = fminf(mm, __shfl_xor(mm, o));
                    m_min = mm;
                }
            }
            float ps = 0.f;
#pragma unroll
            for (int i = 0; i < 16; ++i) { s0[i] = __builtin_amdgcn_exp2f(s0[i]); s1[i] = __builtin_amdgcn_exp2f(s1[i]); ps += s0[i] + s1[i]; }
            l_run += ps;
#pragma unroll
            for (int s = 0; s < 4; ++s) {
                u32x4 pw;
                if (s < 2) { pw.x = cvt_pk_bf16(s0[8 * s + 0], s0[8 * s + 1]); pw.y = cvt_pk_bf16(s0[8 * s + 2], s0[8 * s + 3]); pw.z = cvt_pk_bf16(s0[8 * s + 4], s0[8 * s + 5]); pw.w = cvt_pk_bf16(s0[8 * s + 6], s0[8 * s + 7]); }
                else { const int sp = s - 2; pw.x = cvt_pk_bf16(s1[8 * sp + 0], s1[8 * sp + 1]); pw.y = cvt_pk_bf16(s1[8 * sp + 2], s1[8 * sp + 3]); pw.z = cvt_pk_bf16(s1[8 * sp + 4], s1[8 * sp + 5]); pw.w = cvt_pk_bf16(s1[8 * sp + 6], s1[8 * sp + 7]); }
                const bf16x8 pf = __builtin_bit_cast(bf16x8, pw);
                {
                    const u32x2 lo = *(const u32x2*)(VB + q * VROW + (16 * s + 4 * hh) * 2);
                    const u32x2 hi = *(const u32x2*)(VB + q * VROW + (16 * s + 8 + 4 * hh) * 2);
                    const bf16x8 vf = __builtin_bit_cast(bf16x8, ((u32x4){lo.x, lo.y, hi.x, hi.y}));
                    O0 = __builtin_amdgcn_mfma_f32_32x32x16_bf16(vf, pf, O0, 0, 0, 0);
                }
                {
                    const u32x2 lo = *(const u32x2*)(VB + (32 + q) * VROW + (16 * s + 4 * hh) * 2);
                    const u32x2 hi = *(const u32x2*)(VB + (32 + q) * VROW + (16 * s + 8 + 4 * hh) * 2);
                    const bf16x8 vf = __builtin_bit_cast(bf16x8, ((u32x4){lo.x, lo.y, hi.x, hi.y}));
                    O1 = __builtin_amdgcn_mfma_f32_32x32x16_bf16(vf, pf, O1, 0, 0, 0);
                }
            }
        }
    };
    for (int j = jhi; j >= jlo; j -= 3) {
        STEP(k0r, v0r, f0r, j);
        if (j - 1 >= jlo) STEP(k1r, v1r, f1r, j - 1);
        if (j - 2 >= jlo) STEP(k2r, v2r, f2r, j - 2);
    }
    const float lt = l_run + __shfl_xor(l_run, 32);
    const float inv = 1.0f / lt;
    unsigned char* OST = lds + L_OST + w * 32 * KROW;
#pragma unroll
    for (int g = 0; g < 4; ++g) {
        u32x2 w0, w1;
        w0.x = cvt_pk_bf16(O0[4 * g + 0] * inv, O0[4 * g + 1] * inv); w0.y = cvt_pk_bf16(O0[4 * g + 2] * inv, O0[4 * g + 3] * inv);
        w1.x = cvt_pk_bf16(O1[4 * g + 0] * inv, O1[4 * g + 1] * inv); w1.y = cvt_pk_bf16(O1[4 * g + 2] * inv, O1[4 * g + 3] * inv);
        *(u32x2*)(OST + q * KROW + (8 * g + 4 * hh) * 2) = w0;
        *(u32x2*)(OST + q * KROW + (32 + 8 * g + 4 * hh) * 2) = w1;
    }
    __syncthreads();
#pragma unroll
    for (int i = 0; i < 4; ++i) {
        const int row = (lane >> 3) + 8 * i, ch = lane & 7;
        const u32x4 o8 = *(const u32x4*)(OST + row * KROW + ch * 16);
        const long tok = (long)(b * SEQ + r0 + row);
        const u32x4 z8 = zpre[i];
        u32x4 r8;
#pragma unroll
        for (int e = 0; e < 4; ++e) {
            const unsigned ou = o8[e], zu = z8[e];
            const float z0 = bf_lo(zu), z1 = bf_hi(zu);
            const float g0 = bf_lo(ou) * z0 / (1.0f + __expf(-z0));
            const float g1 = bf_hi(ou) * z1 / (1.0f + __expf(-z1));
            r8[e] = cvt_pk_bf16(g0, g1);
        }
        *(u32x4*)(G + tok * 1024 + h * 64 + ch * 8) = r8;
    }
}

__device__ __forceinline__ void transpose_w(const float* __restrict__ src, int N, bf16_t* __restrict__ dst, int tile) {
    float* T = (float*)g_shm;
    int tid = threadIdx.x; asm volatile("" : "+v"(tid));
    const int ntn = N / 64, kt = tile / ntn, ntl = tile % ntn, k0 = kt * 64, n0 = ntl * 64;
    __syncthreads();
#pragma unroll
    for (int e = 0; e < 8; ++e) { const int idx = tid + 512 * e, kk = idx >> 6, nn = idx & 63; T[kk * 65 + nn] = src[(long)(k0 + kk) * N + n0 + nn]; }
    __syncthreads();
#pragma unroll
    for (int e = 0; e < 4; ++e) { const int idx = tid + 512 * e, nn = idx >> 5, kp = idx & 31;
        *(unsigned*)(dst + (long)(n0 + nn) * 1024 + k0 + 2 * kp) = cvt_pk_bf16(T[(2 * kp) * 65 + nn], T[(2 * kp + 1) * 65 + nn]); }
}

__device__ __forceinline__ float log_sigmoid(float z) { return fminf(z, 0.f) - log1pf(expf(-fabsf(z))); }

__device__ __forceinline__ void ln_phase(float* __restrict__ io, bf16_t* __restrict__ XB, const float* __restrict__ g, const float* __restrict__ bta,
                                         const float* __restrict__ wf, const float* __restrict__ bf, float* __restrict__ LOGF) {
    int tid = threadIdx.x; asm volatile("" : "+v"(tid));
    const int w = tid >> 6, lane = tid & 63;
    f32x4* WF = (f32x4*)g_shm;
    if (wf) {
        __syncthreads();
        for (int idx = tid; idx < 4096; idx += 512) {
            const int ln = idx & 63, hq = (idx >> 6) & 3, ie = idx >> 8, k = 4 * (ln + 64 * (ie >> 2)) + (ie & 3);
            WF[idx] = *(const f32x4*)(wf + k * 16 + 4 * hq);
        }
        __syncthreads();
    }
    f32x4 gv[4], bv[4];
#pragma unroll
    for (int i = 0; i < 4; ++i) { gv[i] = *(const f32x4*)(g + 4 * (lane + 64 * i)); bv[i] = *(const f32x4*)(bta + 4 * (lane + 64 * i)); }
    const int G_ = gridDim.x, c_ = blockIdx.x;
    const int nri = (c_ < 256) ? ((256 - c_ + G_ - 1) / G_) * 32 : 0;
    auto row_of = [&](int ri) __attribute__((always_inline)) { return (c_ + (ri >> 5) * G_) * 256 + w + 8 * (ri & 31); };
    f32x4 nv[4];
    if (nri > 0) {
        const int row = row_of(0);
#pragma unroll
        for (int i = 0; i < 4; ++i) nv[i] = *(const f32x4*)(io + (long)row * 1024 + 4 * (lane + 64 * i));
    }
    for (int ri = 0; ri < nri; ++ri) {
        const int row = row_of(ri);
        float* rp = io + (long)row * 1024;
        f32x4 v[4];
#pragma unroll
        for (int i = 0; i < 4; ++i) v[i] = nv[i];
        if (ri + 1 < nri) {
            const int nrow = row_of(ri + 1);
#pragma unroll
            for (int i = 0; i < 4; ++i) nv[i] = *(const f32x4*)(io + (long)nrow * 1024 + 4 * (lane + 64 * i));
        }
        float s = 0.f;
#pragma unroll
        for (int i = 0; i < 4; ++i) s += (v[i][0] + v[i][1]) + (v[i][2] + v[i][3]);
#pragma unroll
        for (int o = 32; o >= 1; o >>= 1) s += __shfl_xor(s, o);
        const float mu = s * (1.0f / 1024.0f);
        float qs = 0.f;
#pragma unroll
        for (int i = 0; i < 4; ++i) { v[i] = v[i] - mu; qs += (v[i][0] * v[i][0] + v[i][1] * v[i][1]) + (v[i][2] * v[i][2] + v[i][3] * v[i][3]); }
#pragma unroll
        for (int o = 32; o >= 1; o >>= 1) qs += __shfl_xor(qs, o);
        const float rstd = 1.0f / sqrtf(qs * (1.0f / 1024.0f) + LN_EPS);
#pragma unroll
        for (int i = 0; i < 4; ++i) {
            v[i] = v[i] * rstd * gv[i] + bv[i];
            *(f32x4*)(rp + 4 * (lane + 64 * i)) = v[i];
            if (XB) { u32x2 pk; pk.x = cvt_pk_bf16(v[i][0], v[i][1]); pk.y = cvt_pk_bf16(v[i][2], v[i][3]);
                *(u32x2*)(XB + (long)row * 1024 + 4 * (lane + 64 * i)) = pk; }
        }
        if (wf) {
            float a[16];
#pragma unroll
            for (int c = 0; c < 16; ++c) a[c] = 0.f;
#pragma unroll
            for (int i = 0; i < 4; ++i)
#pragma unroll
                for (int e = 0; e < 4; ++e) {
                    const float xv = v[i][e];
#pragma unroll
                    for (int hq = 0; hq < 4; ++hq) {
                        const f32x4 w4 = WF[((i * 4 + e) * 4 + hq) * 64 + lane];
                        a[4 * hq + 0] += xv * w4[0]; a[4 * hq + 1] += xv * w4[1]; a[4 * hq + 2] += xv * w4[2]; a[4 * hq + 3] += xv * w4[3];
                    }
                }
#pragma unroll
            for (int i = 0; i < 8; ++i) { const bool up = (lane & 32) != 0; const float send = up ? a[i] : a[i + 8], keep = up ? a[i + 8] : a[i]; a[i] = keep + __shfl_xor(send, 32); }
#pragma unroll
            for (int i = 0; i < 4; ++i) { const bool up = (lane & 16) != 0; const float send = up ? a[i] : a[i + 4], keep = up ? a[i + 4] : a[i]; a[i] = keep + __shfl_xor(send, 16); }
#pragma unroll
            for (int i = 0; i < 2; ++i) { const bool up = (lane & 8) != 0; const float send = up ? a[i] : a[i + 2], keep = up ? a[i + 2] : a[i]; a[i] = keep + __shfl_xor(send, 8); }
            { const bool up = (lane & 4) != 0; const float send = up ? a[0] : a[1], keep = up ? a[1] : a[0]; a[0] = keep + __shfl_xor(send, 4); }
            a[0] += __shfl_xor(a[0], 2); a[0] += __shfl_xor(a[0], 1);
            if ((lane & 3) == 0) {
                const int hd = ((lane >> 5) & 1) * 8 + ((lane >> 4) & 1) * 4 + ((lane >> 3) & 1) * 2 + ((lane >> 2) & 1);
                const int bb = row / SEQ, ss = row % SEQ;
                LOGF[((long)(bb * NH + hd)) * SEQ + ss] = log_sigmoid(a[0] + bf[hd]);
            }
        }
    }
}

__device__ __forceinline__ void scan_phase(float* __restrict__ F) {
    float* red = (float*)g_shm;
    int tid = threadIdx.x; asm volatile("" : "+v"(tid));
    const int w = tid >> 6, lane = tid & 63;
    for (int bh = blockIdx.x; bh < NB * NH; bh += gridDim.x) {
        float* p = F + (long)bh * SEQ + tid * 16;
        f32x4 v[4];
#pragma unroll
        for (int i = 0; i < 4; ++i) v[i] = *(const f32x4*)(p + 4 * i);
        float run = 0.f;
#pragma unroll
        for (int i = 0; i < 4; ++i)
#pragma unroll
            for (int e = 0; e < 4; ++e) { run += v[i][e]; v[i][e] = run; }
        float inc = run;
#pragma unroll
        for (int o = 1; o < 64; o <<= 1) { const float y = __shfl_up(inc, o); if (lane >= o) inc += y; }
        __syncthreads();
        if (lane == 63) red[w] = inc;
        __syncthreads();
        float base = inc - run;
        for (int ww = 0; ww < w; ++ww) base += red[ww];
#pragma unroll
        for (int i = 0; i < 4; ++i) { v[i] = v[i] + base; *(f32x4*)(p + 4 * i) = v[i]; }
    }
}

__device__ __forceinline__ void grid_bar(unsigned* ctr, unsigned target) {
    __syncthreads();
    if (threadIdx.x == 0) {
        __builtin_amdgcn_fence(__ATOMIC_RELEASE, "agent");
        __hip_atomic_fetch_add(ctr, 1u, __ATOMIC_RELAXED, __HIP_MEMORY_SCOPE_AGENT);
        while (__hip_atomic_load(ctr, __ATOMIC_RELAXED, __HIP_MEMORY_SCOPE_AGENT) < target) __builtin_amdgcn_s_sleep(4);
        __builtin_amdgcn_fence(__ATOMIC_ACQUIRE, "agent");
    }
    __syncthreads();
}

__global__ void __launch_bounds__(512, 2) fwd_megakernel(Params p) {
    cg::grid_group grid = cg::this_grid();
    bf16_t* XB = (bf16_t*)(p.ws + WS_XB);
    bf16_t* QKVZ = (bf16_t*)(p.ws + WS_QKVZ);
    bf16_t* VT = (bf16_t*)(p.ws + WS_VT);
    bf16_t* G = (bf16_t*)(p.ws + WS_G);
    bf16_t* WIN = (bf16_t*)(p.ws + WS_WIN);
    bf16_t* WOUT = (bf16_t*)(p.ws + WS_WOUT);
    float* F = (float*)(p.ws + WS_F);
    float* NRM = (float*)(p.ws + WS_NRM);
    unsigned* CTR = (unsigned*)(p.ws + WS_CTR);
    unsigned bar_gen = 0;
#define GRID_BAR() do { ++bar_gen; grid_bar(CTR, bar_gen * gridDim.x); } while (0)
    const int tid = threadIdx.x;
    LAS unsigned char* lds = (LAS unsigned char*)g_shm;

    if (blockIdx.x == 0 && tid == 0) __hip_atomic_store(CTR, 0u, __ATOMIC_RELAXED, __HIP_MEMORY_SCOPE_AGENT);
    {
        const long nvec = (long)MTOK * 1024 / 8;
#pragma unroll 4
        for (long i = (long)blockIdx.x * 512 + tid; i < nvec; i += (long)gridDim.x * 512) {
            const f32x4 a = *(const f32x4*)(p.x + i * 8), c = *(const f32x4*)(p.x + i * 8 + 4);
            u32x4 o; o.x = cvt_pk_bf16(a[0], a[1]); o.y = cvt_pk_bf16(a[2], a[3]); o.z = cvt_pk_bf16(c[0], c[1]); o.w = cvt_pk_bf16(c[2], c[3]);
            *(u32x4*)(XB + i * 8) = o;
        }
        for (int u = blockIdx.x; u < DEPTH * 1280; u += gridDim.x) {
            const int l = u / 1280, tl = u % 1280;
            if (tl < 1024) {
                const float* src = ((l & 1) ? p.w_in_b : p.w_in_a) + (long)(l >> 1) * 1024 * 4096;
                transpose_w(src, 4096, WIN + (long)l * 4096 * 1024, tl);
            } else {
                const float* src = ((l & 1) ? p.w_out_b : p.w_out_a) + (long)(l >> 1) * 1024 * 1024;
                transpose_w(src, 1024, WOUT + (long)l * 1024 * 1024, tl - 1024);
            }
        }
    }
    grid.sync();

#pragma unroll 1
    for (int layer = 0; layer < DEPTH; ++layer) {
        const bool isB = (layer & 1) != 0;
        const bf16_t* Wi = WIN + (long)layer * 4096 * 1024;
        const bf16_t* Wo = WOUT + (long)layer * 1024 * 1024;
        if (isB) scan_phase(F);
        {
            Sched S; S.mode = 0; S.XB = (const char*)XB; S.W = (const char*)Wi; S.G = gridDim.x; S.c = blockIdx.x;
            Epi E; E.mode = 0; E.QKVZ = QKVZ; E.VT = VT; E.xin = nullptr; E.of = nullptr; E.nrm = isB ? NRM : nullptr;
            __syncthreads();
            gemm_phase(lds, S, E);
        }
        GRID_BAR();
        for (int u = blockIdx.x; u < 4096; u += gridDim.x) {
            const int c = u & 255, i = u >> 8, bh = i * 8 + (c & 7);
            int qb = c >> 3;
            if (isB && (i & 1)) qb = 31 - qb;
            const int b = bh >> 4, h = bh & 15;
            if (!isB) attn_unit<0>(QKVZ, VT, p.rel_bias_a + (long)(layer >> 1) * NH * 257, G, b, h, qb, (qb * 4 - 8) > 0 ? (qb * 4 - 8) : 0, nullptr);
            else attn_unit<1>(QKVZ, VT, F, G, b, h, qb, 0, NRM);
        }
        GRID_BAR();
        {
            Sched S; S.mode = 1; S.XB = (const char*)G; S.W = (const char*)Wo; S.G = gridDim.x; S.c = blockIdx.x;
            Epi E; E.mode = 1; E.QKVZ = nullptr; E.VT = nullptr; E.xin = (layer == 0) ? p.x : p.out; E.of = p.out; E.nrm = nullptr;
            __syncthreads();
            gemm_phase(lds, S, E);
        }
        __syncthreads();
        {
            const bool nextB = (layer + 1 < DEPTH) && ((layer + 1) & 1);
            const int jn = (layer + 1) >> 1;
            ln_phase(p.out, (layer + 1 < DEPTH) ? XB : nullptr, p.ln_g + layer * 1024, p.ln_b + layer * 1024,
                     nextB ? p.w_f_b + (long)jn * 1024 * 16 : nullptr, nextB ? p.b_f_b + jn * 16 : nullptr, F);
        }
        if (layer + 1 < DEPTH) GRID_BAR();
    }
}

extern "C" void kernel_launch(void* const* d_in, const int* in_sizes, int n_in, void* d_out, int out_size, void* d_ws, size_t ws_size, hipStream_t stream) {
    static int grid_blocks = 0;
    if (grid_blocks == 0) {
        if (ws_size < WS_END) { fprintf(stderr, "kernel_launch: workspace too small (%zu < %zu)\n", ws_size, (size_t)WS_END); grid_blocks = -1; return; }
        int dev = 0, cus = 0, per_cu = 0;
        hipGetDevice(&dev);
        hipDeviceGetAttribute(&cus, hipDeviceAttributeMultiprocessorCount, dev);
        hipFuncSetAttribute((const void*)fwd_megakernel, hipFuncAttributeMaxDynamicSharedMemorySize, LDS_BYTES);
        hipOccupancyMaxActiveBlocksPerMultiprocessor(&per_cu, (const void*)fwd_megakernel, 512, LDS_BYTES);
        if (per_cu < 1) { fprintf(stderr, "kernel_launch: occupancy query says %d blocks per CU\n", per_cu); per_cu = 1; }
        grid_blocks = cus * 1;
        (void)hipGetLastError();
    }
    if (grid_blocks < 0) return;
    Params p{};
    p.x = (const float*)d_in[0]; p.w_in_a = (const float*)d_in[1]; p.rel_bias_a = (const float*)d_in[2]; p.w_out_a = (const float*)d_in[3];
    p.w_in_b = (const float*)d_in[4]; p.w_f_b = (const float*)d_in[5]; p.b_f_b = (const float*)d_in[6]; p.w_out_b = (const float*)d_in[7];
    p.ln_g = (const float*)d_in[8]; p.ln_b = (const float*)d_in[9];
    p.out = (float*)d_out; p.ws = (unsigned char*)d_ws;
    void* args[] = {&p};
    hipError_t e = hipLaunchCooperativeKernel((const void*)fwd_megakernel, dim3(grid_blocks), dim3(512), args, LDS_BYTES, stream);
    if (e != hipSuccess) fprintf(stderr, "cooperative launch failed: %s (grid %d)\n", hipGetErrorString(e), grid_blocks);
}
```

```cpp
#include <hip/hip_runtime.h>
#include <hip/hip_cooperative_groups.h>
#include <cstdio>
#include <cstdint>
namespace cg = cooperative_groups;

typedef unsigned short bf16_t;
typedef short bf16x8 __attribute__((ext_vector_type(8)));
typedef float f32x4 __attribute__((ext_vector_type(4)));
typedef float f32x16 __attribute__((ext_vector_type(16)));
typedef unsigned u32x4 __attribute__((ext_vector_type(4)));
typedef unsigned u32x2 __attribute__((ext_vector_type(2)));

constexpr int DM = 1024, NB = 8, SEQ = 8192, MTOK = NB * SEQ, NH = 16, DEPTH = 4;
constexpr float LN_EPS = 1e-5f;
constexpr float ALPHA = 1.681792830507429f;
constexpr float LOG2E = 1.4426950408889634f;
constexpr int LDS_BYTES = 131072;

constexpr size_t WS_XB = 0;
constexpr size_t WS_QKVZ = WS_XB + (size_t)MTOK * 1024 * 2;
constexpr size_t WS_VT = WS_QKVZ + (size_t)MTOK * 4096 * 2;
constexpr size_t WS_G = WS_VT + (size_t)MTOK * 1024 * 2;
constexpr size_t WS_WIN = WS_G + (size_t)MTOK * 1024 * 2;
constexpr size_t WS_WOUT = WS_WIN + (size_t)DEPTH * 4096 * 1024 * 2;
constexpr size_t WS_F = WS_WOUT + (size_t)DEPTH * 1024 * 1024 * 2;
constexpr size_t WS_NRM = WS_F + (size_t)NB * NH * SEQ * 4;
constexpr size_t WS_CTR = WS_NRM + (size_t)2 * 1024 * 128 * 4;
constexpr size_t WS_END = WS_CTR + 256;

extern __shared__ __attribute__((aligned(16))) unsigned char g_shm[];

struct Params {
    const float* x; const float* w_in_a; const float* rel_bias_a; const float* w_out_a;
    const float* w_in_b; const float* w_f_b; const float* b_f_b; const float* w_out_b;
    const float* ln_g; const float* ln_b;
    float* out; unsigned char* ws;
};

typedef __bf16 bf16x2_t __attribute__((ext_vector_type(2)));
typedef float f32x2_t __attribute__((ext_vector_type(2)));
__device__ __forceinline__ unsigned cvt_pk_bf16(float lo, float hi) { const f32x2_t v = {lo, hi}; const bf16x2_t r = __builtin_convertvector(v, bf16x2_t); return __builtin_bit_cast(unsigned, r); }
__device__ __forceinline__ float ld_coh(const float* p) { return __hip_atomic_load(p, __ATOMIC_RELAXED, __HIP_MEMORY_SCOPE_AGENT); }
template <int CTRL> __device__ __forceinline__ float dpp_f(float v) { return __int_as_float(__builtin_amdgcn_update_dpp(0, __float_as_int(v), CTRL, 0xf, 0xf, false)); }
__device__ __forceinline__ float bf_lo(unsigned u) { return __uint_as_float(u << 16); }
__device__ __forceinline__ float bf_hi(unsigned u) { return __uint_as_float(u & 0xffff0000u); }

#define LAS __attribute__((address_space(3)))
constexpr int BK = 64, HALF = 128, HTB = HALF * BK * 2, GK = 1024;
__device__ __forceinline__ int lds_byte(int r, int c) { const int st = (r >> 4) * 2 + (c >> 5), rr = r & 15, cc = c & 31, ob = rr * 64 + cc * 2; return st * 1024 + (ob ^ (((ob >> 9) & 1) << 5)); }
__device__ __forceinline__ void stage_rc(int b, int& R, int& C) { const int st = b / 1024, sb = b % 1024, swz = sb ^ (((sb >> 9) & 1) << 5); R = (st >> 1) * 16 + swz / 64; C = (st & 1) * 32 + (swz % 64) / 2; }
__device__ __forceinline__ int perm32(int rho) { const int n = rho >> 4, i = rho & 15; return 8 * (i >> 2) + 4 * n + (i & 3); }

__device__ __forceinline__ void tile_map(int L, int nM, int nN, int& pm, int& pn) {
    const int nwg = nM * nN; int wgid = L;
    { const int q = nwg / 8, r = nwg % 8, xcd = wgid % 8, off = wgid / 8; wgid = (xcd < r ? xcd * (q + 1) : r * (q + 1) + (xcd - r) * q) + off; }
    const int nig = 8 * nN, gid = wgid / nig, fm = gid * 8, gsz = (nM - fm) < 8 ? (nM - fm) : 8;
    pm = fm + ((wgid % nig) % gsz); pn = (wgid % nig) / gsz;
}

struct Unit { int pm, pn; };
constexpr size_t TSTEP = (size_t)256 * GK * 2;
struct Sched {
    int mode;
    const char* XB; const char* W; int G, c;
    __device__ __forceinline__ bool next(int i, Unit& u) const {
        if (mode == 1) { const int panel = c + (i >> 2) * G; if (panel >= 256) return false; u.pm = panel; u.pn = i & 3; return true; }
        const long L = (long)i * G + c; if (L >= 4096) return false;
        tile_map((int)L, 256, 16, u.pm, u.pn); return true;
    }
    __device__ __forceinline__ bool vt(const Unit& u) const { return mode == 0 && u.pn >= 8 && u.pn < 12; }
    __device__ __forceinline__ const char* pA(const Unit& u) const { return vt(u) ? W + (size_t)u.pn * TSTEP : XB + (size_t)u.pm * TSTEP; }
    __device__ __forceinline__ const char* pB(const Unit& u) const { return vt(u) ? XB + (size_t)u.pm * TSTEP : W + (size_t)u.pn * TSTEP; }
};
struct Epi {
    int mode; bf16_t* QKVZ; bf16_t* VT; const float* xin; float* of; float* nrm;
    __device__ __forceinline__ void operator()(const f32x4 (&acc)[2][2][4][2], const Unit& u, int wr, int wc, int fr, int fq) const {
        if (mode == 0) {
            bf16_t* ob; long ldo;
            if (u.pn >= 8 && u.pn < 12) { ob = VT + ((long)((u.pm >> 5) * 1024 + (u.pn - 8) * 256)) * SEQ + (u.pm & 31) * 256; ldo = SEQ; }
            else { ob = QKVZ + (long)u.pm * 256 * 4096 + u.pn * 256; ldo = 4096; }
            if (nrm && u.pn < 8) {
                const int which = u.pn >> 2, pnl = u.pn & 3;
#pragma unroll
                for (int ai = 0; ai < 2; ++ai)
#pragma unroll
                    for (int bj = 0; bj < 2; ++bj) {
                        float mx = 0.f;
#pragma unroll
                        for (int m = 0; m < 4; ++m) {
                            const f32x4 v0 = acc[ai][bj][m][0], v1 = acc[ai][bj][m][1];
                            float s = (v0[0] * v0[0] + v0[1] * v0[1]) + (v0[2] * v0[2] + v0[3] * v0[3]) + (v1[0] * v1[0] + v1[1] * v1[1]) + (v1[2] * v1[2] + v1[3] * v1[3]);
                            s += __shfl_xor(s, 16); s += __shfl_xor(s, 32);
                            mx = fmaxf(mx, s);
                        }
                        mx = fmaxf(mx, dpp_f<0xB1>(mx)); mx = fmaxf(mx, dpp_f<0x4E>(mx)); mx = fmaxf(mx, dpp_f<0x141>(mx)); mx = fmaxf(mx, dpp_f<0x140>(mx));
                        if (fr == 0 && fq == 0) nrm[((long)which * 1024 + (u.pm * 4 + 2 * ai + wr)) * 32 + pnl * 8 + 4 * bj + wc] = mx * 1.02f;
                    }
            }
#pragma unroll
            for (int ai = 0; ai < 2; ++ai)
#pragma unroll
                for (int m = 0; m < 4; ++m) {
                    bf16_t* rp = ob + (long)(ai * HALF + wr * 64 + m * 16 + fr) * ldo + wc * 32 + fq * 8;
#pragma unroll
                    for (int bj = 0; bj < 2; ++bj) {
                        const f32x4 v0 = acc[ai][bj][m][0], v1 = acc[ai][bj][m][1];
                        u32x4 w; w.x = cvt_pk_bf16(v0[0], v0[1]); w.y = cvt_pk_bf16(v0[2], v0[3]); w.z = cvt_pk_bf16(v1[0], v1[1]); w.w = cvt_pk_bf16(v1[2], v1[3]);
                        *(u32x4*)(rp + bj * HALF) = w;
                    }
                }
        } else {
            const long o = (long)u.pm * 256 * 1024 + u.pn * 256;
#pragma unroll
            for (int ai = 0; ai < 2; ++ai)
#pragma unroll
                for (int m = 0; m < 4; ++m) {
                    const long ro = o + (long)(ai * HALF + wr * 64 + m * 16 + fr) * 1024 + wc * 32 + fq * 8;
#pragma unroll
                    for (int bj = 0; bj < 2; ++bj)
#pragma unroll
                        for (int n = 0; n < 2; ++n) {
                            const f32x4 xv = *(const f32x4*)(xin + ro + bj * HALF + n * 4);
                            const f32x4 r = xv * ALPHA + acc[ai][bj][m][n];
                            *(f32x4*)(of + ro + bj * HALF + n * 4) = r;
                        }
                }
        }
    }
};

__device__ __forceinline__ void gemm_phase(LAS unsigned char* lds, const Sched& S, const Epi& E) {
    int tid = threadIdx.x; asm volatile("" : "+v"(tid));
    const int wid = __builtin_amdgcn_readfirstlane(tid >> 6), lane = tid & 63, wr = wid >> 2, wc = wid & 3, fr = lane & 15, fq = lane >> 4;
    constexpr int K = GK, nt = K / BK;
    unsigned voffA[2], voffB[2];
#pragma unroll
    for (int i = 0; i < 2; ++i) { int R, C; stage_rc(tid * 16 + i * 8192, R, C); const int Rb = (R & ~31) + perm32(R & 31);
        voffA[i] = (unsigned)(R * K + C) * 2u; voffB[i] = (unsigned)(Rb * K + C) * 2u; }
    constexpr size_t kstep = (size_t)(BK * 2);
    constexpr size_t hstep = (size_t)HALF * K * 2;
    const unsigned ldsw = (unsigned)wid * 1024u;
    const int aoff = lds_byte(wr * 64 + fr, fq * 8), boff = lds_byte(wc * 32 + fr, fq * 8);
#define PG8_SA(b, h) (((b) * 2 + (h)) * HTB)
#define PG8_SB(b, h) ((4 + (b) * 2 + (h)) * HTB)
#define PG8_STAGE(bufoff, gbase, voff) do { _Pragma("unroll") for (int _i = 0; _i < 2; ++_i) \
        __builtin_amdgcn_global_load_lds((const unsigned*)((const char*)(gbase) + (voff)[_i]), (LAS unsigned*)(lds + (bufoff) + ldsw + _i * 8192), 16, 0, 0); } while (0)
#define PG8_LDA(dst, b, h) do { _Pragma("unroll") for (int m = 0; m < 4; ++m) _Pragma("unroll") for (int k = 0; k < 2; ++k) dst[m][k] = *(const LAS bf16x8*)(lds + PG8_SA(b, h) + aoff + m * 2048 + k * 1024); } while (0)
#define PG8_LDB(dst, b, h) do { _Pragma("unroll") for (int n = 0; n < 2; ++n) _Pragma("unroll") for (int k = 0; k < 2; ++k) dst[n][k] = *(const LAS bf16x8*)(lds + PG8_SB(b, h) + boff + n * 2048 + k * 1024); } while (0)
#define PG8_MMA(ai, bj, At, Bt) do { __builtin_amdgcn_s_setprio(1); _Pragma("unroll") for (int m = 0; m < 4; ++m) _Pragma("unroll") for (int n = 0; n < 2; ++n) _Pragma("unroll") for (int k = 0; k < 2; ++k) \
        acc[ai][bj][m][n] = __builtin_amdgcn_mfma_f32_16x16x32_bf16(Bt[n][k], At[m][k], acc[ai][bj][m][n], 0, 0, 0); __builtin_amdgcn_s_setprio(0); } while (0)
#define PG8_WAIT_V(n) asm volatile("s_waitcnt vmcnt(" #n ")" ::: "memory")
#define PG8_WAIT_L(n) asm volatile("s_waitcnt lgkmcnt(" #n ")" ::: "memory")
#define PG8_BAR __builtin_amdgcn_s_barrier()
#define PG8_SCHED __builtin_amdgcn_sched_barrier(0)
    Unit cur, nxt; int ui = 0;
    if (!S.next(0, cur)) return;
    f32x4 acc[2][2][4][2];
#pragma unroll
    for (int a = 0; a < 2; ++a)
#pragma unroll
        for (int b = 0; b < 2; ++b)
#pragma unroll
            for (int m = 0; m < 4; ++m)
#pragma unroll
                for (int n = 0; n < 2; ++n) acc[a][b][m][n] = (f32x4){0.f, 0.f, 0.f, 0.f};
    bf16x8 At[4][2], B0[2][2], B1[2][2];
    const char* cA = S.pA(cur); const char* cB = S.pB(cur);
    PG8_STAGE(PG8_SB(0, 0), cB, voffB); PG8_STAGE(PG8_SB(0, 1), cB + hstep, voffB); PG8_STAGE(PG8_SA(0, 0), cA, voffA); PG8_STAGE(PG8_SA(0, 1), cA + hstep, voffA);
    if (wr == 1) PG8_BAR;
    PG8_WAIT_V(2); PG8_BAR;
    PG8_STAGE(PG8_SB(1, 0), cB + kstep, voffB); PG8_STAGE(PG8_SA(1, 0), cA + kstep, voffA); PG8_STAGE(PG8_SB(1, 1), cB + hstep + kstep, voffB);
    PG8_WAIT_V(6); PG8_BAR;
    for (;;) {
        const bool has_next = S.next(ui + 1, nxt);
        const char* nA = has_next ? S.pA(nxt) : cA; const char* nB = has_next ? S.pB(nxt) : cB;
        for (int t = 0; t < nt; t += 2) {
            const bool last = (t == nt - 2);
            const char* a1 = cA + (size_t)(t + 1) * kstep;
            const char* a2 = last ? nA : cA + (size_t)(t + 2) * kstep; const char* b2 = last ? nB : cB + (size_t)(t + 2) * kstep;
            const char* a3 = a2 + kstep; const char* b3 = b2 + kstep;
            PG8_LDB(B0, 0, 0); PG8_LDB(B1, 0, 1); PG8_SCHED; PG8_LDA(At, 0, 0); PG8_STAGE(PG8_SA(1, 1), a1 + hstep, voffA);
            PG8_WAIT_V(8); PG8_WAIT_L(0); PG8_BAR; PG8_MMA(0, 0, At, B0); PG8_MMA(0, 1, At, B1); PG8_BAR; PG8_SCHED;
            PG8_LDA(At, 0, 1); PG8_STAGE(PG8_SB(0, 0), b2, voffB); PG8_STAGE(PG8_SB(0, 1), b2 + hstep, voffB); PG8_STAGE(PG8_SA(0, 0), a2, voffA);
            PG8_WAIT_V(8); PG8_WAIT_L(0); PG8_BAR; PG8_MMA(1, 0, At, B0); PG8_MMA(1, 1, At, B1); PG8_BAR; PG8_SCHED;
            PG8_LDB(B0, 1, 0); PG8_LDB(B1, 1, 1); PG8_SCHED; PG8_LDA(At, 1, 0); PG8_STAGE(PG8_SA(0, 1), a2 + hstep, voffA);
            PG8_WAIT_V(8); PG8_WAIT_L(0); PG8_BAR; PG8_MMA(0, 0, At, B0); PG8_MMA(0, 1, At, B1); PG8_BAR; PG8_SCHED;
            PG8_LDA(At, 1, 1); PG8_STAGE(PG8_SB(1, 0), b3, voffB); PG8_STAGE(PG8_SB(1, 1), b3 + hstep, voffB); PG8_STAGE(PG8_SA(1, 0), a3, voffA);
            PG8_WAIT_V(8); PG8_WAIT_L(0); PG8_BAR; PG8_MMA(1, 0, At, B0); PG8_MMA(1, 1, At, B1); PG8_BAR; PG8_SCHED;
        }
        if (wr == 0) PG8_BAR;
        E(acc, cur, wr, wc, fr, fq);
        if (!has_next) break;
#pragma unroll
        for (int a = 0; a < 2; ++a)
#pragma unroll
            for (int b = 0; b < 2; ++b)
#pragma unroll
                for (int m = 0; m < 4; ++m)
#pragma unroll
                    for (int n = 0; n < 2; ++n) acc[a][b][m][n] = (f32x4){0.f, 0.f, 0.f, 0.f};
        cur = nxt; cA = nA; cB = nB; ++ui;
        if (wr == 1) PG8_BAR;
    }
    PG8_WAIT_V(0);
    PG8_BAR;
#undef PG8_SA
#undef PG8_SB
#undef PG8_STAGE
#undef PG8_LDA
#undef PG8_LDB
#undef PG8_MMA
}

constexpr int KROW = 144, VROW = 136;
constexpr int L_KB = 0, L_VB = 2 * 64 * KROW, L_FB = L_VB + 2 * 64 * VROW, L_RELB = L_FB + 512, L_OST = L_RELB + 1280, L_UW = L_OST + 8 * 32 * KROW, L_ATT_END = L_UW + 8 * 128 * 4;
static_assert(L_ATT_END <= LDS_BYTES, "lds");
constexpr float TH_DEFER = 8.0f;
constexpr float PRUNE_NAT = 60.0f;

template <int MODE>
__device__ __forceinline__ void attn_unit(const bf16_t* __restrict__ QKVZ, const bf16_t* __restrict__ VT, const float* __restrict__ aux,
                                          bf16_t* __restrict__ G, int b, int h, int qb, int jlo, const float* __restrict__ nrm) {
    unsigned char* lds = g_shm;
    int tid = threadIdx.x; asm volatile("" : "+v"(tid));
    const int w = tid >> 6, lane = tid & 63, q = lane & 31, hh = lane >> 5;
    const int r0 = qb * 256 + w * 32, t = r0 + q;
    const int jhi = qb * 4 + 3, cw = qb * 4 + (w >> 1);
    const int lrow = tid >> 3, lch = tid & 7;
    const bf16_t* kbase = QKVZ + ((long)(b * SEQ + lrow)) * 4096 + 1024 + h * 64 + lch * 8;
    const bf16_t* vbase = VT + ((long)((b * NH + h) * 64 + lrow)) * SEQ + lch * 8;
    const float* fbase = aux + (long)(b * NH + h) * SEQ;
    constexpr float SC = 0.125f * LOG2E;

    __syncthreads();
    bf16x8 qf[4];
    {
        const bf16_t* qp = QKVZ + ((long)(b * SEQ + t)) * 4096 + h * 64 + hh * 8;
#pragma unroll
        for (int ks = 0; ks < 4; ++ks) qf[ks] = *(const bf16x8*)(qp + ks * 16);
    }
    float Ft = 0.f;
    if (MODE == 1) Ft = fbase[t] * LOG2E;
    u32x4 k0r, v0r, k1r, v1r, k2r, v2r; float f0r = 0.f, f1r = 0.f, f2r = 0.f;
    k0r = *(const u32x4*)(kbase + (long)jhi * 64 * 4096);       v0r = *(const u32x4*)(vbase + jhi * 64);
    k1r = *(const u32x4*)(kbase + (long)(jhi - 1) * 64 * 4096); v1r = *(const u32x4*)(vbase + (jhi - 1) * 64);
    k2r = *(const u32x4*)(kbase + (long)(jhi - 2) * 64 * 4096); v2r = *(const u32x4*)(vbase + (jhi - 2) * 64);
    if (MODE == 1) { if (tid < 64) { f0r = fbase[jhi * 64 + tid]; f1r = fbase[(jhi - 1) * 64 + tid]; f2r = fbase[(jhi - 2) * 64 + tid]; } }
    u32x4 zpre[4];
#pragma unroll
    for (int i = 0; i < 4; ++i) zpre[i] = *(const u32x4*)(QKVZ + (long)(b * SEQ + r0 + (lane >> 3) + 8 * i) * 4096 + 3072 + h * 64 + (lane & 7) * 8);
    if (MODE == 1) {
        int* JL = (int*)(lds + L_RELB);
        const float* NQ = nrm + ((long)(b * 128)) * 32 + 2 * h;
        const float* NK = nrm + ((long)(1024 + b * 128)) * 32 + 2 * h;
        float Qa = 0.f, Qb = 0.f, Bd = 0.f;
#pragma unroll
        for (int i = 0; i < 4; ++i) { Qa = fmaxf(Qa, sqrtf(ld_coh(NQ + (4 * qb + i) * 32))); Qb = fmaxf(Qb, sqrtf(ld_coh(NQ + (4 * qb + i) * 32 + 1))); }
#pragma unroll
        for (int i = 0; i < 4; ++i) Bd = fmaxf(Bd, Qa * sqrtf(ld_coh(NK + (4 * qb + i) * 32)) + Qb * sqrtf(ld_coh(NK + (4 * qb + i) * 32 + 1)));
        if (tid == 0) *JL = 4 * qb;
        __syncthreads();
        if (tid < 4 * qb) {
            const float Bj = Qa * sqrtf(ld_coh(NK + tid * 32)) + Qb * sqrtf(ld_coh(NK + tid * 32 + 1));
            const float Dj = ld_coh(fbase + 256 * qb) - ld_coh(fbase + 64 * tid + 63);
            if (!((Bj + Bd) * 0.125f + Dj < -PRUNE_NAT)) atomicMin(JL, tid);
        }
        __syncthreads();
        jlo = *JL;
        float* UW = (float*)(lds + L_UW) + w * 128;
        const float qa = sqrtf(ld_coh(NQ + cw * 32)), qbb = sqrtf(ld_coh(NQ + cw * 32 + 1));
        const float Fr0 = ld_coh(fbase + r0);
        for (int jr = lane; jr < cw - jlo; jr += 64) {
            const int j = jlo + jr;
            const float ka = sqrtf(ld_coh(NK + j * 32)), kb = sqrtf(ld_coh(NK + j * 32 + 1));
            UW[jr] = (qa * ka + qbb * kb) * SC + (Fr0 - ld_coh(fbase + 64 * j + 63)) * LOG2E;
        }
    }
    if (MODE == 0) { if (tid < 288) { int rl = 192 - tid; rl = rl < -128 ? -128 : (rl > 128 ? 128 : rl); ((float*)(lds + L_RELB))[tid] = aux[h * 257 + rl + 128] * LOG2E; } }

    f32x16 O0, O1;
#pragma unroll
    for (int i = 0; i < 16; ++i) { O0[i] = 0.f; O1[i] = 0.f; }
    float m_run = 0.f, l_run = 0.f, m_min = -1e30f;
    bool first = true;

    auto LOADT = [&](u32x4& kr, u32x4& vr, float& fr_, int jj) __attribute__((always_inline)) {
        if (jj >= jlo) {
            kr = *(const u32x4*)(kbase + (long)jj * 64 * 4096);
            vr = *(const u32x4*)(vbase + jj * 64);
            if (MODE == 1) { if (tid < 64) fr_ = fbase[jj * 64 + tid]; }
        }
    };
    auto STEP = [&](u32x4& kreg, u32x4& vreg, float& freg, int j) __attribute__((always_inline)) {
        const int buf = (jhi - j) & 1;
        unsigned char* KB = lds + L_KB + buf * 64 * KROW;
        unsigned char* VB = lds + L_VB + buf * 64 * VROW;
        float* FB = (float*)(lds + L_FB + buf * 256);
        *(u32x4*)(KB + lrow * KROW + lch * 16) = kreg;
        *(u32x2*)(VB + lrow * VROW + lch * 16) = (u32x2){vreg.x, vreg.y};
        *(u32x2*)(VB + lrow * VROW + lch * 16 + 8) = (u32x2){vreg.z, vreg.w};
        if (MODE == 1) { if (tid < 64) FB[tid] = freg * LOG2E; }
        __syncthreads();
        LOADT(kreg, vreg, freg, j - 3);
        bool active;
        if (MODE == 0) active = (j >= cw - 8 && j <= cw);
        else {
            active = (j <= cw);
            if (j < cw) { const float ub = ((const float*)(lds + L_UW))[w * 128 + (j - jlo)]; if (ub - m_min < -PRUNE_NAT * LOG2E) active = false; }
        }
        if (active) {
            f32x16 s0, s1;
#pragma unroll
            for (int i = 0; i < 16; ++i) { s0[i] = 0.f; s1[i] = 0.f; }
#pragma unroll
            for (int ks = 0; ks < 4; ++ks) {
                const bf16x8 k0 = *(const bf16x8*)(KB + q * KROW + (16 * ks + 8 * hh) * 2);
                const bf16x8 k1 = *(const bf16x8*)(KB + (32 + q) * KROW + (16 * ks + 8 * hh) * 2);
                s0 = __builtin_amdgcn_mfma_f32_32x32x16_bf16(k0, qf[ks], s0, 0, 0, 0);
                s1 = __builtin_amdgcn_mfma_f32_32x32x16_bf16(k1, qf[ks], s1, 0, 0, 0);
            }
            if (MODE == 0) {
                const float* RB = (const float*)(lds + L_RELB);
                if (r0 - (64 * j + 63) >= 128) {
                    const float cb = RB[64] - m_run;
#pragma unroll
                    for (int i = 0; i < 16; ++i) { s0[i] = s0[i] * SC + cb; s1[i] = s1[i] * SC + cb; }
                } else {
                    const float* Rp = RB + (192 - (t - 64 * j - 4 * hh));
#pragma unroll
                    for (int i = 0; i < 16; ++i) {
                        s0[i] = s0[i] * SC + (Rp[(i & 3) + 8 * (i >> 2)] - m_run);
                        s1[i] = s1[i] * SC + (Rp[(i & 3) + 8 * (i >> 2) + 32] - m_run);
                    }
                }
            } else {
                const bool diag = (j == cw);
                const float base = Ft - m_run;
#pragma unroll
                for (int g = 0; g < 4; ++g) {
                    const f32x4 f0 = *(const f32x4*)(FB + 8 * g + 4 * hh);
                    const f32x4 f1 = *(const f32x4*)(FB + 32 + 8 * g + 4 * hh);
#pragma unroll
                    for (int e = 0; e < 4; ++e) {
                        const int i = 4 * g + e;
                        float x0 = s0[i] * SC + (base - f0[e]);
                        float x1 = s1[i] * SC + (base - f1[e]);
                        if (diag) {
                            const int sp = 64 * j + 8 * g + 4 * hh + e;
                            if (sp > t) x0 = -1e30f;
                            if (sp + 32 > t) x1 = -1e30f;
                        }
                        s0[i] = x0; s1[i] = x1;
                    }
                }
            }
            float mx = s0[0];
#pragma unroll
            for (int i = 1; i < 16; ++i) mx = fmaxf(mx, s0[i]);
#pragma unroll
            for (int i = 0; i < 16; ++i) mx = fmaxf(mx, s1[i]);
            if (first || __any(mx > TH_DEFER)) {
                mx = fmaxf(mx, __shfl_xor(mx, 32));
                float d;
                if (first) { d = mx; }
                else {
                    d = fmaxf(mx, 0.f);
                    const float al = __builtin_amdgcn_exp2f(-d);
                    l_run *= al;
#pragma unroll
                    for (int i = 0; i < 16; ++i) { O0[i] *= al; O1[i] *= al; }
                }
                m_run += d;
#pragma unroll
                for (int i = 0; i < 16; ++i) { s0[i] -= d; s1[i] -= d; }
                first = false;
                if (MODE == 1) {
                    float mm = m_run;
#pragma unroll
                    for (int o = 32; o >= 1; o >>= 1) mm = fminf(mm, __shfl_xor(mm, o));
                    m_min = mm;
                }
            }
            float ps = 0.f;
#pragma unroll
            for (int i = 0; i < 16; ++i) { s0[i] = __builtin_amdgcn_exp2f(s0[i]); s1[i] = __builtin_amdgcn_exp2f(s1[i]); ps += s0[i] + s1[i]; }
            l_run += ps;
#pragma unroll
            for (int s = 0; s < 4; ++s) {
                u32x4 pw;
                if (s < 2) { pw.x = cvt_pk_bf16(s0[8 * s + 0], s0[8 * s + 1]); pw.y = cvt_pk_bf16(s0[8 * s + 2], s0[8 * s + 3]); pw.z = cvt_pk_bf16(s0[8 * s + 4], s0[8 * s + 5]); pw.w = cvt_pk_bf16(s0[8 * s + 6], s0[8 * s + 7]); }
                else { const int sp = s - 2; pw.x = cvt_pk_bf16(s1[8 * sp + 0], s1[8 * sp + 1]); pw.y = cvt_pk_bf16(s1[8 * sp + 2], s1[8 * sp + 3]); pw.z = cvt_pk_bf16(s1[8 * sp + 4], s1[8 * sp + 5]); pw.w = cvt_pk_bf16(s1[8 * sp + 6], s1[8 * sp + 7]); }
                const bf16x8 pf = __builtin_bit_cast(bf16x8, pw);
                {
                    const u32x2 lo = *(const u32x2*)(VB + q * VROW + (16 * s + 4 * hh) * 2);
                    const u32x2 hi = *(const u32x2*)(VB + q * VROW + (16 * s + 8 + 4 * hh) * 2);
                    const bf16x8 vf = __builtin_bit_cast(bf16x8, ((u32x4){lo.x, lo.y, hi.x, hi.y}));
                    O0 = __builtin_amdgcn_mfma_f32_32x32x16_bf16(vf, pf, O0, 0, 0, 0);
                }
                {
                    const u32x2 lo = *(const u32x2*)(VB + (32 + q) * VROW + (16 * s + 4 * hh) * 2);
                    const u32x2 hi = *(const u32x2*)(VB + (32 + q) * VROW + (16 * s + 8 + 4 * hh) * 2);
                    const bf16x8 vf = __builtin_bit_cast(bf16x8, ((u32x4){lo.x, lo.y, hi.x, hi.y}));
                    O1 = __builtin_amdgcn_mfma_f32_32x32x16_bf16(vf, pf, O1, 0, 0, 0);
                }
            }
        }
    };
    for (int j = jhi; j >= jlo; j -= 3) {
        STEP(k0r, v0r, f0r, j);
        if (j - 1 >= jlo) STEP(k1r, v1r, f1r, j - 1);
        if (j - 2 >= jlo) STEP(k2r, v2r, f2r, j - 2);
    }
    const float lt = l_run + __shfl_xor(l_run, 32);
    const float inv = 1.0f / lt;
    unsigned char* OST = lds + L_OST + w * 32 * KROW;
#pragma unroll
    for (int g = 0; g < 4; ++g) {
        u32x2 w0, w1;
        w0.x = cvt_pk_bf16(O0[4 * g + 0] * inv, O0[4 * g + 1] * inv); w0.y = cvt_pk_bf16(O0[4 * g + 2] * inv, O0[4 * g + 3] * inv);
        w1.x = cvt_pk_bf16(O1[4 * g + 0] * inv, O1[4 * g + 1] * inv); w1.y = cvt_pk_bf16(O1[4 * g + 2] * inv, O1[4 * g + 3] * inv);
        *(u32x2*)(OST + q * KROW + (8 * g + 4 * hh) * 2) = w0;
        *(u32x2*)(OST + q * KROW + (32 + 8 * g + 4 * hh) * 2) = w1;
    }
    __syncthreads();
#pragma unroll
    for (int i = 0; i < 4; ++i) {
        const int row = (lane >> 3) + 8 * i, ch = lane & 7;
        const u32x4 o8 = *(const u32x4*)(OST + row * KROW + ch * 16);
        const long tok = (long)(b * SEQ + r0 + row);
        const u32x4 z8 = zpre[i];
        u32x4 r8;
#pragma unroll
        for (int e = 0; e < 4; ++e) {
            const unsigned ou = o8[e], zu = z8[e];
            const float z0 = bf_lo(zu), z1 = bf_hi(zu);
            const float g0 = bf_lo(ou) * z0 / (1.0f + __expf(-z0));
            const float g1 = bf_hi(ou) * z1 / (1.0f + __expf(-z1));
            r8[e] = cvt_pk_bf16(g0, g1);
        }
        *(u32x4*)(G + tok * 1024 + h * 64 + ch * 8) = r8;
    }
}

__device__ __forceinline__ void transpose_w(const float* __restrict__ src, int N, bf16_t* __restrict__ dst, int tile) {
    float* T = (float*)g_shm;
    int tid = threadIdx.x; asm volatile("" : "+v"(tid));
    const int ntn = N / 64, kt = tile / ntn, ntl = tile % ntn, k0 = kt * 64, n0 = ntl * 64;
    __syncthreads();
#pragma unroll
    for (int e = 0; e < 8; ++e) { const int idx = tid + 512 * e, kk = idx >> 6, nn = idx & 63; T[kk * 65 + nn] = src[(long)(k0 + kk) * N + n0 + nn]; }
    __syncthreads();
#pragma unroll
    for (int e = 0; e < 4; ++e) { const int idx = tid + 512 * e, nn = idx >> 5, kp = idx & 31;
        *(unsigned*)(dst + (long)(n0 + nn) * 1024 + k0 + 2 * kp) = cvt_pk_bf16(T[(2 * kp) * 65 + nn], T[(2 * kp + 1) * 65 + nn]); }
}

__device__ __forceinline__ float log_sigmoid(float z) { return fminf(z, 0.f) - log1pf(expf(-fabsf(z))); }

__device__ __forceinline__ void ln_phase(float* __restrict__ io, bf16_t* __restrict__ XB, const float* __restrict__ g, const float* __restrict__ bta,
                                         const float* __restrict__ wf, const float* __restrict__ bf, float* __restrict__ LOGF) {
    int tid = threadIdx.x; asm volatile("" : "+v"(tid));
    const int w = tid >> 6, lane = tid & 63;
    f32x4* WF = (f32x4*)g_shm;
    if (wf) {
        __syncthreads();
        for (int idx = tid; idx < 4096; idx += 512) {
            const int ln = idx & 63, hq = (idx >> 6) & 3, ie = idx >> 8, k = 4 * (ln + 64 * (ie >> 2)) + (ie & 3);
            WF[idx] = *(const f32x4*)(wf + k * 16 + 4 * hq);
        }
        __syncthreads();
    }
    f32x4 gv[4], bv[4];
#pragma unroll
    for (int i = 0; i < 4; ++i) { gv[i] = *(const f32x4*)(g + 4 * (lane + 64 * i)); bv[i] = *(const f32x4*)(bta + 4 * (lane + 64 * i)); }
    const int G_ = gridDim.x, c_ = blockIdx.x;
    const int nri = (c_ < 256) ? ((256 - c_ + G_ - 1) / G_) * 32 : 0;
    auto row_of = [&](int ri) __attribute__((always_inline)) { return (c_ + (ri >> 5) * G_) * 256 + w + 8 * (ri & 31); };
    f32x4 nv[4];
    if (nri > 0) {
        const int row = row_of(0);
#pragma unroll
        for (int i = 0; i < 4; ++i) nv[i] = *(const f32x4*)(io + (long)row * 1024 + 4 * (lane + 64 * i));
    }
    for (int ri = 0; ri < nri; ++ri) {
        const int row = row_of(ri);
        float* rp = io + (long)row * 1024;
        f32x4 v[4];
#pragma unroll
        for (int i = 0; i < 4; ++i) v[i] = nv[i];
        if (ri + 1 < nri) {
            const int nrow = row_of(ri + 1);
#pragma unroll
            for (int i = 0; i < 4; ++i) nv[i] = *(const f32x4*)(io + (long)nrow * 1024 + 4 * (lane + 64 * i));
        }
        float s = 0.f;
#pragma unroll
        for (int i = 0; i < 4; ++i) s += (v[i][0] + v[i][1]) + (v[i][2] + v[i][3]);
#pragma unroll
        for (int o = 32; o >= 1; o >>= 1) s += __shfl_xor(s, o);
        const float mu = s * (1.0f / 1024.0f);
        float qs = 0.f;
#pragma unroll
        for (int i = 0; i < 4; ++i) { v[i] = v[i] - mu; qs += (v[i][0] * v[i][0] + v[i][1] * v[i][1]) + (v[i][2] * v[i][2] + v[i][3] * v[i][3]); }
#pragma unroll
        for (int o = 32; o >= 1; o >>= 1) qs += __shfl_xor(qs, o);
        const float rstd = 1.0f / sqrtf(qs * (1.0f / 1024.0f) + LN_EPS);
#pragma unroll
        for (int i = 0; i < 4; ++i) {
            v[i] = v[i] * rstd * gv[i] + bv[i];
            *(f32x4*)(rp + 4 * (lane + 64 * i)) = v[i];
            if (XB) { u32x2 pk; pk.x = cvt_pk_bf16(v[i][0], v[i][1]); pk.y = cvt_pk_bf16(v[i][2], v[i][3]);
                *(u32x2*)(XB + (long)row * 1024 + 4 * (lane + 64 * i)) = pk; }
        }
        if (wf) {
            float a[16];
#pragma unroll
            for (int c = 0; c < 16; ++c) a[c] = 0.f;
#pragma unroll
            for (int i = 0; i < 4; ++i)
#pragma unroll
                for (int e = 0; e < 4; ++e) {
                    const float xv = v[i][e];
#pragma unroll
                    for (int hq = 0; hq < 4; ++hq) {
                        const f32x4 w4 = WF[((i * 4 + e) * 4 + hq) * 64 + lane];
                        a[4 * hq + 0] += xv * w4[0]; a[4 * hq + 1] += xv * w4[1]; a[4 * hq + 2] += xv * w4[2]; a[4 * hq + 3] += xv * w4[3];
                    }
                }
#pragma unroll
            for (int i = 0; i < 8; ++i) { const bool up = (lane & 32) != 0; const float send = up ? a[i] : a[i + 8], keep = up ? a[i + 8] : a[i]; a[i] = keep + __shfl_xor(send, 32); }
#pragma unroll
            for (int i = 0; i < 4; ++i) { const bool up = (lane & 16) != 0; const float send = up ? a[i] : a[i + 4], keep = up ? a[i + 4] : a[i]; a[i] = keep + __shfl_xor(send, 16); }
#pragma unroll
            for (int i = 0; i < 2; ++i) { const bool up = (lane & 8) != 0; const float send = up ? a[i] : a[i + 2], keep = up ? a[i + 2] : a[i]; a[i] = keep + __shfl_xor(send, 8); }
            { const bool up = (lane & 4) != 0; const float send = up ? a[0] : a[1], keep = up ? a[1] : a[0]; a[0] = keep + __shfl_xor(send, 4); }
            a[0] += __shfl_xor(a[0], 2); a[0] += __shfl_xor(a[0], 1);
            if ((lane & 3) == 0) {
                const int hd = ((lane >> 5) & 1) * 8 + ((lane >> 4) & 1) * 4 + ((lane >> 3) & 1) * 2 + ((lane >> 2) & 1);
                const int bb = row / SEQ, ss = row % SEQ;
                LOGF[((long)(bb * NH + hd)) * SEQ + ss] = log_sigmoid(a[0] + bf[hd]);
            }
        }
    }
}

__device__ __forceinline__ void scan_phase(float* __restrict__ F) {
    float* red = (float*)g_shm;
    int tid = threadIdx.x; asm volatile("" : "+v"(tid));
    const int w = tid >> 6, lane = tid & 63;
    for (int bh = blockIdx.x; bh < NB * NH; bh += gridDim.x) {
        float* p = F + (long)bh * SEQ + tid * 16;
        f32x4 v[4];
#pragma unroll
        for (int i = 0; i < 4; ++i) v[i] = *(const f32x4*)(p + 4 * i);
        float run = 0.f;
#pragma unroll
        for (int i = 0; i < 4; ++i)
#pragma unroll
            for (int e = 0; e < 4; ++e) { run += v[i][e]; v[i][e] = run; }
        float inc = run;
#pragma unroll
        for (int o = 1; o < 64; o <<= 1) { const float y = __shfl_up(inc, o); if (lane >= o) inc += y; }
        __syncthreads();
        if (lane == 63) red[w] = inc;
        __syncthreads();
        float base = inc - run;
        for (int ww = 0; ww < w; ++ww) base += red[ww];
#pragma unroll
        for (int i = 0; i < 4; ++i) { v[i] = v[i] + base; *(f32x4*)(p + 4 * i) = v[i]; }
    }
}

__device__ __forceinline__ void grid_bar(unsigned* ctr, unsigned target) {
    __syncthreads();
    if (threadIdx.x == 0) {
        __builtin_amdgcn_fence(__ATOMIC_RELEASE, "agent");
        __hip_atomic_fetch_add(ctr, 1u, __ATOMIC_RELAXED, __HIP_MEMORY_SCOPE_AGENT);
        while (__hip_atomic_load(ctr, __ATOMIC_RELAXED, __HIP_MEMORY_SCOPE_AGENT) < target) __builtin_amdgcn_s_sleep(4);
        __builtin_amdgcn_fence(__ATOMIC_ACQUIRE, "agent");
    }
    __syncthreads();
}

__global__ void __launch_bounds__(512, 2) fwd_megakernel(Params p) {
    cg::grid_group grid = cg::this_grid();
    bf16_t* XB = (bf16_t*)(p.ws + WS_XB);
    bf16_t* QKVZ = (bf16_t*)(p.ws + WS_QKVZ);
    bf16_t* VT = (bf16_t*)(p.ws + WS_VT);
    bf16_t* G = (bf16_t*)(p.ws + WS_G);
    bf16_t* WIN = (bf16_t*)(p.ws + WS_WIN);
    bf16_t* WOUT = (bf16_t*)(p.ws + WS_WOUT);
    float* F = (float*)(p.ws + WS_F);
    float* NRM = (float*)(p.ws + WS_NRM);
    unsigned* CTR = (unsigned*)(p.ws + WS_CTR);
    unsigned bar_gen = 0;
#define GRID_BAR() do { ++bar_gen; grid_bar(CTR, bar_gen * gridDim.x); } while (0)
    const int tid = threadIdx.x;
    LAS unsigned char* lds = (LAS unsigned char*)g_shm;

    if (blockIdx.x == 0 && tid == 0) __hip_atomic_store(CTR, 0u, __ATOMIC_RELAXED, __HIP_MEMORY_SCOPE_AGENT);
    {
        const long nvec = (long)MTOK * 1024 / 8;
#pragma unroll 4
        for (long i = (long)blockIdx.x * 512 + tid; i < nvec; i += (long)gridDim.x * 512) {
            const f32x4 a = *(const f32x4*)(p.x + i * 8), c = *(const f32x4*)(p.x + i * 8 + 4);
            u32x4 o; o.x = cvt_pk_bf16(a[0], a[1]); o.y = cvt_pk_bf16(a[2], a[3]); o.z = cvt_pk_bf16(c[0], c[1]); o.w = cvt_pk_bf16(c[2], c[3]);
            *(u32x4*)(XB + i * 8) = o;
        }
        for (int u = blockIdx.x; u < DEPTH * 1280; u += gridDim.x) {
            const int l = u / 1280, tl = u % 1280;
            if (tl < 1024) {
                const float* src = ((l & 1) ? p.w_in_b : p.w_in_a) + (long)(l >> 1) * 1024 * 4096;
                transpose_w(src, 4096, WIN + (long)l * 4096 * 1024, tl);
            } else {
                const float* src = ((l & 1) ? p.w_out_b : p.w_out_a) + (long)(l >> 1) * 1024 * 1024;
                transpose_w(src, 1024, WOUT + (long)l * 1024 * 1024, tl - 1024);
            }
        }
    }
    grid.sync();

#pragma unroll 1
    for (int layer = 0; layer < DEPTH; ++layer) {
        const bool isB = (layer & 1) != 0;
        const bf16_t* Wi = WIN + (long)layer * 4096 * 1024;
        const bf16_t* Wo = WOUT + (long)layer * 1024 * 1024;
        if (isB) scan_phase(F);
        {
            Sched S; S.mode = 0; S.XB = (const char*)XB; S.W = (const char*)Wi; S.G = gridDim.x; S.c = blockIdx.x;
            Epi E; E.mode = 0; E.QKVZ = QKVZ; E.VT = VT; E.xin = nullptr; E.of = nullptr; E.nrm = isB ? NRM : nullptr;
            __syncthreads();
            gemm_phase(lds, S, E);
        }
        GRID_BAR();
        for (int u = blockIdx.x; u < 4096; u += gridDim.x) {
            const int c = u & 255, i = u >> 8;
            int qb = c >> 3;
            if (isB && (i & 1)) qb = 31 - qb;
            const int b = c & 7, h = i;
            if (!isB) attn_unit<0>(QKVZ, VT, p.rel_bias_a + (long)(layer >> 1) * NH * 257, G, b, h, qb, (qb * 4 - 8) > 0 ? (qb * 4 - 8) : 0, nullptr);
            else attn_unit<1>(QKVZ, VT, F, G, b, h, qb, 0, NRM);
        }
        GRID_BAR();
        {
            Sched S; S.mode = 1; S.XB = (const char*)G; S.W = (const char*)Wo; S.G = gridDim.x; S.c = blockIdx.x;
            Epi E; E.mode = 1; E.QKVZ = nullptr; E.VT = nullptr; E.xin = (layer == 0) ? p.x : p.out; E.of = p.out; E.nrm = nullptr;
            __syncthreads();
            gemm_phase(lds, S, E);
        }
        __syncthreads();
        {
            const bool nextB = (layer + 1 < DEPTH) && ((layer + 1) & 1);
            const int jn = (layer + 1) >> 1;
            ln_phase(p.out, (layer + 1 < DEPTH) ? XB : nullptr, p.ln_g + layer * 1024, p.ln_b + layer * 1024,
                     nextB ? p.w_f_b + (long)jn * 1024 * 16 : nullptr, nextB ? p.b_f_b + jn * 16 : nullptr, F);
        }
        if (layer + 1 < DEPTH) GRID_BAR();
    }
}

extern "C" void kernel_launch(void* const* d_in, const int* in_sizes, int n_in, void* d_out, int out_size, void* d_ws, size_t ws_size, hipStream_t stream) {
    static int grid_blocks = 0;
    if (grid_blocks == 0) {
        if (ws_size < WS_END) { fprintf(stderr, "kernel_launch: workspace too small (%zu < %zu)\n", ws_size, (size_t)WS_END); grid_blocks = -1; return; }
        int dev = 0, cus = 0, per_cu = 0;
        hipGetDevice(&dev);
        hipDeviceGetAttribute(&cus, hipDeviceAttributeMultiprocessorCount, dev);
        hipFuncSetAttribute((const void*)fwd_megakernel, hipFuncAttributeMaxDynamicSharedMemorySize, LDS_BYTES);
        hipOccupancyMaxActiveBlocksPerMultiprocessor(&per_cu, (const void*)fwd_megakernel, 512, LDS_BYTES);
        if (per_cu < 1) { fprintf(stderr, "kernel_launch: occupancy query says %d blocks per CU\n", per_cu); per_cu = 1; }
        grid_blocks = cus * 1;
        (void)hipGetLastError();
    }
    if (grid_blocks < 0) return;
    Params p{};
    p.x = (const float*)d_in[0]; p.w_in_a = (const float*)d_in[1]; p.rel_bias_a = (const float*)d_in[2]; p.w_out_a = (const float*)d_in[3];
    p.w_in_b = (const float*)d_in[4]; p.w_f_b = (const float*)d_in[5]; p.b_f_b = (const float*)d_in[6]; p.w_out_b = (const float*)d_in[7];
    p.ln_g = (const float*)d_in[8]; p.ln_b = (const float*)d_in[9];
    p.out = (float*)d_out; p.ws = (unsigned char*)d_ws;
    void* args[] = {&p};
    hipError_t e = hipLaunchCooperativeKernel((const void*)fwd_megakernel, dim3(grid_blocks), dim3(512), args, LDS_BYTES, stream);
    if (e != hipSuccess) fprintf(stderr, "cooperative launch failed: %s (grid %d)\n", hipGetErrorString(e), grid_blocks);
}
```

```cpp
#include <hip/hip_runtime.h>
#include <hip/hip_cooperative_groups.h>
#include <cstdio>
#include <cstdint>
namespace cg = cooperative_groups;

typedef unsigned short bf16_t;
typedef short bf16x8 __attribute__((ext_vector_type(8)));
typedef float f32x4 __attribute__((ext_vector_type(4)));
typedef float f32x16 __attribute__((ext_vector_type(16)));
typedef unsigned u32x4 __attribute__((ext_vector_type(4)));
typedef unsigned u32x2 __attribute__((ext_vector_type(2)));

constexpr int DM = 1024, NB = 8, SEQ = 8192, MTOK = NB * SEQ, NH = 16, DEPTH = 4;
constexpr float LN_EPS = 1e-5f;
constexpr float ALPHA = 1.681792830507429f;
constexpr float LOG2E = 1.4426950408889634f;
constexpr int LDS_BYTES = 131072;

constexpr size_t WS_XB = 0;
constexpr size_t WS_QKVZ = WS_XB + (size_t)MTOK * 1024 * 2;
constexpr size_t WS_VT = WS_QKVZ + (size_t)MTOK * 4096 * 2;
constexpr size_t WS_G = WS_VT + (size_t)MTOK * 1024 * 2;
constexpr size_t WS_WIN = WS_G + (size_t)MTOK * 1024 * 2;
constexpr size_t WS_WOUT = WS_WIN + (size_t)DEPTH * 4096 * 1024 * 2;
constexpr size_t WS_F = WS_WOUT + (size_t)DEPTH * 1024 * 1024 * 2;
constexpr size_t WS_NRM = WS_F + (size_t)NB * NH * SEQ * 4;
constexpr size_t WS_CTR = WS_NRM + (size_t)2 * 1024 * 128 * 4;
constexpr size_t WS_STATS = WS_CTR + 256;
constexpr size_t WS_END = WS_STATS + (size_t)MTOK * 2 * 4;

extern __shared__ __attribute__((aligned(16))) unsigned char g_shm[];

struct Params {
    const float* x; const float* w_in_a; const float* rel_bias_a; const float* w_out_a;
    const float* w_in_b; const float* w_f_b; const float* b_f_b; const float* w_out_b;
    const float* ln_g; const float* ln_b;
    float* out; unsigned char* ws;
};

typedef __bf16 bf16x2_t __attribute__((ext_vector_type(2)));
typedef float f32x2_t __attribute__((ext_vector_type(2)));
__device__ __forceinline__ unsigned cvt_pk_bf16(float lo, float hi) { const f32x2_t v = {lo, hi}; const bf16x2_t r = __builtin_convertvector(v, bf16x2_t); return __builtin_bit_cast(unsigned, r); }
__device__ __forceinline__ float ld_coh(const float* p) { return __hip_atomic_load(p, __ATOMIC_RELAXED, __HIP_MEMORY_SCOPE_AGENT); }
template <int CTRL> __device__ __forceinline__ float dpp_f(float v) { return __int_as_float(__builtin_amdgcn_update_dpp(0, __float_as_int(v), CTRL, 0xf, 0xf, false)); }
__device__ __forceinline__ float bf_lo(unsigned u) { return __uint_as_float(u << 16); }
__device__ __forceinline__ float bf_hi(unsigned u) { return __uint_as_float(u & 0xffff0000u); }

#define LAS __attribute__((address_space(3)))
constexpr int BK = 64, HALF = 128, HTB = HALF * BK * 2, GK = 1024;
__device__ __forceinline__ int lds_byte(int r, int c) { const int st = (r >> 4) * 2 + (c >> 5), rr = r & 15, cc = c & 31, ob = rr * 64 + cc * 2; return st * 1024 + (ob ^ (((ob >> 9) & 1) << 5)); }
__device__ __forceinline__ void stage_rc(int b, int& R, int& C) { const int st = b / 1024, sb = b % 1024, swz = sb ^ (((sb >> 9) & 1) << 5); R = (st >> 1) * 16 + swz / 64; C = (st & 1) * 32 + (swz % 64) / 2; }
__device__ __forceinline__ int perm32(int rho) { const int n = rho >> 4, i = rho & 15; return 8 * (i >> 2) + 4 * n + (i & 3); }

__device__ __forceinline__ void tile_map(int L, int nM, int nN, int& pm, int& pn) {
    const int nwg = nM * nN; int wgid = L;
    { const int q = nwg / 8, r = nwg % 8, xcd = wgid % 8, off = wgid / 8; wgid = (xcd < r ? xcd * (q + 1) : r * (q + 1) + (xcd - r) * q) + off; }
    const int nig = 8 * nN, gid = wgid / nig, fm = gid * 8, gsz = (nM - fm) < 8 ? (nM - fm) : 8;
    pm = fm + ((wgid % nig) % gsz); pn = (wgid % nig) / gsz;
}

struct Unit { int pm, pn; };
constexpr size_t TSTEP = (size_t)256 * GK * 2;
struct Sched {
    int mode;
    const char* XB; const char* W; int G, c;
    __device__ __forceinline__ bool next(int i, Unit& u) const {
        if (mode == 1) { const int panel = c + (i >> 2) * G; if (panel >= 256) return false; u.pm = panel; u.pn = i & 3; return true; }
        const long L = (long)i * G + c; if (L >= 4096) return false;
        tile_map((int)L, 256, 16, u.pm, u.pn); return true;
    }
    __device__ __forceinline__ bool vt(const Unit& u) const { return mode == 0 && u.pn >= 8 && u.pn < 12; }
    __device__ __forceinline__ const char* pA(const Unit& u) const { return vt(u) ? W + (size_t)u.pn * TSTEP : XB + (size_t)u.pm * TSTEP; }
    __device__ __forceinline__ const char* pB(const Unit& u) const { return vt(u) ? XB + (size_t)u.pm * TSTEP : W + (size_t)u.pn * TSTEP; }
};
struct Epi {
    int mode; bf16_t* QKVZ; bf16_t* VT; const float* xin; float* of; float* nrm;
    const float* stats; const float* gp; const float* bp;
    __device__ __forceinline__ void operator()(const f32x4 (&acc)[2][2][4][2], const Unit& u, int wr, int wc, int fr, int fq) const {
        if (mode == 0) {
            bf16_t* ob; long ldo;
            if (u.pn >= 8 && u.pn < 12) { ob = VT + ((long)((u.pm >> 5) * 1024 + (u.pn - 8) * 256)) * SEQ + (u.pm & 31) * 256; ldo = SEQ; }
            else { ob = QKVZ + (long)u.pm * 256 * 4096 + u.pn * 256; ldo = 4096; }
            if (nrm && u.pn < 8) {
                const int which = u.pn >> 2, pnl = u.pn & 3;
#pragma unroll
                for (int ai = 0; ai < 2; ++ai)
#pragma unroll
                    for (int bj = 0; bj < 2; ++bj) {
                        float mx = 0.f;
#pragma unroll
                        for (int m = 0; m < 4; ++m) {
                            const f32x4 v0 = acc[ai][bj][m][0], v1 = acc[ai][bj][m][1];
                            float s = (v0[0] * v0[0] + v0[1] * v0[1]) + (v0[2] * v0[2] + v0[3] * v0[3]) + (v1[0] * v1[0] + v1[1] * v1[1]) + (v1[2] * v1[2] + v1[3] * v1[3]);
                            s += __shfl_xor(s, 16); s += __shfl_xor(s, 32);
                            mx = fmaxf(mx, s);
                        }
                        mx = fmaxf(mx, dpp_f<0xB1>(mx)); mx = fmaxf(mx, dpp_f<0x4E>(mx)); mx = fmaxf(mx, dpp_f<0x141>(mx)); mx = fmaxf(mx, dpp_f<0x140>(mx));
                        if (fr == 0 && fq == 0) nrm[((long)which * 1024 + (u.pm * 4 + 2 * ai + wr)) * 32 + pnl * 8 + 4 * bj + wc] = mx * 1.02f;
                    }
            }
#pragma unroll
            for (int ai = 0; ai < 2; ++ai)
#pragma unroll
                for (int m = 0; m < 4; ++m) {
                    bf16_t* rp = ob + (long)(ai * HALF + wr * 64 + m * 16 + fr) * ldo + wc * 32 + fq * 8;
#pragma unroll
                    for (int bj = 0; bj < 2; ++bj) {
                        const f32x4 v0 = acc[ai][bj][m][0], v1 = acc[ai][bj][m][1];
                        u32x4 w; w.x = cvt_pk_bf16(v0[0], v0[1]); w.y = cvt_pk_bf16(v0[2], v0[3]); w.z = cvt_pk_bf16(v1[0], v1[1]); w.w = cvt_pk_bf16(v1[2], v1[3]);
                        *(u32x4*)(rp + bj * HALF) = w;
                    }
                }
        } else {
            const long o = (long)u.pm * 256 * 1024 + u.pn * 256;
            f32x4 gv[2][2], bv[2][2];
#pragma unroll
            for (int bj = 0; bj < 2; ++bj)
#pragma unroll
                for (int n = 0; n < 2; ++n) {
                    gv[bj][n] = (f32x4){1.f, 1.f, 1.f, 1.f}; bv[bj][n] = (f32x4){0.f, 0.f, 0.f, 0.f};
                    if (stats) { gv[bj][n] = *(const f32x4*)(gp + u.pn * 256 + wc * 32 + fq * 8 + bj * HALF + n * 4); bv[bj][n] = *(const f32x4*)(bp + u.pn * 256 + wc * 32 + fq * 8 + bj * HALF + n * 4); }
                }
#pragma unroll
            for (int ai = 0; ai < 2; ++ai)
#pragma unroll
                for (int m = 0; m < 4; ++m) {
                    const int row = u.pm * 256 + ai * HALF + wr * 64 + m * 16 + fr;
                    const long ro = o + (long)(ai * HALF + wr * 64 + m * 16 + fr) * 1024 + wc * 32 + fq * 8;
                    float mu = 0.f, rs = 1.f;
                    if (stats) { mu = stats[2 * row]; rs = stats[2 * row + 1]; }
#pragma unroll
                    for (int bj = 0; bj < 2; ++bj)
#pragma unroll
                        for (int n = 0; n < 2; ++n) {
                            f32x4 xv = *(const f32x4*)(xin + ro + bj * HALF + n * 4);
                            if (stats) xv = (xv - mu) * rs * gv[bj][n] + bv[bj][n];
                            const f32x4 r = xv * ALPHA + acc[ai][bj][m][n];
                            *(f32x4*)(of + ro + bj * HALF + n * 4) = r;
                        }
                }
        }
    }
};

__device__ __forceinline__ void gemm_phase(LAS unsigned char* lds, const Sched& S, const Epi& E) {
    int tid = threadIdx.x; asm volatile("" : "+v"(tid));
    const int wid = __builtin_amdgcn_readfirstlane(tid >> 6), lane = tid & 63, wr = wid >> 2, wc = wid & 3, fr = lane & 15, fq = lane >> 4;
    constexpr int K = GK, nt = K / BK;
    unsigned voffA[2], voffB[2];
#pragma unroll
    for (int i = 0; i < 2; ++i) { int R, C; stage_rc(tid * 16 + i * 8192, R, C); const int Rb = (R & ~31) + perm32(R & 31);
        voffA[i] = (unsigned)(R * K + C) * 2u; voffB[i] = (unsigned)(Rb * K + C) * 2u; }
    constexpr size_t kstep = (size_t)(BK * 2);
    constexpr size_t hstep = (size_t)HALF * K * 2;
    const unsigned ldsw = (unsigned)wid * 1024u;
    const int aoff = lds_byte(wr * 64 + fr, fq * 8), boff = lds_byte(wc * 32 + fr, fq * 8);
#define PG8_SA(b, h) (((b) * 2 + (h)) * HTB)
#define PG8_SB(b, h) ((4 + (b) * 2 + (h)) * HTB)
#define PG8_STAGE(bufoff, gbase, voff) do { _Pragma("unroll") for (int _i = 0; _i < 2; ++_i) \
        __builtin_amdgcn_global_load_lds((const unsigned*)((const char*)(gbase) + (voff)[_i]), (LAS unsigned*)(lds + (bufoff) + ldsw + _i * 8192), 16, 0, 0); } while (0)
#define PG8_LDA(dst, b, h) do { _Pragma("unroll") for (int m = 0; m < 4; ++m) _Pragma("unroll") for (int k = 0; k < 2; ++k) dst[m][k] = *(const LAS bf16x8*)(lds + PG8_SA(b, h) + aoff + m * 2048 + k * 1024); } while (0)
#define PG8_LDB(dst, b, h) do { _Pragma("unroll") for (int n = 0; n < 2; ++n) _Pragma("unroll") for (int k = 0; k < 2; ++k) dst[n][k] = *(const LAS bf16x8*)(lds + PG8_SB(b, h) + boff + n * 2048 + k * 1024); } while (0)
#define PG8_MMA(ai, bj, At, Bt) do { __builtin_amdgcn_s_setprio(1); _Pragma("unroll") for (int m = 0; m < 4; ++m) _Pragma("unroll") for (int n = 0; n < 2; ++n) _Pragma("unroll") for (int k = 0; k < 2; ++k) \
        acc[ai][bj][m][n] = __builtin_amdgcn_mfma_f32_16x16x32_bf16(Bt[n][k], At[m][k], acc[ai][bj][m][n], 0, 0, 0); __builtin_amdgcn_s_setprio(0); } while (0)
#define PG8_WAIT_V(n) asm volatile("s_waitcnt vmcnt(" #n ")" ::: "memory")
#define PG8_WAIT_L(n) asm volatile("s_waitcnt lgkmcnt(" #n ")" ::: "memory")
#define PG8_BAR __builtin_amdgcn_s_barrier()
#define PG8_SCHED __builtin_amdgcn_sched_barrier(0)
    Unit cur, nxt; int ui = 0;
    if (!S.next(0, cur)) return;
    f32x4 acc[2][2][4][2];
#pragma unroll
    for (int a = 0; a < 2; ++a)
#pragma unroll
        for (int b = 0; b < 2; ++b)
#pragma unroll
            for (int m = 0; m < 4; ++m)
#pragma unroll
                for (int n = 0; n < 2; ++n) acc[a][b][m][n] = (f32x4){0.f, 0.f, 0.f, 0.f};
    bf16x8 At[4][2], B0[2][2], B1[2][2];
    const char* cA = S.pA(cur); const char* cB = S.pB(cur);
    PG8_STAGE(PG8_SB(0, 0), cB, voffB); PG8_STAGE(PG8_SB(0, 1), cB + hstep, voffB); PG8_STAGE(PG8_SA(0, 0), cA, voffA); PG8_STAGE(PG8_SA(0, 1), cA + hstep, voffA);
    if (wr == 1) PG8_BAR;
    PG8_WAIT_V(2); PG8_BAR;
    PG8_STAGE(PG8_SB(1, 0), cB + kstep, voffB); PG8_STAGE(PG8_SA(1, 0), cA + kstep, voffA); PG8_STAGE(PG8_SB(1, 1), cB + hstep + kstep, voffB);
    PG8_WAIT_V(6); PG8_BAR;
    for (;;) {
        const bool has_next = S.next(ui + 1, nxt);
        const char* nA = has_next ? S.pA(nxt) : cA; const char* nB = has_next ? S.pB(nxt) : cB;
        for (int t = 0; t < nt; t += 2) {
            const bool last = (t == nt - 2);
            const char* a1 = cA + (size_t)(t + 1) * kstep;
            const char* a2 = last ? nA : cA + (size_t)(t + 2) * kstep; const char* b2 = last ? nB : cB + (size_t)(t + 2) * kstep;
            const char* a3 = a2 + kstep; const char* b3 = b2 + kstep;
            PG8_LDB(B0, 0, 0); PG8_LDB(B1, 0, 1); PG8_SCHED; PG8_LDA(At, 0, 0); PG8_STAGE(PG8_SA(1, 1), a1 + hstep, voffA);
            PG8_WAIT_V(8); PG8_WAIT_L(0); PG8_BAR; PG8_MMA(0, 0, At, B0); PG8_MMA(0, 1, At, B1); PG8_BAR; PG8_SCHED;
            PG8_LDA(At, 0, 1); PG8_STAGE(PG8_SB(0, 0), b2, voffB); PG8_STAGE(PG8_SB(0, 1), b2 + hstep, voffB); PG8_STAGE(PG8_SA(0, 0), a2, voffA);
            PG8_WAIT_V(8); PG8_WAIT_L(0); PG8_BAR; PG8_MMA(1, 0, At, B0); PG8_MMA(1, 1, At, B1); PG8_BAR; PG8_SCHED;
            PG8_LDB(B0, 1, 0); PG8_LDB(B1, 1, 1); PG8_SCHED; PG8_LDA(At, 1, 0); PG8_STAGE(PG8_SA(0, 1), a2 + hstep, voffA);
            PG8_WAIT_V(8); PG8_WAIT_L(0); PG8_BAR; PG8_MMA(0, 0, At, B0); PG8_MMA(0, 1, At, B1); PG8_BAR; PG8_SCHED;
            PG8_LDA(At, 1, 1); PG8_STAGE(PG8_SB(1, 0), b3, voffB); PG8_STAGE(PG8_SB(1, 1), b3 + hstep, voffB); PG8_STAGE(PG8_SA(1, 0), a3, voffA);
            PG8_WAIT_V(8); PG8_WAIT_L(0); PG8_BAR; PG8_MMA(1, 0, At, B0); PG8_MMA(1, 1, At, B1); PG8_BAR; PG8_SCHED;
        }
        if (wr == 0) PG8_BAR;
        E(acc, cur, wr, wc, fr, fq);
        if (!has_next) break;
#pragma unroll
        for (int a = 0; a < 2; ++a)
#pragma unroll
            for (int b = 0; b < 2; ++b)
#pragma unroll
                for (int m = 0; m < 4; ++m)
#pragma unroll
                    for (int n = 0; n < 2; ++n) acc[a][b][m][n] = (f32x4){0.f, 0.f, 0.f, 0.f};
        cur = nxt; cA = nA; cB = nB; ++ui;
        if (wr == 1) PG8_BAR;
    }
    PG8_WAIT_V(0);
    PG8_BAR;
#undef PG8_SA
#undef PG8_SB
#undef PG8_STAGE
#undef PG8_LDA
#undef PG8_LDB
#undef PG8_MMA
}

constexpr int KROW = 144, VROW = 136;
constexpr int L_KB = 0, L_VB = 2 * 64 * KROW, L_FB = L_VB + 2 * 64 * VROW, L_RELB = L_FB + 512, L_OST = L_RELB + 1280, L_UW = L_OST + 8 * 32 * KROW, L_ATT_END = L_UW + 8 * 128 * 4;
static_assert(L_ATT_END <= LDS_BYTES, "lds");
constexpr float TH_DEFER = 8.0f;
constexpr float PRUNE_NAT = 60.0f;

template <int MODE>
__device__ __forceinline__ void attn_unit(const bf16_t* __restrict__ QKVZ, const bf16_t* __restrict__ VT, const float* __restrict__ aux,
                                          bf16_t* __restrict__ G, int b, int h, int qb, int jlo, const float* __restrict__ nrm) {
    unsigned char* lds = g_shm;
    int tid = threadIdx.x; asm volatile("" : "+v"(tid));
    const int w = tid >> 6, lane = tid & 63, q = lane & 31, hh = lane >> 5;
    const int r0 = qb * 256 + w * 32, t = r0 + q;
    const int jhi = qb * 4 + 3, cw = qb * 4 + (w >> 1);
    const int lrow = tid >> 3, lch = tid & 7;
    const bf16_t* kbase = QKVZ + ((long)(b * SEQ + lrow)) * 4096 + 1024 + h * 64 + lch * 8;
    const bf16_t* vbase = VT + ((long)((b * NH + h) * 64 + lrow)) * SEQ + lch * 8;
    const float* fbase = aux + (long)(b * NH + h) * SEQ;
    constexpr float SC = 0.125f * LOG2E;

    __syncthreads();
    bf16x8 qf[4];
    {
        const bf16_t* qp = QKVZ + ((long)(b * SEQ + t)) * 4096 + h * 64 + hh * 8;
#pragma unroll
        for (int ks = 0; ks < 4; ++ks) qf[ks] = *(const bf16x8*)(qp + ks * 16);
    }
    float Ft = 0.f;
    if (MODE == 1) Ft = fbase[t] * LOG2E;
    u32x4 k0r, v0r, k1r, v1r, k2r, v2r; float f0r = 0.f, f1r = 0.f, f2r = 0.f;
    k0r = *(const u32x4*)(kbase + (long)jhi * 64 * 4096);       v0r = *(const u32x4*)(vbase + jhi * 64);
    k1r = *(const u32x4*)(kbase + (long)(jhi - 1) * 64 * 4096); v1r = *(const u32x4*)(vbase + (jhi - 1) * 64);
    k2r = *(const u32x4*)(kbase + (long)(jhi - 2) * 64 * 4096); v2r = *(const u32x4*)(vbase + (jhi - 2) * 64);
    if (MODE == 1) { if (tid < 64) { f0r = fbase[jhi * 64 + tid]; f1r = fbase[(jhi - 1) * 64 + tid]; f2r = fbase[(jhi - 2) * 64 + tid]; } }
    u32x4 zpre[4];
#pragma unroll
    for (int i = 0; i < 4; ++i) zpre[i] = *(const u32x4*)(QKVZ + (long)(b * SEQ + r0 + (lane >> 3) + 8 * i) * 4096 + 3072 + h * 64 + (lane & 7) * 8);
    if (MODE == 1) {
        int* JL = (int*)(lds + L_RELB);
        const float* NQ = nrm + ((long)(b * 128)) * 32 + 2 * h;
        const float* NK = nrm + ((long)(1024 + b * 128)) * 32 + 2 * h;
        float Qa = 0.f, Qb = 0.f, Bd = 0.f;
#pragma unroll
        for (int i = 0; i < 4; ++i) { Qa = fmaxf(Qa, sqrtf(ld_coh(NQ + (4 * qb + i) * 32))); Qb = fmaxf(Qb, sqrtf(ld_coh(NQ + (4 * qb + i) * 32 + 1))); }
#pragma unroll
        for (int i = 0; i < 4; ++i) Bd = fmaxf(Bd, Qa * sqrtf(ld_coh(NK + (4 * qb + i) * 32)) + Qb * sqrtf(ld_coh(NK + (4 * qb + i) * 32 + 1)));
        if (tid == 0) *JL = 4 * qb;
        __syncthreads();
        if (tid < 4 * qb) {
            const float Bj = Qa * sqrtf(ld_coh(NK + tid * 32)) + Qb * sqrtf(ld_coh(NK + tid * 32 + 1));
            const float Dj = ld_coh(fbase + 256 * qb) - ld_coh(fbase + 64 * tid + 63);
            if (!((Bj + Bd) * 0.125f + Dj < -PRUNE_NAT)) atomicMin(JL, tid);
        }
        __syncthreads();
        jlo = *JL;
        float* UW = (float*)(lds + L_UW) + w * 128;
        const float qa = sqrtf(ld_coh(NQ + cw * 32)), qbb = sqrtf(ld_coh(NQ + cw * 32 + 1));
        const float Fr0 = ld_coh(fbase + r0);
        for (int jr = lane; jr < cw - jlo; jr += 64) {
            const int j = jlo + jr;
            const float ka = sqrtf(ld_coh(NK + j * 32)), kb = sqrtf(ld_coh(NK + j * 32 + 1));
            UW[jr] = (qa * ka + qbb * kb) * SC + (Fr0 - ld_coh(fbase + 64 * j + 63)) * LOG2E;
        }
    }
    if (MODE == 0) { if (tid < 288) { int rl = 192 - tid; rl = rl < -128 ? -128 : (rl > 128 ? 128 : rl); ((float*)(lds + L_RELB))[tid] = aux[h * 257 + rl + 128] * LOG2E; } }

    f32x16 O0, O1;
#pragma unroll
    for (int i = 0; i < 16; ++i) { O0[i] = 0.f; O1[i] = 0.f; }
    float m_run = 0.f, l_run = 0.f, m_min = -1e30f;
    bool first = true;

    auto LOADT = [&](u32x4& kr, u32x4& vr, float& fr_, int jj) __attribute__((always_inline)) {
        if (jj >= jlo) {
            kr = *(const u32x4*)(kbase + (long)jj * 64 * 4096);
            vr = *(const u32x4*)(vbase + jj * 64);
            if (MODE == 1) { if (tid < 64) fr_ = fbase[jj * 64 + tid]; }
        }
    };
    auto STEP = [&](u32x4& kreg, u32x4& vreg, float& freg, int j) __attribute__((always_inline)) {
        const int buf = (jhi - j) & 1;
        unsigned char* KB = lds + L_KB + buf * 64 * KROW;
        unsigned char* VB = lds + L_VB + buf * 64 * VROW;
        float* FB = (float*)(lds + L_FB + buf * 256);
        *(u32x4*)(KB + lrow * KROW + lch * 16) = kreg;
        *(u32x2*)(VB + lrow * VROW + lch * 16) = (u32x2){vreg.x, vreg.y};
        *(u32x2*)(VB + lrow * VROW + lch * 16 + 8) = (u32x2){vreg.z, vreg.w};
        if (MODE == 1) { if (tid < 64) FB[tid] = freg * LOG2E; }
        __syncthreads();
        LOADT(kreg, vreg, freg, j - 3);
        bool active;
        if (MODE == 0) active = (j >= cw - 8 && j <= cw);
        else {
            active = (j <= cw);
            if (j < cw) { const float ub = ((const float*)(lds + L_UW))[w * 128 + (j - jlo)]; if (ub - m_min < -PRUNE_NAT * LOG2E) active = false; }
        }
        if (active) {
            f32x16 s0, s1;
#pragma unroll
            for (int i = 0; i < 16; ++i) { s0[i] = 0.f; s1[i] = 0.f; }
#pragma unroll
            for (int ks = 0; ks < 4; ++ks) {
                const bf16x8 k0 = *(const bf16x8*)(KB + q * KROW + (16 * ks + 8 * hh) * 2);
                const bf16x8 k1 = *(const bf16x8*)(KB + (32 + q) * KROW + (16 * ks + 8 * hh) * 2);
                s0 = __builtin_amdgcn_mfma_f32_32x32x16_bf16(k0, qf[ks], s0, 0, 0, 0);
                s1 = __builtin_amdgcn_mfma_f32_32x32x16_bf16(k1, qf[ks], s1, 0, 0, 0);
            }
            if (MODE == 0) {
                const float* RB = (const float*)(lds + L_RELB);
                if (r0 - (64 * j + 63) >= 128) {
                    const float cb = RB[64] - m_run;
#pragma unroll
                    for (int i = 0; i < 16; ++i) { s0[i] = s0[i] * SC + cb; s1[i] = s1[i] * SC + cb; }
                } else {
                    const float* Rp = RB + (192 - (t - 64 * j - 4 * hh));
#pragma unroll
                    for (int i = 0; i < 16; ++i) {
                        s0[i] = s0[i] * SC + (Rp[(i & 3) + 8 * (i >> 2)] - m_run);
                        s1[i] = s1[i] * SC + (Rp[(i & 3) + 8 * (i >> 2) + 32] - m_run);
                    }
                }
            } else {
                const bool diag = (j == cw);
                const float base = Ft - m_run;
#pragma unroll
                for (int g = 0; g < 4; ++g) {
                    const f32x4 f0 = *(const f32x4*)(FB + 8 * g + 4 * hh);
                    const f32x4 f1 = *(const f32x4*)(FB + 32 + 8 * g + 4 * hh);
#pragma unroll
                    for (int e = 0; e < 4; ++e) {
                        const int i = 4 * g + e;
                        float x0 = s0[i] * SC + (base - f0[e]);
                        float x1 = s1[i] * SC + (base - f1[e]);
                        if (diag) {
                            const int sp = 64 * j + 8 * g + 4 * hh + e;
                            if (sp > t) x0 = -1e30f;
                            if (sp + 32 > t) x1 = -1e30f;
                        }
                        s0[i] = x0; s1[i] = x1;
                    }
                }
            }
            float mx = s0[0];
#pragma unroll
            for (int i = 1; i < 16; ++i) mx = fmaxf(mx, s0[i]);
#pragma unroll
            for (int i = 0; i < 16; ++i) mx = fmaxf(mx, s1[i]);
            if (first || __any(mx > TH_DEFER)) {
                mx = fmaxf(mx, __shfl_xor(mx, 32));
                float d;
                if (first) { d = mx; }
                else {
                    d = fmaxf(mx, 0.f);
                    const float al = __builtin_amdgcn_exp2f(-d);
                    l_run *= al;
#pragma unroll
                    for (int i = 0; i < 16; ++i) { O0[i] *= al; O1[i] *= al; }
                }
                m_run += d;
#pragma unroll
                for (int i = 0; i < 16; ++i) { s0[i] -= d; s1[i] -= d; }
                first = false;
                if (MODE == 1) {
                    float mm = m_run;
#pragma unroll
                    for (int o = 32; o >= 1; o >>= 1) mm = fminf(mm, __shfl_xor(mm, o));
                    m_min = mm;
                }
            }
            float ps = 0.f;
#pragma unroll
            for (int i = 0; i < 16; ++i) { s0[i] = __builtin_amdgcn_exp2f(s0[i]); s1[i] = __builtin_amdgcn_exp2f(s1[i]); ps += s0[i] + s1[i]; }
            l_run += ps;
#pragma unroll
            for (int s = 0; s < 4; ++s) {
                u32x4 pw;
                if (s < 2) { pw.x = cvt_pk_bf16(s0[8 * s + 0], s0[8 * s + 1]); pw.y = cvt_pk_bf16(s0[8 * s + 2], s0[8 * s + 3]); pw.z = cvt_pk_bf16(s0[8 * s + 4], s0[8 * s + 5]); pw.w = cvt_pk_bf16(s0[8 * s + 6], s0[8 * s + 7]); }
                else { const int sp = s - 2; pw.x = cvt_pk_bf16(s1[8 * sp + 0], s1[8 * sp + 1]); pw.y = cvt_pk_bf16(s1[8 * sp + 2], s1[8 * sp + 3]); pw.z = cvt_pk_bf16(s1[8 * sp + 4], s1[8 * sp + 5]); pw.w = cvt_pk_bf16(s1[8 * sp + 6], s1[8 * sp + 7]); }
                const bf16x8 pf = __builtin_bit_cast(bf16x8, pw);
                {
                    const u32x2 lo = *(const u32x2*)(VB + q * VROW + (16 * s + 4 * hh) * 2);
                    const u32x2 hi = *(const u32x2*)(VB + q * VROW + (16 * s + 8 + 4 * hh) * 2);
                    const bf16x8 vf = __builtin_bit_cast(bf16x8, ((u32x4){lo.x, lo.y, hi.x, hi.y}));
                    O0 = __builtin_amdgcn_mfma_f32_32x32x16_bf16(vf, pf, O0, 0, 0, 0);
                }
                {
                    const u32x2 lo = *(const u32x2*)(VB + (32 + q) * VROW + (16 * s + 4 * hh) * 2);
                    const u32x2 hi = *(const u32x2*)(VB + (32 + q) * VROW + (16 * s + 8 + 4 * hh) * 2);
                    const bf16x8 vf = __builtin_bit_cast(bf16x8, ((u32x4){lo.x, lo.y, hi.x, hi.y}));
                    O1 = __builtin_amdgcn_mfma_f32_32x32x16_bf16(vf, pf, O1, 0, 0, 0);
                }
            }
        }
    };
    for (int j = jhi; j >= jlo; j -= 3) {
        STEP(k0r, v0r, f0r, j);
        if (j - 1 >= jlo) STEP(k1r, v1r, f1r, j - 1);
        if (j - 2 >= jlo) STEP(k2r, v2r, f2r, j - 2);
    }
    const float lt = l_run + __shfl_xor(l_run, 32);
    const float inv = 1.0f / lt;
    unsigned char* OST = lds + L_OST + w * 32 * KROW;
#pragma unroll
    for (int g = 0; g < 4; ++g) {
        u32x2 w0, w1;
        w0.x = cvt_pk_bf16(O0[4 * g + 0] * inv, O0[4 * g + 1] * inv); w0.y = cvt_pk_bf16(O0[4 * g + 2] * inv, O0[4 * g + 3] * inv);
        w1.x = cvt_pk_bf16(O1[4 * g + 0] * inv, O1[4 * g + 1] * inv); w1.y = cvt_pk_bf16(O1[4 * g + 2] * inv, O1[4 * g + 3] * inv);
        *(u32x2*)(OST + q * KROW + (8 * g + 4 * hh) * 2) = w0;
        *(u32x2*)(OST + q * KROW + (32 + 8 * g + 4 * hh) * 2) = w1;
    }
    __syncthreads();
#pragma unroll
    for (int i = 0; i < 4; ++i) {
        const int row = (lane >> 3) + 8 * i, ch = lane & 7;
        const u32x4 o8 = *(const u32x4*)(OST + row * KROW + ch * 16);
        const long tok = (long)(b * SEQ + r0 + row);
        const u32x4 z8 = zpre[i];
        u32x4 r8;
#pragma unroll
        for (int e = 0; e < 4; ++e) {
            const unsigned ou = o8[e], zu = z8[e];
            const float z0 = bf_lo(zu), z1 = bf_hi(zu);
            const float g0 = bf_lo(ou) * z0 / (1.0f + __expf(-z0));
            const float g1 = bf_hi(ou) * z1 / (1.0f + __expf(-z1));
            r8[e] = cvt_pk_bf16(g0, g1);
        }
        *(u32x4*)(G + tok * 1024 + h * 64 + ch * 8) = r8;
    }
}

__device__ __forceinline__ void transpose_w(const float* __restrict__ src, int N, bf16_t* __restrict__ dst, int tile) {
    float* T = (float*)g_shm;
    int tid = threadIdx.x; asm volatile("" : "+v"(tid));
    const int ntn = N / 64, kt = tile / ntn, ntl = tile % ntn, k0 = kt * 64, n0 = ntl * 64;
    __syncthreads();
#pragma unroll
    for (int e = 0; e < 8; ++e) { const int idx = tid + 512 * e, kk = idx >> 6, nn = idx & 63; T[kk * 65 + nn] = src[(long)(k0 + kk) * N + n0 + nn]; }
    __syncthreads();
#pragma unroll
    for (int e = 0; e < 4; ++e) { const int idx = tid + 512 * e, nn = idx >> 5, kp = idx & 31;
        *(unsigned*)(dst + (long)(n0 + nn) * 1024 + k0 + 2 * kp) = cvt_pk_bf16(T[(2 * kp) * 65 + nn], T[(2 * kp + 1) * 65 + nn]); }
}

__device__ __forceinline__ float log_sigmoid(float z) { return fminf(z, 0.f) - log1pf(expf(-fabsf(z))); }

__device__ __forceinline__ void ln_phase(float* __restrict__ io, bf16_t* __restrict__ XB, const float* __restrict__ g, const float* __restrict__ bta,
                                         const float* __restrict__ wf, const float* __restrict__ bf, float* __restrict__ LOGF,
                                         float* __restrict__ stats, const bool write_x) {
    int tid = threadIdx.x; asm volatile("" : "+v"(tid));
    const int w = tid >> 6, lane = tid & 63;
    f32x4* WF = (f32x4*)g_shm;
    if (wf) {
        __syncthreads();
        for (int idx = tid; idx < 4096; idx += 512) {
            const int ln = idx & 63, hq = (idx >> 6) & 3, ie = idx >> 8, k = 4 * (ln + 64 * (ie >> 2)) + (ie & 3);
            WF[idx] = *(const f32x4*)(wf + k * 16 + 4 * hq);
        }
        __syncthreads();
    }
    f32x4 gv[4], bv[4];
#pragma unroll
    for (int i = 0; i < 4; ++i) { gv[i] = *(const f32x4*)(g + 4 * (lane + 64 * i)); bv[i] = *(const f32x4*)(bta + 4 * (lane + 64 * i)); }
    const int G_ = gridDim.x, c_ = blockIdx.x;
    const int nri = (c_ < 256) ? ((256 - c_ + G_ - 1) / G_) * 32 : 0;
    auto row_of = [&](int ri) __attribute__((always_inline)) { return (c_ + (ri >> 5) * G_) * 256 + w + 8 * (ri & 31); };
    f32x4 nv[4];
    if (nri > 0) {
        const int row = row_of(0);
#pragma unroll
        for (int i = 0; i < 4; ++i) nv[i] = *(const f32x4*)(io + (long)row * 1024 + 4 * (lane + 64 * i));
    }
    for (int ri = 0; ri < nri; ++ri) {
        const int row = row_of(ri);
        float* rp = io + (long)row * 1024;
        f32x4 v[4];
#pragma unroll
        for (int i = 0; i < 4; ++i) v[i] = nv[i];
        if (ri + 1 < nri) {
            const int nrow = row_of(ri + 1);
#pragma unroll
            for (int i = 0; i < 4; ++i) nv[i] = *(const f32x4*)(io + (long)nrow * 1024 + 4 * (lane + 64 * i));
        }
        float s = 0.f;
#pragma unroll
        for (int i = 0; i < 4; ++i) s += (v[i][0] + v[i][1]) + (v[i][2] + v[i][3]);
#pragma unroll
        for (int o = 32; o >= 1; o >>= 1) s += __shfl_xor(s, o);
        const float mu = s * (1.0f / 1024.0f);
        float qs = 0.f;
#pragma unroll
        for (int i = 0; i < 4; ++i) { v[i] = v[i] - mu; qs += (v[i][0] * v[i][0] + v[i][1] * v[i][1]) + (v[i][2] * v[i][2] + v[i][3] * v[i][3]); }
#pragma unroll
        for (int o = 32; o >= 1; o >>= 1) qs += __shfl_xor(qs, o);
        const float rstd = 1.0f / sqrtf(qs * (1.0f / 1024.0f) + LN_EPS);
        if (!write_x && lane == 0) { stats[2 * row] = mu; stats[2 * row + 1] = rstd; }
#pragma unroll
        for (int i = 0; i < 4; ++i) {
            v[i] = v[i] * rstd * gv[i] + bv[i];
            if (write_x) *(f32x4*)(rp + 4 * (lane + 64 * i)) = v[i];
            if (XB) { u32x2 pk; pk.x = cvt_pk_bf16(v[i][0], v[i][1]); pk.y = cvt_pk_bf16(v[i][2], v[i][3]);
                *(u32x2*)(XB + (long)row * 1024 + 4 * (lane + 64 * i)) = pk; }
        }
        if (wf) {
            float a[16];
#pragma unroll
            for (int c = 0; c < 16; ++c) a[c] = 0.f;
#pragma unroll
            for (int i = 0; i < 4; ++i)
#pragma unroll
                for (int e = 0; e < 4; ++e) {
                    const float xv = v[i][e];
#pragma unroll
                    for (int hq = 0; hq < 4; ++hq) {
                        const f32x4 w4 = WF[((i * 4 + e) * 4 + hq) * 64 + lane];
                        a[4 * hq + 0] += xv * w4[0]; a[4 * hq + 1] += xv * w4[1]; a[4 * hq + 2] += xv * w4[2]; a[4 * hq + 3] += xv * w4[3];
                    }
                }
#pragma unroll
            for (int i = 0; i < 8; ++i) { const bool up = (lane & 32) != 0; const float send = up ? a[i] : a[i + 8], keep = up ? a[i + 8] : a[i]; a[i] = keep + __shfl_xor(send, 32); }
#pragma unroll
            for (int i = 0; i < 4; ++i) { const bool up = (lane & 16) != 0; const float send = up ? a[i] : a[i + 4], keep = up ? a[i + 4] : a[i]; a[i] = keep + __shfl_xor(send, 16); }
#pragma unroll
            for (int i = 0; i < 2; ++i) { const bool up = (lane & 8) != 0; const float send = up ? a[i] : a[i + 2], keep = up ? a[i + 2] : a[i]; a[i] = keep + __shfl_xor(send, 8); }
            { const bool up = (lane & 4) != 0; const float send = up ? a[0] : a[1], keep = up ? a[1] : a[0]; a[0] = keep + __shfl_xor(send, 4); }
            a[0] += __shfl_xor(a[0], 2); a[0] += __shfl_xor(a[0], 1);
            if ((lane & 3) == 0) {
                const int hd = ((lane >> 5) & 1) * 8 + ((lane >> 4) & 1) * 4 + ((lane >> 3) & 1) * 2 + ((lane >> 2) & 1);
                const int bb = row / SEQ, ss = row % SEQ;
                LOGF[((long)(bb * NH + hd)) * SEQ + ss] = log_sigmoid(a[0] + bf[hd]);
            }
        }
    }
}

__device__ __forceinline__ void scan_phase(float* __restrict__ F) {
    float* red = (float*)g_shm;
    int tid = threadIdx.x; asm volatile("" : "+v"(tid));
    const int w = tid >> 6, lane = tid & 63;
    for (int bh = blockIdx.x; bh < NB * NH; bh += gridDim.x) {
        float* p = F + (long)bh * SEQ + tid * 16;
        f32x4 v[4];
#pragma unroll
        for (int i = 0; i < 4; ++i) v[i] = *(const f32x4*)(p + 4 * i);
        float run = 0.f;
#pragma unroll
        for (int i = 0; i < 4; ++i)
#pragma unroll
            for (int e = 0; e < 4; ++e) { run += v[i][e]; v[i][e] = run; }
        float inc = run;
#pragma unroll
        for (int o = 1; o < 64; o <<= 1) { const float y = __shfl_up(inc, o); if (lane >= o) inc += y; }
        __syncthreads();
        if (lane == 63) red[w] = inc;
        __syncthreads();
        float base = inc - run;
        for (int ww = 0; ww < w; ++ww) base += red[ww];
#pragma unroll
        for (int i = 0; i < 4; ++i) { v[i] = v[i] + base; *(f32x4*)(p + 4 * i) = v[i]; }
    }
}

__device__ __forceinline__ void grid_bar(unsigned* ctr, unsigned target) {
    __syncthreads();
    if (threadIdx.x == 0) {
        __builtin_amdgcn_fence(__ATOMIC_RELEASE, "agent");
        __hip_atomic_fetch_add(ctr, 1u, __ATOMIC_RELAXED, __HIP_MEMORY_SCOPE_AGENT);
        while (__hip_atomic_load(ctr, __ATOMIC_RELAXED, __HIP_MEMORY_SCOPE_AGENT) < target) __builtin_amdgcn_s_sleep(4);
        __builtin_amdgcn_fence(__ATOMIC_ACQUIRE, "agent");
    }
    __syncthreads();
}

__global__ void __launch_bounds__(512, 2) fwd_megakernel(Params p) {
    cg::grid_group grid = cg::this_grid();
    bf16_t* XB = (bf16_t*)(p.ws + WS_XB);
    bf16_t* QKVZ = (bf16_t*)(p.ws + WS_QKVZ);
    bf16_t* VT = (bf16_t*)(p.ws + WS_VT);
    bf16_t* G = (bf16_t*)(p.ws + WS_G);
    bf16_t* WIN = (bf16_t*)(p.ws + WS_WIN);
    bf16_t* WOUT = (bf16_t*)(p.ws + WS_WOUT);
    float* F = (float*)(p.ws + WS_F);
    float* NRM = (float*)(p.ws + WS_NRM);
    unsigned* CTR = (unsigned*)(p.ws + WS_CTR);
    float* STATS = (float*)(p.ws + WS_STATS);
    unsigned bar_gen = 0;
#define GRID_BAR() do { ++bar_gen; grid_bar(CTR, bar_gen * gridDim.x); } while (0)
    const int tid = threadIdx.x;
    LAS unsigned char* lds = (LAS unsigned char*)g_shm;

    if (blockIdx.x == 0 && tid == 0) __hip_atomic_store(CTR, 0u, __ATOMIC_RELAXED, __HIP_MEMORY_SCOPE_AGENT);
    {
        const long nvec = (long)MTOK * 1024 / 8;
#pragma unroll 4
        for (long i = (long)blockIdx.x * 512 + tid; i < nvec; i += (long)gridDim.x * 512) {
            const f32x4 a = *(const f32x4*)(p.x + i * 8), c = *(const f32x4*)(p.x + i * 8 + 4);
            u32x4 o; o.x = cvt_pk_bf16(a[0], a[1]); o.y = cvt_pk_bf16(a[2], a[3]); o.z = cvt_pk_bf16(c[0], c[1]); o.w = cvt_pk_bf16(c[2], c[3]);
            *(u32x4*)(XB + i * 8) = o;
        }
        for (int u = blockIdx.x; u < DEPTH * 1280; u += gridDim.x) {
            const int l = u / 1280, tl = u % 1280;
            if (tl < 1024) {
                const float* src = ((l & 1) ? p.w_in_b : p.w_in_a) + (long)(l >> 1) * 1024 * 4096;
                transpose_w(src, 4096, WIN + (long)l * 4096 * 1024, tl);
            } else {
                const float* src = ((l & 1) ? p.w_out_b : p.w_out_a) + (long)(l >> 1) * 1024 * 1024;
                transpose_w(src, 1024, WOUT + (long)l * 1024 * 1024, tl - 1024);
            }
        }
    }
    grid.sync();

#pragma unroll 1
    for (int layer = 0; layer < DEPTH; ++layer) {
        const bool isB = (layer & 1) != 0;
        const bf16_t* Wi = WIN + (long)layer * 4096 * 1024;
        const bf16_t* Wo = WOUT + (long)layer * 1024 * 1024;
        if (isB) scan_phase(F);
        {
            Sched S; S.mode = 0; S.XB = (const char*)XB; S.W = (const char*)Wi; S.G = gridDim.x; S.c = blockIdx.x;
            Epi E; E.mode = 0; E.QKVZ = QKVZ; E.VT = VT; E.xin = nullptr; E.of = nullptr; E.nrm = isB ? NRM : nullptr; E.stats = nullptr; E.gp = nullptr; E.bp = nullptr;
            __syncthreads();
            gemm_phase(lds, S, E);
        }
        GRID_BAR();
        for (int u = blockIdx.x; u < 4096; u += gridDim.x) {
            const int c = u & 255, i = u >> 8;
            int qb = c >> 3;
            if (isB && (i & 1)) qb = 31 - qb;
            const int b = c & 7, h = i;
            if (!isB) attn_unit<0>(QKVZ, VT, p.rel_bias_a + (long)(layer >> 1) * NH * 257, G, b, h, qb, (qb * 4 - 8) > 0 ? (qb * 4 - 8) : 0, nullptr);
            else attn_unit<1>(QKVZ, VT, F, G, b, h, qb, 0, NRM);
        }
        GRID_BAR();
        {
            Sched S; S.mode = 1; S.XB = (const char*)G; S.W = (const char*)Wo; S.G = gridDim.x; S.c = blockIdx.x;
            Epi E; E.mode = 1; E.QKVZ = nullptr; E.VT = nullptr; E.xin = (layer == 0) ? p.x : p.out; E.of = p.out; E.nrm = nullptr;
            E.stats = (layer == 0) ? nullptr : STATS; E.gp = p.ln_g + (layer > 0 ? layer - 1 : 0) * 1024; E.bp = p.ln_b + (layer > 0 ? layer - 1 : 0) * 1024;
            __syncthreads();
            gemm_phase(lds, S, E);
        }
        __syncthreads();
        {
            const bool nextB = (layer + 1 < DEPTH) && ((layer + 1) & 1);
            const int jn = (layer + 1) >> 1;
            ln_phase(p.out, (layer + 1 < DEPTH) ? XB : nullptr, p.ln_g + layer * 1024, p.ln_b + layer * 1024,
                     nextB ? p.w_f_b + (long)jn * 1024 * 16 : nullptr, nextB ? p.b_f_b + jn * 16 : nullptr, F, STATS, layer + 1 == DEPTH);
        }
        if (layer + 1 < DEPTH) GRID_BAR();
    }
}

extern "C" void kernel_launch(void* const* d_in, const int* in_sizes, int n_in, void* d_out, int out_size, void* d_ws, size_t ws_size, hipStream_t stream) {
    static int grid_blocks = 0;
    if (grid_blocks == 0) {
        if (ws_size < WS_END) { fprintf(stderr, "kernel_launch: workspace too small (%zu < %zu)\n", ws_size, (size_t)WS_END); grid_blocks = -1; return; }
        int dev = 0, cus = 0, per_cu = 0;
        hipGetDevice(&dev);
        hipDeviceGetAttribute(&cus, hipDeviceAttributeMultiprocessorCount, dev);
        hipFuncSetAttribute((const void*)fwd_megakernel, hipFuncAttributeMaxDynamicSharedMemorySize, LDS_BYTES);
        hipOccupancyMaxActiveBlocksPerMultiprocessor(&per_cu, (const void*)fwd_megakernel, 512, LDS_BYTES);
        if (per_cu < 1) { fprintf(stderr, "kernel_launch: occupancy query says %d blocks per CU\n", per_cu); per_cu = 1; }
        grid_blocks = cus * 1;
        (void)hipGetLastError();
    }
    if (grid_blocks < 0) return;
    Params p{};
    p.x = (const float*)d_in[0]; p.w_in_a = (const float*)d_in[1]; p.rel_bias_a = (const float*)d_in[2]; p.w_out_a = (const float*)d_in[3];
    p.w_in_b = (const float*)d_in[4]; p.w_f_b = (const float*)d_in[5]; p.b_f_b = (const float*)d_in[6]; p.w_out_b = (const float*)d_in[7];
    p.ln_g = (const float*)d_in[8]; p.ln_b = (const float*)d_in[9];
    p.out = (float*)d_out; p.ws = (unsigned char*)d_ws;
    void* args[] = {&p};
    hipError_t e = hipLaunchCooperativeKernel((const void*)fwd_megakernel, dim3(grid_blocks), dim3(512), args, LDS_BYTES, stream);
    if (e != hipSuccess) fprintf(stderr, "cooperative launch failed: %s (grid %d)\n", hipGetErrorString(e), grid_blocks);
}
```

```cpp
#include <hip/hip_runtime.h>
#include <hip/hip_cooperative_groups.h>
#include <cstdio>
#include <cstdint>
namespace cg = cooperative_groups;

typedef unsigned short bf16_t;
typedef short bf16x8 __attribute__((ext_vector_type(8)));
typedef float f32x4 __attribute__((ext_vector_type(4)));
typedef float f32x16 __attribute__((ext_vector_type(16)));
typedef unsigned u32x4 __attribute__((ext_vector_type(4)));
typedef unsigned u32x2 __attribute__((ext_vector_type(2)));

constexpr int DM = 1024, NB = 8, SEQ = 8192, MTOK = NB * SEQ, NH = 16, DEPTH = 4;
constexpr float LN_EPS = 1e-5f;
constexpr float ALPHA = 1.681792830507429f;
constexpr float LOG2E = 1.4426950408889634f;
constexpr int LDS_PHASE_BYTES = 131072;
constexpr int LDS_BYTES = LDS_PHASE_BYTES + 16;

constexpr size_t WS_XB = 0;
constexpr size_t WS_QKVZ = WS_XB + (size_t)MTOK * 1024 * 2;
constexpr size_t WS_VT = WS_QKVZ + (size_t)MTOK * 4096 * 2;
constexpr size_t WS_G = WS_VT + (size_t)MTOK * 1024 * 2;
constexpr size_t WS_WIN = WS_G + (size_t)MTOK * 1024 * 2;
constexpr size_t WS_WOUT = WS_WIN + (size_t)DEPTH * 4096 * 1024 * 2;
constexpr size_t WS_F = WS_WOUT + (size_t)DEPTH * 1024 * 1024 * 2;
constexpr size_t WS_NRM = WS_F + (size_t)NB * NH * SEQ * 4;
constexpr size_t WS_CTR = WS_NRM + (size_t)2 * 1024 * 128 * 4;
constexpr size_t WS_STATS = WS_CTR + 256;
constexpr size_t WS_XBAR = WS_STATS + (size_t)MTOK * 2 * 4;
constexpr size_t WS_END = WS_XBAR + 16384;

extern __shared__ __attribute__((aligned(16))) unsigned char g_shm[];

struct Params {
    const float* x; const float* w_in_a; const float* rel_bias_a; const float* w_out_a;
    const float* w_in_b; const float* w_f_b; const float* b_f_b; const float* w_out_b;
    const float* ln_g; const float* ln_b;
    float* out; unsigned char* ws;
};

typedef __bf16 bf16x2_t __attribute__((ext_vector_type(2)));
typedef float f32x2_t __attribute__((ext_vector_type(2)));
__device__ __forceinline__ unsigned cvt_pk_bf16(float lo, float hi) { const f32x2_t v = {lo, hi}; const bf16x2_t r = __builtin_convertvector(v, bf16x2_t); return __builtin_bit_cast(unsigned, r); }
__device__ __forceinline__ float ld_coh(const float* p) { return __hip_atomic_load(p, __ATOMIC_RELAXED, __HIP_MEMORY_SCOPE_AGENT); }
template <int CTRL> __device__ __forceinline__ float dpp_f(float v) { return __int_as_float(__builtin_amdgcn_update_dpp(0, __float_as_int(v), CTRL, 0xf, 0xf, false)); }
__device__ __forceinline__ float bf_lo(unsigned u) { return __uint_as_float(u << 16); }
__device__ __forceinline__ float bf_hi(unsigned u) { return __uint_as_float(u & 0xffff0000u); }

#define LAS __attribute__((address_space(3)))
constexpr int BK = 64, HALF = 128, HTB = HALF * BK * 2, GK = 1024;
__device__ __forceinline__ int lds_byte(int r, int c) { const int st = (r >> 4) * 2 + (c >> 5), rr = r & 15, cc = c & 31, ob = rr * 64 + cc * 2; return st * 1024 + (ob ^ (((ob >> 9) & 1) << 5)); }
__device__ __forceinline__ void stage_rc(int b, int& R, int& C) { const int st = b / 1024, sb = b % 1024, swz = sb ^ (((sb >> 9) & 1) << 5); R = (st >> 1) * 16 + swz / 64; C = (st & 1) * 32 + (swz % 64) / 2; }
__device__ __forceinline__ int perm32(int rho) { const int n = rho >> 4, i = rho & 15; return 8 * (i >> 2) + 4 * n + (i & 3); }

__device__ __forceinline__ void tile_map(int L, int nM, int nN, int& pm, int& pn) {
    const int nwg = nM * nN; int wgid = L;
    { const int q = nwg / 8, r = nwg % 8, xcd = wgid % 8, off = wgid / 8; wgid = (xcd < r ? xcd * (q + 1) : r * (q + 1) + (xcd - r) * q) + off; }
    const int nig = 8 * nN, gid = wgid / nig, fm = gid * 8, gsz = (nM - fm) < 8 ? (nM - fm) : 8;
    pm = fm + ((wgid % nig) % gsz); pn = (wgid % nig) / gsz;
}

struct Unit { int pm, pn; };
constexpr size_t TSTEP = (size_t)256 * GK * 2;
struct Sched {
    int mode;
    const char* XB; const char* W; int G, c;
    __device__ __forceinline__ bool next(int i, Unit& u) const {
        if (mode == 1) { const int panel = c + (i >> 2) * G; if (panel >= 256) return false; u.pm = panel; u.pn = i & 3; return true; }
        const long L = (long)i * G + c; if (L >= 4096) return false;
        tile_map((int)L, 256, 16, u.pm, u.pn); return true;
    }
    __device__ __forceinline__ bool vt(const Unit& u) const { return mode == 0 && u.pn >= 8 && u.pn < 12; }
    __device__ __forceinline__ const char* pA(const Unit& u) const { return vt(u) ? W + (size_t)u.pn * TSTEP : XB + (size_t)u.pm * TSTEP; }
    __device__ __forceinline__ const char* pB(const Unit& u) const { return vt(u) ? XB + (size_t)u.pm * TSTEP : W + (size_t)u.pn * TSTEP; }
};
struct Epi {
    int mode; bf16_t* QKVZ; bf16_t* VT; const float* xin; float* of; float* nrm;
    const float* stats; const float* gp; const float* bp;
    __device__ __forceinline__ void operator()(const f32x4 (&acc)[2][2][4][2], const Unit& u, int wr, int wc, int fr, int fq) const {
        if (mode == 0) {
            bf16_t* ob; long ldo;
            if (u.pn >= 8 && u.pn < 12) { ob = VT + ((long)((u.pm >> 5) * 1024 + (u.pn - 8) * 256)) * SEQ + (u.pm & 31) * 256; ldo = SEQ; }
            else { ob = QKVZ + (long)u.pm * 256 * 4096 + u.pn * 256; ldo = 4096; }
            if (nrm && u.pn < 8) {
                const int which = u.pn >> 2, pnl = u.pn & 3;
#pragma unroll
                for (int ai = 0; ai < 2; ++ai)
#pragma unroll
                    for (int bj = 0; bj < 2; ++bj) {
                        float mx = 0.f;
#pragma unroll
                        for (int m = 0; m < 4; ++m) {
                            const f32x4 v0 = acc[ai][bj][m][0], v1 = acc[ai][bj][m][1];
                            float s = (v0[0] * v0[0] + v0[1] * v0[1]) + (v0[2] * v0[2] + v0[3] * v0[3]) + (v1[0] * v1[0] + v1[1] * v1[1]) + (v1[2] * v1[2] + v1[3] * v1[3]);
                            s += __shfl_xor(s, 16); s += __shfl_xor(s, 32);
                            mx = fmaxf(mx, s);
                        }
                        mx = fmaxf(mx, dpp_f<0xB1>(mx)); mx = fmaxf(mx, dpp_f<0x4E>(mx)); mx = fmaxf(mx, dpp_f<0x141>(mx)); mx = fmaxf(mx, dpp_f<0x140>(mx));
                        if (fr == 0 && fq == 0) nrm[((long)which * 1024 + (u.pm * 4 + 2 * ai + wr)) * 32 + pnl * 8 + 4 * bj + wc] = mx * 1.02f;
                    }
            }
#pragma unroll
            for (int ai = 0; ai < 2; ++ai)
#pragma unroll
                for (int m = 0; m < 4; ++m) {
                    bf16_t* rp = ob + (long)(ai * HALF + wr * 64 + m * 16 + fr) * ldo + wc * 32 + fq * 8;
#pragma unroll
                    for (int bj = 0; bj < 2; ++bj) {
                        const f32x4 v0 = acc[ai][bj][m][0], v1 = acc[ai][bj][m][1];
                        u32x4 w; w.x = cvt_pk_bf16(v0[0], v0[1]); w.y = cvt_pk_bf16(v0[2], v0[3]); w.z = cvt_pk_bf16(v1[0], v1[1]); w.w = cvt_pk_bf16(v1[2], v1[3]);
                        *(u32x4*)(rp + bj * HALF) = w;
                    }
                }
        } else {
            const long o = (long)u.pm * 256 * 1024 + u.pn * 256;
            f32x4 gv[2][2], bv[2][2];
#pragma unroll
            for (int bj = 0; bj < 2; ++bj)
#pragma unroll
                for (int n = 0; n < 2; ++n) {
                    gv[bj][n] = (f32x4){1.f, 1.f, 1.f, 1.f}; bv[bj][n] = (f32x4){0.f, 0.f, 0.f, 0.f};
                    if (stats) { gv[bj][n] = *(const f32x4*)(gp + u.pn * 256 + wc * 32 + fq * 8 + bj * HALF + n * 4); bv[bj][n] = *(const f32x4*)(bp + u.pn * 256 + wc * 32 + fq * 8 + bj * HALF + n * 4); }
                }
#pragma unroll
            for (int ai = 0; ai < 2; ++ai)
#pragma unroll
                for (int m = 0; m < 4; ++m) {
                    const int row = u.pm * 256 + ai * HALF + wr * 64 + m * 16 + fr;
                    const long ro = o + (long)(ai * HALF + wr * 64 + m * 16 + fr) * 1024 + wc * 32 + fq * 8;
                    float mu = 0.f, rs = 1.f;
                    if (stats) { mu = stats[2 * row]; rs = stats[2 * row + 1]; }
#pragma unroll
                    for (int bj = 0; bj < 2; ++bj)
#pragma unroll
                        for (int n = 0; n < 2; ++n) {
                            f32x4 xv = *(const f32x4*)(xin + ro + bj * HALF + n * 4);
                            if (stats) xv = (xv - mu) * rs * gv[bj][n] + bv[bj][n];
                            const f32x4 r = xv * ALPHA + acc[ai][bj][m][n];
                            *(f32x4*)(of + ro + bj * HALF + n * 4) = r;
                        }
                }
        }
    }
};

__device__ __forceinline__ void gemm_phase(LAS unsigned char* lds, const Sched& S, const Epi& E) {
    int tid = threadIdx.x; asm volatile("" : "+v"(tid));
    const int wid = __builtin_amdgcn_readfirstlane(tid >> 6), lane = tid & 63, wr = wid >> 2, wc = wid & 3, fr = lane & 15, fq = lane >> 4;
    constexpr int K = GK, nt = K / BK;
    unsigned voffA[2], voffB[2];
#pragma unroll
    for (int i = 0; i < 2; ++i) { int R, C; stage_rc(tid * 16 + i * 8192, R, C); const int Rb = (R & ~31) + perm32(R & 31);
        voffA[i] = (unsigned)(R * K + C) * 2u; voffB[i] = (unsigned)(Rb * K + C) * 2u; }
    constexpr size_t kstep = (size_t)(BK * 2);
    constexpr size_t hstep = (size_t)HALF * K * 2;
    const unsigned ldsw = (unsigned)wid * 1024u;
    const int aoff = lds_byte(wr * 64 + fr, fq * 8), boff = lds_byte(wc * 32 + fr, fq * 8);
#define PG8_SA(b, h) (((b) * 2 + (h)) * HTB)
#define PG8_SB(b, h) ((4 + (b) * 2 + (h)) * HTB)
#define PG8_STAGE(bufoff, gbase, voff) do { _Pragma("unroll") for (int _i = 0; _i < 2; ++_i) \
        __builtin_amdgcn_global_load_lds((const unsigned*)((const char*)(gbase) + (voff)[_i]), (LAS unsigned*)(lds + (bufoff) + ldsw + _i * 8192), 16, 0, 0); } while (0)
#define PG8_LDA(dst, b, h) do { _Pragma("unroll") for (int m = 0; m < 4; ++m) _Pragma("unroll") for (int k = 0; k < 2; ++k) dst[m][k] = *(const LAS bf16x8*)(lds + PG8_SA(b, h) + aoff + m * 2048 + k * 1024); } while (0)
#define PG8_LDB(dst, b, h) do { _Pragma("unroll") for (int n = 0; n < 2; ++n) _Pragma("unroll") for (int k = 0; k < 2; ++k) dst[n][k] = *(const LAS bf16x8*)(lds + PG8_SB(b, h) + boff + n * 2048 + k * 1024); } while (0)
#define PG8_MMA(ai, bj, At, Bt) do { __builtin_amdgcn_s_setprio(1); _Pragma("unroll") for (int m = 0; m < 4; ++m) _Pragma("unroll") for (int n = 0; n < 2; ++n) _Pragma("unroll") for (int k = 0; k < 2; ++k) \
        acc[ai][bj][m][n] = __builtin_amdgcn_mfma_f32_16x16x32_bf16(Bt[n][k], At[m][k], acc[ai][bj][m][n], 0, 0, 0); __builtin_amdgcn_s_setprio(0); } while (0)
#define PG8_WAIT_V(n) asm volatile("s_waitcnt vmcnt(" #n ")" ::: "memory")
#define PG8_WAIT_L(n) asm volatile("s_waitcnt lgkmcnt(" #n ")" ::: "memory")
#define PG8_BAR __builtin_amdgcn_s_barrier()
#define PG8_SCHED __builtin_amdgcn_sched_barrier(0)
    Unit cur, nxt; int ui = 0;
    if (!S.next(0, cur)) return;
    f32x4 acc[2][2][4][2];
#pragma unroll
    for (int a = 0; a < 2; ++a)
#pragma unroll
        for (int b = 0; b < 2; ++b)
#pragma unroll
            for (int m = 0; m < 4; ++m)
#pragma unroll
                for (int n = 0; n < 2; ++n) acc[a][b][m][n] = (f32x4){0.f, 0.f, 0.f, 0.f};
    bf16x8 At[4][2], B0[2][2], B1[2][2];
    const char* cA = S.pA(cur); const char* cB = S.pB(cur);
    PG8_STAGE(PG8_SB(0, 0), cB, voffB); PG8_STAGE(PG8_SB(0, 1), cB + hstep, voffB); PG8_STAGE(PG8_SA(0, 0), cA, voffA); PG8_STAGE(PG8_SA(0, 1), cA + hstep, voffA);
    if (wr == 1) PG8_BAR;
    PG8_WAIT_V(2); PG8_BAR;
    PG8_STAGE(PG8_SB(1, 0), cB + kstep, voffB); PG8_STAGE(PG8_SA(1, 0), cA + kstep, voffA); PG8_STAGE(PG8_SB(1, 1), cB + hstep + kstep, voffB);
    PG8_WAIT_V(6); PG8_BAR;
    for (;;) {
        const bool has_next = S.next(ui + 1, nxt);
        const char* nA = has_next ? S.pA(nxt) : cA; const char* nB = has_next ? S.pB(nxt) : cB;
        for (int t = 0; t < nt; t += 2) {
            const bool last = (t == nt - 2);
            const char* a1 = cA + (size_t)(t + 1) * kstep;
            const char* a2 = last ? nA : cA + (size_t)(t + 2) * kstep; const char* b2 = last ? nB : cB + (size_t)(t + 2) * kstep;
            const char* a3 = a2 + kstep; const char* b3 = b2 + kstep;
            PG8_LDB(B0, 0, 0); PG8_LDB(B1, 0, 1); PG8_SCHED; PG8_LDA(At, 0, 0); PG8_STAGE(PG8_SA(1, 1), a1 + hstep, voffA);
            PG8_WAIT_V(8); PG8_WAIT_L(0); PG8_BAR; PG8_MMA(0, 0, At, B0); PG8_MMA(0, 1, At, B1); PG8_BAR; PG8_SCHED;
            PG8_LDA(At, 0, 1); PG8_STAGE(PG8_SB(0, 0), b2, voffB); PG8_STAGE(PG8_SB(0, 1), b2 + hstep, voffB); PG8_STAGE(PG8_SA(0, 0), a2, voffA);
            PG8_WAIT_V(8); PG8_WAIT_L(0); PG8_BAR; PG8_MMA(1, 0, At, B0); PG8_MMA(1, 1, At, B1); PG8_BAR; PG8_SCHED;
            PG8_LDB(B0, 1, 0); PG8_LDB(B1, 1, 1); PG8_SCHED; PG8_LDA(At, 1, 0); PG8_STAGE(PG8_SA(0, 1), a2 + hstep, voffA);
            PG8_WAIT_V(8); PG8_WAIT_L(0); PG8_BAR; PG8_MMA(0, 0, At, B0); PG8_MMA(0, 1, At, B1); PG8_BAR; PG8_SCHED;
            PG8_LDA(At, 1, 1); PG8_STAGE(PG8_SB(1, 0), b3, voffB); PG8_STAGE(PG8_SB(1, 1), b3 + hstep, voffB); PG8_STAGE(PG8_SA(1, 0), a3, voffA);
            PG8_WAIT_V(8); PG8_WAIT_L(0); PG8_BAR; PG8_MMA(1, 0, At, B0); PG8_MMA(1, 1, At, B1); PG8_BAR; PG8_SCHED;
        }
        if (wr == 0) PG8_BAR;
        E(acc, cur, wr, wc, fr, fq);
        if (!has_next) break;
#pragma unroll
        for (int a = 0; a < 2; ++a)
#pragma unroll
            for (int b = 0; b < 2; ++b)
#pragma unroll
                for (int m = 0; m < 4; ++m)
#pragma unroll
                    for (int n = 0; n < 2; ++n) acc[a][b][m][n] = (f32x4){0.f, 0.f, 0.f, 0.f};
        cur = nxt; cA = nA; cB = nB; ++ui;
        if (wr == 1) PG8_BAR;
    }
    PG8_WAIT_V(0);
    PG8_BAR;
#undef PG8_SA
#undef PG8_SB
#undef PG8_STAGE
#undef PG8_LDA
#undef PG8_LDB
#undef PG8_MMA
}

constexpr int KROW = 144, VROW = 136;
constexpr int L_KB = 0, L_VB = 2 * 64 * KROW, L_FB = L_VB + 2 * 64 * VROW, L_RELB = L_FB + 512, L_OST = L_RELB + 1280, L_UW = L_OST + 8 * 32 * KROW, L_ATT_END = L_UW + 8 * 128 * 4;
static_assert(L_ATT_END <= LDS_PHASE_BYTES, "lds");
constexpr float TH_DEFER = 8.0f;
constexpr float PRUNE_NAT = 60.0f;

template <int MODE>
__device__ __forceinline__ void attn_unit(const bf16_t* __restrict__ QKVZ, const bf16_t* __restrict__ VT, const float* __restrict__ aux,
                                          bf16_t* __restrict__ G, int b, int h, int qb, int jlo, const float* __restrict__ nrm) {
    unsigned char* lds = g_shm;
    int tid = threadIdx.x; asm volatile("" : "+v"(tid));
    const int w = tid >> 6, lane = tid & 63, q = lane & 31, hh = lane >> 5;
    const int r0 = qb * 256 + w * 32, t = r0 + q;
    const int jhi = qb * 4 + 3, cw = qb * 4 + (w >> 1);
    const int lrow = tid >> 3, lch = tid & 7;
    const bf16_t* kbase = QKVZ + ((long)(b * SEQ + lrow)) * 4096 + 1024 + h * 64 + lch * 8;
    const bf16_t* vbase = VT + ((long)((b * NH + h) * 64 + lrow)) * SEQ + lch * 8;
    const float* fbase = aux + (long)(b * NH + h) * SEQ;
    constexpr float SC = 0.125f * LOG2E;

    __syncthreads();
    bf16x8 qf[4];
    {
        const bf16_t* qp = QKVZ + ((long)(b * SEQ + t)) * 4096 + h * 64 + hh * 8;
#pragma unroll
        for (int ks = 0; ks < 4; ++ks) qf[ks] = *(const bf16x8*)(qp + ks * 16);
    }
    float Ft = 0.f;
    if (MODE == 1) Ft = fbase[t] * LOG2E;
    u32x4 k0r, v0r, k1r, v1r, k2r, v2r; float f0r = 0.f, f1r = 0.f, f2r = 0.f;
    k0r = *(const u32x4*)(kbase + (long)jhi * 64 * 4096);       v0r = *(const u32x4*)(vbase + jhi * 64);
    k1r = *(const u32x4*)(kbase + (long)(jhi - 1) * 64 * 4096); v1r = *(const u32x4*)(vbase + (jhi - 1) * 64);
    k2r = *(const u32x4*)(kbase + (long)(jhi - 2) * 64 * 4096); v2r = *(const u32x4*)(vbase + (jhi - 2) * 64);
    if (MODE == 1) { if (tid < 64) { f0r = fbase[jhi * 64 + tid]; f1r = fbase[(jhi - 1) * 64 + tid]; f2r = fbase[(jhi - 2) * 64 + tid]; } }
    u32x4 zpre[4];
#pragma unroll
    for (int i = 0; i < 4; ++i) zpre[i] = *(const u32x4*)(QKVZ + (long)(b * SEQ + r0 + (lane >> 3) + 8 * i) * 4096 + 3072 + h * 64 + (lane & 7) * 8);
    if (MODE == 1) {
        int* JL = (int*)(lds + L_RELB);
        const float* NQ = nrm + ((long)(b * 128)) * 32 + 2 * h;
        const float* NK = nrm + ((long)(1024 + b * 128)) * 32 + 2 * h;
        float Qa = 0.f, Qb = 0.f, Bd = 0.f;
#pragma unroll
        for (int i = 0; i < 4; ++i) { Qa = fmaxf(Qa, sqrtf(ld_coh(NQ + (4 * qb + i) * 32))); Qb = fmaxf(Qb, sqrtf(ld_coh(NQ + (4 * qb + i) * 32 + 1))); }
#pragma unroll
        for (int i = 0; i < 4; ++i) Bd = fmaxf(Bd, Qa * sqrtf(ld_coh(NK + (4 * qb + i) * 32)) + Qb * sqrtf(ld_coh(NK + (4 * qb + i) * 32 + 1)));
        if (tid == 0) *JL = 4 * qb;
        __syncthreads();
        if (tid < 4 * qb) {
            const float Bj = Qa * sqrtf(ld_coh(NK + tid * 32)) + Qb * sqrtf(ld_coh(NK + tid * 32 + 1));
            const float Dj = ld_coh(fbase + 256 * qb) - ld_coh(fbase + 64 * tid + 63);
            if (!((Bj + Bd) * 0.125f + Dj < -PRUNE_NAT)) atomicMin(JL, tid);
        }
        __syncthreads();
        jlo = *JL;
        float* UW = (float*)(lds + L_UW) + w * 128;
        const float qa = sqrtf(ld_coh(NQ + cw * 32)), qbb = sqrtf(ld_coh(NQ + cw * 32 + 1));
        const float Fr0 = ld_coh(fbase + r0);
        for (int jr = lane; jr < cw - jlo; jr += 64) {
            const int j = jlo + jr;
            const float ka = sqrtf(ld_coh(NK + j * 32)), kb = sqrtf(ld_coh(NK + j * 32 + 1));
            UW[jr] = (qa * ka + qbb * kb) * SC + (Fr0 - ld_coh(fbase + 64 * j + 63)) * LOG2E;
        }
    }
    if (MODE == 0) { if (tid < 288) { int rl = 192 - tid; rl = rl < -128 ? -128 : (rl > 128 ? 128 : rl); ((float*)(lds + L_RELB))[tid] = aux[h * 257 + rl + 128] * LOG2E; } }

    f32x16 O0, O1;
#pragma unroll
    for (int i = 0; i < 16; ++i) { O0[i] = 0.f; O1[i] = 0.f; }
    float m_run = 0.f, l_run = 0.f, m_min = -1e30f;
    bool first = true;

    auto LOADT = [&](u32x4& kr, u32x4& vr, float& fr_, int jj) __attribute__((always_inline)) {
        if (jj >= jlo) {
            kr = *(const u32x4*)(kbase + (long)jj * 64 * 4096);
            vr = *(const u32x4*)(vbase + jj * 64);
            if (MODE == 1) { if (tid < 64) fr_ = fbase[jj * 64 + tid]; }
        }
    };
    auto STEP = [&](u32x4& kreg, u32x4& vreg, float& freg, int j) __attribute__((always_inline)) {
        const int buf = (jhi - j) & 1;
        unsigned char* KB = lds + L_KB + buf * 64 * KROW;
        unsigned char* VB = lds + L_VB + buf * 64 * VROW;
        float* FB = (float*)(lds + L_FB + buf * 256);
        *(u32x4*)(KB + lrow * KROW + lch * 16) = kreg;
        *(u32x2*)(VB + lrow * VROW + lch * 16) = (u32x2){vreg.x, vreg.y};
        *(u32x2*)(VB + lrow * VROW + lch * 16 + 8) = (u32x2){vreg.z, vreg.w};
        if (MODE == 1) { if (tid < 64) FB[tid] = freg * LOG2E; }
        __syncthreads();
        LOADT(kreg, vreg, freg, j - 3);
        bool active;
        if (MODE == 0) active = (j >= cw - 8 && j <= cw);
        else {
            active = (j <= cw);
            if (j < cw) { const float ub = ((const float*)(lds + L_UW))[w * 128 + (j - jlo)]; if (ub - m_min < -PRUNE_NAT * LOG2E) active = false; }
        }
        if (active) {
            f32x16 s0, s1;
#pragma unroll
            for (int i = 0; i < 16; ++i) { s0[i] = 0.f; s1[i] = 0.f; }
#pragma unroll
            for (int ks = 0; ks < 4; ++ks) {
                const bf16x8 k0 = *(const bf16x8*)(KB + q * KROW + (16 * ks + 8 * hh) * 2);
                const bf16x8 k1 = *(const bf16x8*)(KB + (32 + q) * KROW + (16 * ks + 8 * hh) * 2);
                s0 = __builtin_amdgcn_mfma_f32_32x32x16_bf16(k0, qf[ks], s0, 0, 0, 0);
                s1 = __builtin_amdgcn_mfma_f32_32x32x16_bf16(k1, qf[ks], s1, 0, 0, 0);
            }
            if (MODE == 0) {
                const float* RB = (const float*)(lds + L_RELB);
                if (r0 - (64 * j + 63) >= 128) {
                    const float cb = RB[64] - m_run;
#pragma unroll
                    for (int i = 0; i < 16; ++i) { s0[i] = s0[i] * SC + cb; s1[i] = s1[i] * SC + cb; }
                } else {
                    const float* Rp = RB + (192 - (t - 64 * j - 4 * hh));
#pragma unroll
                    for (int i = 0; i < 16; ++i) {
                        s0[i] = s0[i] * SC + (Rp[(i & 3) + 8 * (i >> 2)] - m_run);
                        s1[i] = s1[i] * SC + (Rp[(i & 3) + 8 * (i >> 2) + 32] - m_run);
                    }
                }
            } else {
                const bool diag = (j == cw);
                const float base = Ft - m_run;
#pragma unroll
                for (int g = 0; g < 4; ++g) {
                    const f32x4 f0 = *(const f32x4*)(FB + 8 * g + 4 * hh);
                    const f32x4 f1 = *(const f32x4*)(FB + 32 + 8 * g + 4 * hh);
#pragma unroll
                    for (int e = 0; e < 4; ++e) {
                        const int i = 4 * g + e;
                        float x0 = s0[i] * SC + (base - f0[e]);
                        float x1 = s1[i] * SC + (base - f1[e]);
                        if (diag) {
                            const int sp = 64 * j + 8 * g + 4 * hh + e;
                            if (sp > t) x0 = -1e30f;
                            if (sp + 32 > t) x1 = -1e30f;
                        }
                        s0[i] = x0; s1[i] = x1;
                    }
                }
            }
            float mx = s0[0];
#pragma unroll
            for (int i = 1; i < 16; ++i) mx = fmaxf(mx, s0[i]);
#pragma unroll
            for (int i = 0; i < 16; ++i) mx = fmaxf(mx, s1[i]);
            if (first || __any(mx > TH_DEFER)) {
                mx = fmaxf(mx, __shfl_xor(mx, 32));
                float d;
                if (first) { d = mx; }
                else {
                    d = fmaxf(mx, 0.f);
                    const float al = __builtin_amdgcn_exp2f(-d);
                    l_run *= al;
#pragma unroll
                    for (int i = 0; i < 16; ++i) { O0[i] *= al; O1[i] *= al; }
                }
                m_run += d;
#pragma unroll
                for (int i = 0; i < 16; ++i) { s0[i] -= d; s1[i] -= d; }
                first = false;
                if (MODE == 1) {
                    float mm = m_run;
#pragma unroll
                    for (int o = 32; o >= 1; o >>= 1) mm = fminf(mm, __shfl_xor(mm, o));
                    m_min = mm;
                }
            }
            float ps = 0.f;
#pragma unroll
            for (int i = 0; i < 16; ++i) { s0[i] = __builtin_amdgcn_exp2f(s0[i]); s1[i] = __builtin_amdgcn_exp2f(s1[i]); ps += s0[i] + s1[i]; }
            l_run += ps;
#pragma unroll
            for (int s = 0; s < 4; ++s) {
                u32x4 pw;
                if (s < 2) { pw.x = cvt_pk_bf16(s0[8 * s + 0], s0[8 * s + 1]); pw.y = cvt_pk_bf16(s0[8 * s + 2], s0[8 * s + 3]); pw.z = cvt_pk_bf16(s0[8 * s + 4], s0[8 * s + 5]); pw.w = cvt_pk_bf16(s0[8 * s + 6], s0[8 * s + 7]); }
                else { const int sp = s - 2; pw.x = cvt_pk_bf16(s1[8 * sp + 0], s1[8 * sp + 1]); pw.y = cvt_pk_bf16(s1[8 * sp + 2], s1[8 * sp + 3]); pw.z = cvt_pk_bf16(s1[8 * sp + 4], s1[8 * sp + 5]); pw.w = cvt_pk_bf16(s1[8 * sp + 6], s1[8 * sp + 7]); }
                const bf16x8 pf = __builtin_bit_cast(bf16x8, pw);
                {
                    const u32x2 lo = *(const u32x2*)(VB + q * VROW + (16 * s + 4 * hh) * 2);
                    const u32x2 hi = *(const u32x2*)(VB + q * VROW + (16 * s + 8 + 4 * hh) * 2);
                    const bf16x8 vf = __builtin_bit_cast(bf16x8, ((u32x4){lo.x, lo.y, hi.x, hi.y}));
                    O0 = __builtin_amdgcn_mfma_f32_32x32x16_bf16(vf, pf, O0, 0, 0, 0);
                }
                {
                    const u32x2 lo = *(const u32x2*)(VB + (32 + q) * VROW + (16 * s + 4 * hh) * 2);
                    const u32x2 hi = *(const u32x2*)(VB + (32 + q) * VROW + (16 * s + 8 + 4 * hh) * 2);
                    const bf16x8 vf = __builtin_bit_cast(bf16x8, ((u32x4){lo.x, lo.y, hi.x, hi.y}));
                    O1 = __builtin_amdgcn_mfma_f32_32x32x16_bf16(vf, pf, O1, 0, 0, 0);
                }
            }
        }
    };
    for (int j = jhi; j >= jlo; j -= 3) {
        STEP(k0r, v0r, f0r, j);
        if (j - 1 >= jlo) STEP(k1r, v1r, f1r, j - 1);
        if (j - 2 >= jlo) STEP(k2r, v2r, f2r, j - 2);
    }
    const float lt = l_run + __shfl_xor(l_run, 32);
    const float inv = 1.0f / lt;
    unsigned char* OST = lds + L_OST + w * 32 * KROW;
#pragma unroll
    for (int g = 0; g < 4; ++g) {
        u32x2 w0, w1;
        w0.x = cvt_pk_bf16(O0[4 * g + 0] * inv, O0[4 * g + 1] * inv); w0.y = cvt_pk_bf16(O0[4 * g + 2] * inv, O0[4 * g + 3] * inv);
        w1.x = cvt_pk_bf16(O1[4 * g + 0] * inv, O1[4 * g + 1] * inv); w1.y = cvt_pk_bf16(O1[4 * g + 2] * inv, O1[4 * g + 3] * inv);
        *(u32x2*)(OST + q * KROW + (8 * g + 4 * hh) * 2) = w0;
        *(u32x2*)(OST + q * KROW + (32 + 8 * g + 4 * hh) * 2) = w1;
    }
    __syncthreads();
#pragma unroll
    for (int i = 0; i < 4; ++i) {
        const int row = (lane >> 3) + 8 * i, ch = lane & 7;
        const u32x4 o8 = *(const u32x4*)(OST + row * KROW + ch * 16);
        const long tok = (long)(b * SEQ + r0 + row);
        const u32x4 z8 = zpre[i];
        u32x4 r8;
#pragma unroll
        for (int e = 0; e < 4; ++e) {
            const unsigned ou = o8[e], zu = z8[e];
            const float z0 = bf_lo(zu), z1 = bf_hi(zu);
            const float g0 = bf_lo(ou) * z0 / (1.0f + __expf(-z0));
            const float g1 = bf_hi(ou) * z1 / (1.0f + __expf(-z1));
            r8[e] = cvt_pk_bf16(g0, g1);
        }
        *(u32x4*)(G + tok * 1024 + h * 64 + ch * 8) = r8;
    }
}

__device__ __forceinline__ void transpose_w(const float* __restrict__ src, int N, bf16_t* __restrict__ dst, int tile) {
    float* T = (float*)g_shm;
    int tid = threadIdx.x; asm volatile("" : "+v"(tid));
    const int ntn = N / 64, kt = tile / ntn, ntl = tile % ntn, k0 = kt * 64, n0 = ntl * 64;
    __syncthreads();
#pragma unroll
    for (int e = 0; e < 8; ++e) { const int idx = tid + 512 * e, kk = idx >> 6, nn = idx & 63; T[kk * 65 + nn] = src[(long)(k0 + kk) * N + n0 + nn]; }
    __syncthreads();
#pragma unroll
    for (int e = 0; e < 4; ++e) { const int idx = tid + 512 * e, nn = idx >> 5, kp = idx & 31;
        *(unsigned*)(dst + (long)(n0 + nn) * 1024 + k0 + 2 * kp) = cvt_pk_bf16(T[(2 * kp) * 65 + nn], T[(2 * kp + 1) * 65 + nn]); }
}

__device__ __forceinline__ float log_sigmoid(float z) { return fminf(z, 0.f) - log1pf(expf(-fabsf(z))); }

__device__ __forceinline__ void ln_phase(float* __restrict__ io, bf16_t* __restrict__ XB, const float* __restrict__ g, const float* __restrict__ bta,
                                         const float* __restrict__ wf, const float* __restrict__ bf, float* __restrict__ LOGF,
                                         float* __restrict__ stats, const bool write_x) {
    int tid = threadIdx.x; asm volatile("" : "+v"(tid));
    const int w = tid >> 6, lane = tid & 63;
    f32x4* WF = (f32x4*)g_shm;
    if (wf) {
        __syncthreads();
        for (int idx = tid; idx < 4096; idx += 512) {
            const int ln = idx & 63, hq = (idx >> 6) & 3, ie = idx >> 8, k = 4 * (ln + 64 * (ie >> 2)) + (ie & 3);
            WF[idx] = *(const f32x4*)(wf + k * 16 + 4 * hq);
        }
        __syncthreads();
    }
    f32x4 gv[4], bv[4];
#pragma unroll
    for (int i = 0; i < 4; ++i) { gv[i] = *(const f32x4*)(g + 4 * (lane + 64 * i)); bv[i] = *(const f32x4*)(bta + 4 * (lane + 64 * i)); }
    const int G_ = gridDim.x, c_ = blockIdx.x;
    const int nri = (c_ < 256) ? ((256 - c_ + G_ - 1) / G_) * 32 : 0;
    auto row_of = [&](int ri) __attribute__((always_inline)) { return (c_ + (ri >> 5) * G_) * 256 + w + 8 * (ri & 31); };
    f32x4 nv[4];
    if (nri > 0) {
        const int row = row_of(0);
#pragma unroll
        for (int i = 0; i < 4; ++i) nv[i] = *(const f32x4*)(io + (long)row * 1024 + 4 * (lane + 64 * i));
    }
    for (int ri = 0; ri < nri; ++ri) {
        const int row = row_of(ri);
        float* rp = io + (long)row * 1024;
        f32x4 v[4];
#pragma unroll
        for (int i = 0; i < 4; ++i) v[i] = nv[i];
        if (ri + 1 < nri) {
            const int nrow = row_of(ri + 1);
#pragma unroll
            for (int i = 0; i < 4; ++i) nv[i] = *(const f32x4*)(io + (long)nrow * 1024 + 4 * (lane + 64 * i));
        }
        float s = 0.f;
#pragma unroll
        for (int i = 0; i < 4; ++i) s += (v[i][0] + v[i][1]) + (v[i][2] + v[i][3]);
#pragma unroll
        for (int o = 32; o >= 1; o >>= 1) s += __shfl_xor(s, o);
        const float mu = s * (1.0f / 1024.0f);
        float qs = 0.f;
#pragma unroll
        for (int i = 0; i < 4; ++i) { v[i] = v[i] - mu; qs += (v[i][0] * v[i][0] + v[i][1] * v[i][1]) + (v[i][2] * v[i][2] + v[i][3] * v[i][3]); }
#pragma unroll
        for (int o = 32; o >= 1; o >>= 1) qs += __shfl_xor(qs, o);
        const float rstd = 1.0f / sqrtf(qs * (1.0f / 1024.0f) + LN_EPS);
        if (!write_x && lane == 0) { stats[2 * row] = mu; stats[2 * row + 1] = rstd; }
#pragma unroll
        for (int i = 0; i < 4; ++i) {
            v[i] = v[i] * rstd * gv[i] + bv[i];
            if (write_x) *(f32x4*)(rp + 4 * (lane + 64 * i)) = v[i];
            if (XB) { u32x2 pk; pk.x = cvt_pk_bf16(v[i][0], v[i][1]); pk.y = cvt_pk_bf16(v[i][2], v[i][3]);
                *(u32x2*)(XB + (long)row * 1024 + 4 * (lane + 64 * i)) = pk; }
        }
        if (wf) {
            float a[16];
#pragma unroll
            for (int c = 0; c < 16; ++c) a[c] = 0.f;
#pragma unroll
            for (int i = 0; i < 4; ++i)
#pragma unroll
                for (int e = 0; e < 4; ++e) {
                    const float xv = v[i][e];
#pragma unroll
                    for (int hq = 0; hq < 4; ++hq) {
                        const f32x4 w4 = WF[((i * 4 + e) * 4 + hq) * 64 + lane];
                        a[4 * hq + 0] += xv * w4[0]; a[4 * hq + 1] += xv * w4[1]; a[4 * hq + 2] += xv * w4[2]; a[4 * hq + 3] += xv * w4[3];
                    }
                }
#pragma unroll
            for (int i = 0; i < 8; ++i) { const bool up = (lane & 32) != 0; const float send = up ? a[i] : a[i + 8], keep = up ? a[i + 8] : a[i]; a[i] = keep + __shfl_xor(send, 32); }
#pragma unroll
            for (int i = 0; i < 4; ++i) { const bool up = (lane & 16) != 0; const float send = up ? a[i] : a[i + 4], keep = up ? a[i + 4] : a[i]; a[i] = keep + __shfl_xor(send, 16); }
#pragma unroll
            for (int i = 0; i < 2; ++i) { const bool up = (lane & 8) != 0; const float send = up ? a[i] : a[i + 2], keep = up ? a[i + 2] : a[i]; a[i] = keep + __shfl_xor(send, 8); }
            { const bool up = (lane & 4) != 0; const float send = up ? a[0] : a[1], keep = up ? a[1] : a[0]; a[0] = keep + __shfl_xor(send, 4); }
            a[0] += __shfl_xor(a[0], 2); a[0] += __shfl_xor(a[0], 1);
            if ((lane & 3) == 0) {
                const int hd = ((lane >> 5) & 1) * 8 + ((lane >> 4) & 1) * 4 + ((lane >> 3) & 1) * 2 + ((lane >> 2) & 1);
                const int bb = row / SEQ, ss = row % SEQ;
                LOGF[((long)(bb * NH + hd)) * SEQ + ss] = log_sigmoid(a[0] + bf[hd]);
            }
        }
    }
}

__device__ __forceinline__ void scan_phase(float* __restrict__ F) {
    float* red = (float*)g_shm;
    int tid = threadIdx.x; asm volatile("" : "+v"(tid));
    const int w = tid >> 6, lane = tid & 63;
    for (int bh = blockIdx.x; bh < NB * NH; bh += gridDim.x) {
        float* p = F + (long)bh * SEQ + tid * 16;
        f32x4 v[4];
#pragma unroll
        for (int i = 0; i < 4; ++i) v[i] = *(const f32x4*)(p + 4 * i);
        float run = 0.f;
#pragma unroll
        for (int i = 0; i < 4; ++i)
#pragma unroll
            for (int e = 0; e < 4; ++e) { run += v[i][e]; v[i][e] = run; }
        float inc = run;
#pragma unroll
        for (int o = 1; o < 64; o <<= 1) { const float y = __shfl_up(inc, o); if (lane >= o) inc += y; }
        __syncthreads();
        if (lane == 63) red[w] = inc;
        __syncthreads();
        float base = inc - run;
        for (int ww = 0; ww < w; ++ww) base += red[ww];
#pragma unroll
        for (int i = 0; i < 4; ++i) { v[i] = v[i] + base; *(f32x4*)(p + 4 * i) = v[i]; }
    }
}

#define XB_TMO      128
#define XB_XCNT(j)  (256  + 64 * (j))
#define XB_XSUB(j)  (1280 + 64 * (j))
#define XB_XGEN(j)  (2304 + 64 * (j))
#define XB_TOP      3328
#define XB_TOPGEN   3392
#define XCD_BAR_WORDS 3456
#define XB_SPIN_CAP (1u << 18)
__device__ __forceinline__ unsigned xb_ld(unsigned* p)              { return __hip_atomic_load(p, __ATOMIC_RELAXED, __HIP_MEMORY_SCOPE_AGENT); }
__device__ __forceinline__ unsigned xb_add(unsigned* p, unsigned v) { return __hip_atomic_fetch_add(p, v, __ATOMIC_RELAXED, __HIP_MEMORY_SCOPE_AGENT); }
__device__ __forceinline__ unsigned xb_xcc_id() { return (unsigned)__builtin_amdgcn_s_getreg((3 << 11) | 20) & 0xFu; }
#define XB_SPIN(cond, bar) do { unsigned _sp = 0; while (cond) { __builtin_amdgcn_s_sleep(1); \
    if ((++_sp & 255u) == 0u) { if (xb_ld(&(bar)[XB_TMO])) break; if (_sp > XB_SPIN_CAP) { atomicAdd(&(bar)[XB_TMO], 1u); break; } } } } while (0)
struct XcdBarrier { unsigned* bar; unsigned x; volatile LAS unsigned* st; };
__device__ __forceinline__ XcdBarrier xcd_barrier_post(unsigned* bar, volatile LAS unsigned* st) {
    XcdBarrier b; b.bar = bar; b.x = xb_xcc_id(); b.st = st;
    if (threadIdx.x == 0) (void)xb_add(&bar[XB_XCNT(b.x)], 1u);
    return b;
}
__device__ __forceinline__ void xcd_barrier_complete(unsigned* bar, unsigned x, unsigned& nloc, unsigned& nx) {
    const unsigned G = gridDim.x * gridDim.y * gridDim.z;
    unsigned sum, cnt, mine, sp = 0u;
    for (;;) {
        sum = 0u; cnt = 0u; mine = 0u;
#pragma unroll
        for (unsigned j = 0; j < 16; ++j) { const unsigned c = xb_ld(&bar[XB_XCNT(j)]); sum += c; cnt += (c > 0u) ? 1u : 0u; mine = (j == x) ? c : mine; }
        if (sum == G) break;
        __builtin_amdgcn_s_sleep(1);
        if ((++sp & 255u) == 0u) { if (xb_ld(&bar[XB_TMO])) break; if (sp > XB_SPIN_CAP) { atomicAdd(&bar[XB_TMO], 1u); break; } }
    }
    nloc = mine > 0u ? mine : 1u; nx = cnt > 0u ? cnt : 1u;
}
__device__ __forceinline__ void xcd_barrier(const XcdBarrier& b) {
    asm volatile("s_waitcnt vmcnt(0)" ::: "memory");
    __syncthreads();
    if (threadIdx.x == 0) {
        unsigned* bar = b.bar;
        __builtin_amdgcn_s_waitcnt(0);
        unsigned nloc = b.st[0], nx = b.st[1];
        if (nloc == 0u) { xcd_barrier_complete(bar, b.x, nloc, nx); b.st[0] = nloc; b.st[1] = nx; }
        const unsigned old = xb_add(&bar[XB_XSUB(b.x)], 1u);
        const unsigned gen = old / nloc;
        if (old + 1u == (gen + 1u) * nloc) {
            __builtin_amdgcn_fence(__ATOMIC_RELEASE, "agent");
            asm volatile("s_waitcnt vmcnt(0)" ::: "memory");
            const unsigned og = xb_add(&bar[XB_TOP], 1u);
            const unsigned tg = og / nx;
            if (og + 1u == (tg + 1u) * nx) xb_add(&bar[XB_TOPGEN], 1u);
            else XB_SPIN(xb_ld(&bar[XB_TOPGEN]) == tg, bar);
            __builtin_amdgcn_fence(__ATOMIC_ACQUIRE, "agent");
            xb_add(&bar[XB_XGEN(b.x)], 1u);
            asm volatile("s_waitcnt vmcnt(0)" ::: "memory");
        } else {
            XB_SPIN(xb_ld(&bar[XB_XGEN(b.x)]) == gen, bar);
            __builtin_amdgcn_fence(__ATOMIC_ACQUIRE, "agent");
            asm volatile("s_waitcnt vmcnt(0)" ::: "memory");
        }
    }
    __syncthreads();
}

__device__ __forceinline__ void grid_bar(unsigned* ctr, unsigned target) {
    __syncthreads();
    if (threadIdx.x == 0) {
        __builtin_amdgcn_fence(__ATOMIC_RELEASE, "agent");
        __hip_atomic_fetch_add(ctr, 1u, __ATOMIC_RELAXED, __HIP_MEMORY_SCOPE_AGENT);
        while (__hip_atomic_load(ctr, __ATOMIC_RELAXED, __HIP_MEMORY_SCOPE_AGENT) < target) __builtin_amdgcn_s_sleep(4);
        __builtin_amdgcn_fence(__ATOMIC_ACQUIRE, "agent");
    }
    __syncthreads();
}

__global__ void __launch_bounds__(512, 2) fwd_megakernel(Params p) {
    cg::grid_group grid = cg::this_grid();
    bf16_t* XB = (bf16_t*)(p.ws + WS_XB);
    bf16_t* QKVZ = (bf16_t*)(p.ws + WS_QKVZ);
    bf16_t* VT = (bf16_t*)(p.ws + WS_VT);
    bf16_t* G = (bf16_t*)(p.ws + WS_G);
    bf16_t* WIN = (bf16_t*)(p.ws + WS_WIN);
    bf16_t* WOUT = (bf16_t*)(p.ws + WS_WOUT);
    float* F = (float*)(p.ws + WS_F);
    float* NRM = (float*)(p.ws + WS_NRM);
    unsigned* CTR = (unsigned*)(p.ws + WS_CTR);
    float* STATS = (float*)(p.ws + WS_STATS);
    unsigned bar_gen = 0;
#define GRID_BAR() xcd_barrier(xbar)
    const int tid = threadIdx.x;
    LAS unsigned char* lds = (LAS unsigned char*)g_shm;

    unsigned* XBAR = (unsigned*)(p.ws + WS_XBAR);
    volatile LAS unsigned* xb_st = (volatile LAS unsigned*)((LAS unsigned char*)g_shm + LDS_PHASE_BYTES);
    if (tid == 0) { xb_st[0] = 0u; xb_st[1] = 0u; }
    if (blockIdx.x == 0) { for (int u = tid; u < XCD_BAR_WORDS; u += 512) __hip_atomic_store(XBAR + u, 0u, __ATOMIC_RELAXED, __HIP_MEMORY_SCOPE_AGENT); }
    __syncthreads();
    {
        const long nvec = (long)MTOK * 1024 / 8;
#pragma unroll 4
        for (long i = (long)blockIdx.x * 512 + tid; i < nvec; i += (long)gridDim.x * 512) {
            const f32x4 a = *(const f32x4*)(p.x + i * 8), c = *(const f32x4*)(p.x + i * 8 + 4);
            u32x4 o; o.x = cvt_pk_bf16(a[0], a[1]); o.y = cvt_pk_bf16(a[2], a[3]); o.z = cvt_pk_bf16(c[0], c[1]); o.w = cvt_pk_bf16(c[2], c[3]);
            *(u32x4*)(XB + i * 8) = o;
        }
        for (int u = blockIdx.x; u < DEPTH * 1280; u += gridDim.x) {
            const int l = u / 1280, tl = u % 1280;
            if (tl < 1024) {
                const float* src = ((l & 1) ? p.w_in_b : p.w_in_a) + (long)(l >> 1) * 1024 * 4096;
                transpose_w(src, 4096, WIN + (long)l * 4096 * 1024, tl);
            } else {
                const float* src = ((l & 1) ? p.w_out_b : p.w_out_a) + (long)(l >> 1) * 1024 * 1024;
                transpose_w(src, 1024, WOUT + (long)l * 1024 * 1024, tl - 1024);
            }
        }
    }
    grid.sync();
    const XcdBarrier xbar = xcd_barrier_post(XBAR, xb_st);

#pragma unroll 1
    for (int layer = 0; layer < DEPTH; ++layer) {
        const bool isB = (layer & 1) != 0;
        const bf16_t* Wi = WIN + (long)layer * 4096 * 1024;
        const bf16_t* Wo = WOUT + (long)layer * 1024 * 1024;
        if (isB) scan_phase(F);
        {
            Sched S; S.mode = 0; S.XB = (const char*)XB; S.W = (const char*)Wi; S.G = gridDim.x; S.c = blockIdx.x;
            Epi E; E.mode = 0; E.QKVZ = QKVZ; E.VT = VT; E.xin = nullptr; E.of = nullptr; E.nrm = isB ? NRM : nullptr; E.stats = nullptr; E.gp = nullptr; E.bp = nullptr;
            __syncthreads();
            gemm_phase(lds, S, E);
        }
        GRID_BAR();
        for (int u = blockIdx.x; u < 4096; u += gridDim.x) {
            const int c = u & 255, i = u >> 8;
            int qb = c >> 3;
            if (isB && (i & 1)) qb = 31 - qb;
            const int b = c & 7, h = i;
            if (!isB) attn_unit<0>(QKVZ, VT, p.rel_bias_a + (long)(layer >> 1) * NH * 257, G, b, h, qb, (qb * 4 - 8) > 0 ? (qb * 4 - 8) : 0, nullptr);
            else attn_unit<1>(QKVZ, VT, F, G, b, h, qb, 0, NRM);
        }
        GRID_BAR();
        {
            Sched S; S.mode = 1; S.XB = (const char*)G; S.W = (const char*)Wo; S.G = gridDim.x; S.c = blockIdx.x;
            Epi E; E.mode = 1; E.QKVZ = nullptr; E.VT = nullptr; E.xin = (layer == 0) ? p.x : p.out; E.of = p.out; E.nrm = nullptr;
            E.stats = (layer == 0) ? nullptr : STATS; E.gp = p.ln_g + (layer > 0 ? layer - 1 : 0) * 1024; E.bp = p.ln_b + (layer > 0 ? layer - 1 : 0) * 1024;
            __syncthreads();
            gemm_phase(lds, S, E);
        }
        __syncthreads();
        {
            const bool nextB = (layer + 1 < DEPTH) && ((layer + 1) & 1);
            const int jn = (layer + 1) >> 1;
            ln_phase(p.out, (layer + 1 < DEPTH) ? XB : nullptr, p.ln_g + layer * 1024, p.ln_b + layer * 1024,
                     nextB ? p.w_f_b + (long)jn * 1024 * 16 : nullptr, nextB ? p.b_f_b + jn * 16 : nullptr, F, STATS, layer + 1 == DEPTH);
        }
        if (layer + 1 < DEPTH) GRID_BAR();
    }
}

extern "C" void kernel_launch(void* const* d_in, const int* in_sizes, int n_in, void* d_out, int out_size, void* d_ws, size_t ws_size, hipStream_t stream) {
    static int grid_blocks = 0;
    if (grid_blocks == 0) {
        if (ws_size < WS_END) { fprintf(stderr, "kernel_launch: workspace too small (%zu < %zu)\n", ws_size, (size_t)WS_END); grid_blocks = -1; return; }
        int dev = 0, cus = 0, per_cu = 0;
        hipGetDevice(&dev);
        hipDeviceGetAttribute(&cus, hipDeviceAttributeMultiprocessorCount, dev);
        hipFuncSetAttribute((const void*)fwd_megakernel, hipFuncAttributeMaxDynamicSharedMemorySize, LDS_BYTES);
        hipOccupancyMaxActiveBlocksPerMultiprocessor(&per_cu, (const void*)fwd_megakernel, 512, LDS_BYTES);
        if (per_cu < 1) { fprintf(stderr, "kernel_launch: occupancy query says %d blocks per CU\n", per_cu); per_cu = 1; }
        grid_blocks = cus * 1;
        (void)hipGetLastError();
    }
    if (grid_blocks < 0) return;
    Params p{};
    p.x = (const float*)d_in[0]; p.w_in_a = (const float*)d_in[1]; p.rel_bias_a = (const float*)d_in[2]; p.w_out_a = (const float*)d_in[3];
    p.w_in_b = (const float*)d_in[4]; p.w_f_b = (const float*)d_in[5]; p.b_f_b = (const float*)d_in[6]; p.w_out_b = (const float*)d_in[7];
    p.ln_g = (const float*)d_in[8]; p.ln_b = (const float*)d_in[9];
    p.out = (float*)d_out; p.ws = (unsigned char*)d_ws;
    void* args[] = {&p};
    hipError_t e = hipLaunchCooperativeKernel((const void*)fwd_megakernel, dim3(grid_blocks), dim3(512), args, LDS_BYTES, stream);
    if (e != hipSuccess) fprintf(stderr, "cooperative launch failed: %s (grid %d)\n", hipGetErrorString(e), grid_blocks);
}
```

```cpp
#include <hip/hip_runtime.h>
#include <hip/hip_cooperative_groups.h>
#include <cstdio>
#include <cstdint>
namespace cg = cooperative_groups;

typedef unsigned short bf16_t;
typedef short bf16x8 __attribute__((ext_vector_type(8)));
typedef float f32x4 __attribute__((ext_vector_type(4)));
typedef float f32x16 __attribute__((ext_vector_type(16)));
typedef unsigned u32x4 __attribute__((ext_vector_type(4)));
typedef unsigned u32x2 __attribute__((ext_vector_type(2)));

constexpr int DM = 1024, NB = 8, SEQ = 8192, MTOK = NB * SEQ, NH = 16, DEPTH = 4;
constexpr float LN_EPS = 1e-5f;
constexpr float ALPHA = 1.681792830507429f;
constexpr float LOG2E = 1.4426950408889634f;
constexpr int LDS_PHASE_BYTES = 131072;
constexpr int LDS_BYTES = LDS_PHASE_BYTES + 16;

constexpr size_t WS_XB = 0;
constexpr size_t WS_QKVZ = WS_XB + (size_t)MTOK * 1024 * 2;
constexpr size_t WS_VT = WS_QKVZ + (size_t)MTOK * 4096 * 2;
constexpr size_t WS_G = WS_VT + (size_t)MTOK * 1024 * 2;
constexpr size_t WS_WIN = WS_G + (size_t)MTOK * 1024 * 2;
constexpr size_t WS_WOUT = WS_WIN + (size_t)DEPTH * 4096 * 1024 * 2;
constexpr size_t WS_F = WS_WOUT + (size_t)DEPTH * 1024 * 1024 * 2;
constexpr size_t WS_NRM = WS_F + (size_t)NB * NH * SEQ * 4;
constexpr size_t WS_CTR = WS_NRM + (size_t)2 * 1024 * 128 * 4;
constexpr size_t WS_STATS = WS_CTR + 256;
constexpr size_t WS_XBAR = WS_STATS + (size_t)MTOK * 2 * 4;
constexpr size_t WS_END = WS_XBAR + 16384;

extern __shared__ __attribute__((aligned(16))) unsigned char g_shm[];

struct Params {
    const float* x; const float* w_in_a; const float* rel_bias_a; const float* w_out_a;
    const float* w_in_b; const float* w_f_b; const float* b_f_b; const float* w_out_b;
    const float* ln_g; const float* ln_b;
    float* out; unsigned char* ws;
};

typedef __bf16 bf16x2_t __attribute__((ext_vector_type(2)));
typedef float f32x2_t __attribute__((ext_vector_type(2)));
__device__ __forceinline__ unsigned cvt_pk_bf16(float lo, float hi) { const f32x2_t v = {lo, hi}; const bf16x2_t r = __builtin_convertvector(v, bf16x2_t); return __builtin_bit_cast(unsigned, r); }
__device__ __forceinline__ float ld_coh(const float* p) { return __hip_atomic_load(p, __ATOMIC_RELAXED, __HIP_MEMORY_SCOPE_AGENT); }
template <int CTRL> __device__ __forceinline__ float dpp_f(float v) { return __int_as_float(__builtin_amdgcn_update_dpp(0, __float_as_int(v), CTRL, 0xf, 0xf, false)); }
__device__ __forceinline__ float bf_lo(unsigned u) { return __uint_as_float(u << 16); }
__device__ __forceinline__ float bf_hi(unsigned u) { return __uint_as_float(u & 0xffff0000u); }

#define LAS __attribute__((address_space(3)))
constexpr int BK = 64, HALF = 128, HTB = HALF * BK * 2, GK = 1024;
__device__ __forceinline__ int lds_byte(int r, int c) { const int st = (r >> 4) * 2 + (c >> 5), rr = r & 15, cc = c & 31, ob = rr * 64 + cc * 2; return st * 1024 + (ob ^ (((ob >> 9) & 1) << 5)); }
__device__ __forceinline__ void stage_rc(int b, int& R, int& C) { const int st = b / 1024, sb = b % 1024, swz = sb ^ (((sb >> 9) & 1) << 5); R = (st >> 1) * 16 + swz / 64; C = (st & 1) * 32 + (swz % 64) / 2; }
__device__ __forceinline__ int perm32(int rho) { const int n = rho >> 4, i = rho & 15; return 8 * (i >> 2) + 4 * n + (i & 3); }

__device__ __forceinline__ void tile_map(int L, int nM, int nN, int& pm, int& pn) {
    const int nwg = nM * nN; int wgid = L;
    { const int q = nwg / 8, r = nwg % 8, xcd = wgid % 8, off = wgid / 8; wgid = (xcd < r ? xcd * (q + 1) : r * (q + 1) + (xcd - r) * q) + off; }
    const int nig = 8 * nN, gid = wgid / nig, fm = gid * 8, gsz = (nM - fm) < 8 ? (nM - fm) : 8;
    pm = fm + ((wgid % nig) % gsz); pn = (wgid % nig) / gsz;
}

struct Unit { int pm, pn; };
constexpr size_t TSTEP = (size_t)256 * GK * 2;
struct Sched {
    int mode;
    const char* XB; const char* W; int G, c;
    __device__ __forceinline__ bool next(int i, Unit& u) const {
        if (mode == 1) { const int panel = c + (i >> 2) * G; if (panel >= 256) return false; u.pm = panel; u.pn = i & 3; return true; }
        const long L = (long)i * G + c; if (L >= 4096) return false;
        tile_map((int)L, 256, 16, u.pm, u.pn); return true;
    }
    __device__ __forceinline__ bool vt(const Unit& u) const { return mode == 0 && u.pn >= 8 && u.pn < 12; }
    __device__ __forceinline__ const char* pA(const Unit& u) const { return vt(u) ? W + (size_t)u.pn * TSTEP : XB + (size_t)u.pm * TSTEP; }
    __device__ __forceinline__ const char* pB(const Unit& u) const { return vt(u) ? XB + (size_t)u.pm * TSTEP : W + (size_t)u.pn * TSTEP; }
};
struct Epi {
    int mode; bf16_t* QKVZ; bf16_t* VT; const float* xin; float* of; float* nrm;
    const float* stats; const float* gp; const float* bp;
    __device__ __forceinline__ void operator()(const f32x4 (&acc)[2][2][4][2], const Unit& u, int wr, int wc, int fr, int fq) const {
        if (mode == 0) {
            bf16_t* ob; long ldo;
            if (u.pn >= 8 && u.pn < 12) { ob = VT + ((long)((u.pm >> 5) * 1024 + (u.pn - 8) * 256)) * SEQ + (u.pm & 31) * 256; ldo = SEQ; }
            else { ob = QKVZ + (long)u.pm * 256 * 4096 + u.pn * 256; ldo = 4096; }
            if (nrm && u.pn < 8) {
                const int which = u.pn >> 2, pnl = u.pn & 3;
#pragma unroll
                for (int ai = 0; ai < 2; ++ai)
#pragma unroll
                    for (int bj = 0; bj < 2; ++bj) {
                        float mx = 0.f;
#pragma unroll
                        for (int m = 0; m < 4; ++m) {
                            const f32x4 v0 = acc[ai][bj][m][0], v1 = acc[ai][bj][m][1];
                            float s = (v0[0] * v0[0] + v0[1] * v0[1]) + (v0[2] * v0[2] + v0[3] * v0[3]) + (v1[0] * v1[0] + v1[1] * v1[1]) + (v1[2] * v1[2] + v1[3] * v1[3]);
                            s += __shfl_xor(s, 16); s += __shfl_xor(s, 32);
                            mx = fmaxf(mx, s);
                        }
                        mx = fmaxf(mx, dpp_f<0xB1>(mx)); mx = fmaxf(mx, dpp_f<0x4E>(mx)); mx = fmaxf(mx, dpp_f<0x141>(mx)); mx = fmaxf(mx, dpp_f<0x140>(mx));
                        if (fr == 0 && fq == 0) nrm[((long)which * 1024 + (u.pm * 4 + 2 * ai + wr)) * 32 + pnl * 8 + 4 * bj + wc] = mx * 1.02f;
                    }
            }
#pragma unroll
            for (int ai = 0; ai < 2; ++ai)
#pragma unroll
                for (int m = 0; m < 4; ++m) {
                    bf16_t* rp = ob + (long)(ai * HALF + wr * 64 + m * 16 + fr) * ldo + wc * 32 + fq * 8;
#pragma unroll
                    for (int bj = 0; bj < 2; ++bj) {
                        const f32x4 v0 = acc[ai][bj][m][0], v1 = acc[ai][bj][m][1];
                        u32x4 w; w.x = cvt_pk_bf16(v0[0], v0[1]); w.y = cvt_pk_bf16(v0[2], v0[3]); w.z = cvt_pk_bf16(v1[0], v1[1]); w.w = cvt_pk_bf16(v1[2], v1[3]);
                        *(u32x4*)(rp + bj * HALF) = w;
                    }
                }
        } else {
            const long o = (long)u.pm * 256 * 1024 + u.pn * 256;
            f32x4 gv[2][2], bv[2][2];
#pragma unroll
            for (int bj = 0; bj < 2; ++bj)
#pragma unroll
                for (int n = 0; n < 2; ++n) {
                    gv[bj][n] = (f32x4){1.f, 1.f, 1.f, 1.f}; bv[bj][n] = (f32x4){0.f, 0.f, 0.f, 0.f};
                    if (stats) { gv[bj][n] = *(const f32x4*)(gp + u.pn * 256 + wc * 32 + fq * 8 + bj * HALF + n * 4); bv[bj][n] = *(const f32x4*)(bp + u.pn * 256 + wc * 32 + fq * 8 + bj * HALF + n * 4); }
                }
#pragma unroll
            for (int ai = 0; ai < 2; ++ai)
#pragma unroll
                for (int m = 0; m < 4; ++m) {
                    const int row = u.pm * 256 + ai * HALF + wr * 64 + m * 16 + fr;
                    const long ro = o + (long)(ai * HALF + wr * 64 + m * 16 + fr) * 1024 + wc * 32 + fq * 8;
                    float mu = 0.f, rs = 1.f;
                    if (stats) { mu = stats[2 * row]; rs = stats[2 * row + 1]; }
#pragma unroll
                    for (int bj = 0; bj < 2; ++bj)
#pragma unroll
                        for (int n = 0; n < 2; ++n) {
                            f32x4 xv = *(const f32x4*)(xin + ro + bj * HALF + n * 4);
                            if (stats) xv = (xv - mu) * rs * gv[bj][n] + bv[bj][n];
                            const f32x4 r = xv * ALPHA + acc[ai][bj][m][n];
                            *(f32x4*)(of + ro + bj * HALF + n * 4) = r;
                        }
                }
        }
    }
};

__device__ __forceinline__ void gemm_phase(LAS unsigned char* lds, const Sched& S, const Epi& E) {
    int tid = threadIdx.x; asm volatile("" : "+v"(tid));
    const int wid = __builtin_amdgcn_readfirstlane(tid >> 6), lane = tid & 63, wr = wid >> 2, wc = wid & 3, fr = lane & 15, fq = lane >> 4;
    constexpr int K = GK, nt = K / BK;
    unsigned voffA[2], voffB[2];
#pragma unroll
    for (int i = 0; i < 2; ++i) { int R, C; stage_rc(tid * 16 + i * 8192, R, C); const int Rb = (R & ~31) + perm32(R & 31);
        voffA[i] = (unsigned)(R * K + C) * 2u; voffB[i] = (unsigned)(Rb * K + C) * 2u; }
    constexpr size_t kstep = (size_t)(BK * 2);
    constexpr size_t hstep = (size_t)HALF * K * 2;
    const unsigned ldsw = (unsigned)wid * 1024u;
    const int aoff = lds_byte(wr * 64 + fr, fq * 8), boff = lds_byte(wc * 32 + fr, fq * 8);
#define PG8_SA(b, h) (((b) * 2 + (h)) * HTB)
#define PG8_SB(b, h) ((4 + (b) * 2 + (h)) * HTB)
#define PG8_STAGE(bufoff, gbase, voff) do { _Pragma("unroll") for (int _i = 0; _i < 2; ++_i) \
        __builtin_amdgcn_global_load_lds((const unsigned*)((const char*)(gbase) + (voff)[_i]), (LAS unsigned*)(lds + (bufoff) + ldsw + _i * 8192), 16, 0, 0); } while (0)
#define PG8_LDA(dst, b, h) do { _Pragma("unroll") for (int m = 0; m < 4; ++m) _Pragma("unroll") for (int k = 0; k < 2; ++k) dst[m][k] = *(const LAS bf16x8*)(lds + PG8_SA(b, h) + aoff + m * 2048 + k * 1024); } while (0)
#define PG8_LDB(dst, b, h) do { _Pragma("unroll") for (int n = 0; n < 2; ++n) _Pragma("unroll") for (int k = 0; k < 2; ++k) dst[n][k] = *(const LAS bf16x8*)(lds + PG8_SB(b, h) + boff + n * 2048 + k * 1024); } while (0)
#define PG8_MMA(ai, bj, At, Bt) do { __builtin_amdgcn_s_setprio(1); _Pragma("unroll") for (int m = 0; m < 4; ++m) _Pragma("unroll") for (int n = 0; n < 2; ++n) _Pragma("unroll") for (int k = 0; k < 2; ++k) \
        acc[ai][bj][m][n] = __builtin_amdgcn_mfma_f32_16x16x32_bf16(Bt[n][k], At[m][k], acc[ai][bj][m][n], 0, 0, 0); __builtin_amdgcn_s_setprio(0); } while (0)
#define PG8_WAIT_V(n) asm volatile("s_waitcnt vmcnt(" #n ")" ::: "memory")
#define PG8_WAIT_L(n) asm volatile("s_waitcnt lgkmcnt(" #n ")" ::: "memory")
#define PG8_BAR __builtin_amdgcn_s_barrier()
#define PG8_SCHED __builtin_amdgcn_sched_barrier(0)
    Unit cur, nxt; int ui = 0;
    if (!S.next(0, cur)) return;
    f32x4 acc[2][2][4][2];
#pragma unroll
    for (int a = 0; a < 2; ++a)
#pragma unroll
        for (int b = 0; b < 2; ++b)
#pragma unroll
            for (int m = 0; m < 4; ++m)
#pragma unroll
                for (int n = 0; n < 2; ++n) acc[a][b][m][n] = (f32x4){0.f, 0.f, 0.f, 0.f};
    bf16x8 At[4][2], B0[2][2], B1[2][2];
    const char* cA = S.pA(cur); const char* cB = S.pB(cur);
    PG8_STAGE(PG8_SB(0, 0), cB, voffB); PG8_STAGE(PG8_SB(0, 1), cB + hstep, voffB); PG8_STAGE(PG8_SA(0, 0), cA, voffA); PG8_STAGE(PG8_SA(0, 1), cA + hstep, voffA);
    if (wr == 1) PG8_BAR;
    PG8_WAIT_V(2); PG8_BAR;
    PG8_STAGE(PG8_SB(1, 0), cB + kstep, voffB); PG8_STAGE(PG8_SA(1, 0), cA + kstep, voffA); PG8_STAGE(PG8_SB(1, 1), cB + hstep + kstep, voffB);
    PG8_WAIT_V(6); PG8_BAR;
    for (;;) {
        const bool has_next = S.next(ui + 1, nxt);
        const char* nA = has_next ? S.pA(nxt) : cA; const char* nB = has_next ? S.pB(nxt) : cB;
        for (int t = 0; t < nt; t += 2) {
            const bool last = (t == nt - 2);
            const char* a1 = cA + (size_t)(t + 1) * kstep;
            const char* a2 = last ? nA : cA + (size_t)(t + 2) * kstep; const char* b2 = last ? nB : cB + (size_t)(t + 2) * kstep;
            const char* a3 = a2 + kstep; const char* b3 = b2 + kstep;
            PG8_LDB(B0, 0, 0); PG8_LDB(B1, 0, 1); PG8_SCHED; PG8_LDA(At, 0, 0); PG8_STAGE(PG8_SA(1, 1), a1 + hstep, voffA);
            PG8_WAIT_V(8); PG8_WAIT_L(0); PG8_BAR; PG8_MMA(0, 0, At, B0); PG8_MMA(0, 1, At, B1); PG8_BAR; PG8_SCHED;
            PG8_LDA(At, 0, 1); PG8_STAGE(PG8_SB(0, 0), b2, voffB); PG8_STAGE(PG8_SB(0, 1), b2 + hstep, voffB); PG8_STAGE(PG8_SA(0, 0), a2, voffA);
            PG8_WAIT_V(8); PG8_WAIT_L(0); PG8_BAR; PG8_MMA(1, 0, At, B0); PG8_MMA(1, 1, At, B1); PG8_BAR; PG8_SCHED;
            PG8_LDB(B0, 1, 0); PG8_LDB(B1, 1, 1); PG8_SCHED; PG8_LDA(At, 1, 0); PG8_STAGE(PG8_SA(0, 1), a2 + hstep, voffA);
            PG8_WAIT_V(8); PG8_WAIT_L(0); PG8_BAR; PG8_MMA(0, 0, At, B0); PG8_MMA(0, 1, At, B1); PG8_BAR; PG8_SCHED;
            PG8_LDA(At, 1, 1); PG8_STAGE(PG8_SB(1, 0), b3, voffB); PG8_STAGE(PG8_SB(1, 1), b3 + hstep, voffB); PG8_STAGE(PG8_SA(1, 0), a3, voffA);
            PG8_WAIT_V(8); PG8_WAIT_L(0); PG8_BAR; PG8_MMA(1, 0, At, B0); PG8_MMA(1, 1, At, B1); PG8_BAR; PG8_SCHED;
        }
        if (wr == 0) PG8_BAR;
        E(acc, cur, wr, wc, fr, fq);
        if (!has_next) break;
#pragma unroll
        for (int a = 0; a < 2; ++a)
#pragma unroll
            for (int b = 0; b < 2; ++b)
#pragma unroll
                for (int m = 0; m < 4; ++m)
#pragma unroll
                    for (int n = 0; n < 2; ++n) acc[a][b][m][n] = (f32x4){0.f, 0.f, 0.f, 0.f};
        cur = nxt; cA = nA; cB = nB; ++ui;
        if (wr == 1) PG8_BAR;
    }
    PG8_WAIT_V(0);
    PG8_BAR;
#undef PG8_SA
#undef PG8_SB
#undef PG8_STAGE
#undef PG8_LDA
#undef PG8_LDB
#undef PG8_MMA
}

constexpr int KROW = 144, VROW = 136;
constexpr int L_KB = 0, L_VB = 2 * 64 * KROW, L_FB = L_VB + 2 * 64 * VROW, L_RELB = L_FB + 512, L_OST = L_RELB + 1280, L_UW = L_OST + 8 * 32 * KROW, L_ATT_END = L_UW + 8 * 128 * 4;
static_assert(L_ATT_END <= LDS_PHASE_BYTES, "lds");
constexpr float TH_DEFER = 8.0f;
constexpr float PRUNE_NAT = 40.0f;

template <int MODE>
__device__ __forceinline__ void attn_unit(const bf16_t* __restrict__ QKVZ, const bf16_t* __restrict__ VT, const float* __restrict__ aux,
                                          bf16_t* __restrict__ G, int b, int h, int qb, int jlo, const float* __restrict__ nrm) {
    unsigned char* lds = g_shm;
    int tid = threadIdx.x; asm volatile("" : "+v"(tid));
    const int w = tid >> 6, lane = tid & 63, q = lane & 31, hh = lane >> 5;
    const int r0 = qb * 256 + w * 32, t = r0 + q;
    const int jhi = qb * 4 + 3, cw = qb * 4 + (w >> 1);
    const int lrow = tid >> 3, lch = tid & 7;
    const bf16_t* kbase = QKVZ + ((long)(b * SEQ + lrow)) * 4096 + 1024 + h * 64 + lch * 8;
    const bf16_t* vbase = VT + ((long)((b * NH + h) * 64 + lrow)) * SEQ + lch * 8;
    const float* fbase = aux + (long)(b * NH + h) * SEQ;
    constexpr float SC = 0.125f * LOG2E;

    __syncthreads();
    bf16x8 qf[4];
    {
        const bf16_t* qp = QKVZ + ((long)(b * SEQ + t)) * 4096 + h * 64 + hh * 8;
#pragma unroll
        for (int ks = 0; ks < 4; ++ks) qf[ks] = *(const bf16x8*)(qp + ks * 16);
    }
    float Ft = 0.f;
    if (MODE == 1) Ft = fbase[t] * LOG2E;
    u32x4 k0r, v0r, k1r, v1r, k2r, v2r; float f0r = 0.f, f1r = 0.f, f2r = 0.f;
    k0r = *(const u32x4*)(kbase + (long)jhi * 64 * 4096);       v0r = *(const u32x4*)(vbase + jhi * 64);
    k1r = *(const u32x4*)(kbase + (long)(jhi - 1) * 64 * 4096); v1r = *(const u32x4*)(vbase + (jhi - 1) * 64);
    k2r = *(const u32x4*)(kbase + (long)(jhi - 2) * 64 * 4096); v2r = *(const u32x4*)(vbase + (jhi - 2) * 64);
    if (MODE == 1) { if (tid < 64) { f0r = fbase[jhi * 64 + tid]; f1r = fbase[(jhi - 1) * 64 + tid]; f2r = fbase[(jhi - 2) * 64 + tid]; } }
    u32x4 zpre[4];
#pragma unroll
    for (int i = 0; i < 4; ++i) zpre[i] = *(const u32x4*)(QKVZ + (long)(b * SEQ + r0 + (lane >> 3) + 8 * i) * 4096 + 3072 + h * 64 + (lane & 7) * 8);
    if (MODE == 1) {
        int* JL = (int*)(lds + L_RELB);
        const float* NQ = nrm + ((long)(b * 128)) * 32 + 2 * h;
        const float* NK = nrm + ((long)(1024 + b * 128)) * 32 + 2 * h;
        float Qa = 0.f, Qb = 0.f, Bd = 0.f;
#pragma unroll
        for (int i = 0; i < 4; ++i) { Qa = fmaxf(Qa, sqrtf(ld_coh(NQ + (4 * qb + i) * 32))); Qb = fmaxf(Qb, sqrtf(ld_coh(NQ + (4 * qb + i) * 32 + 1))); }
#pragma unroll
        for (int i = 0; i < 4; ++i) Bd = fmaxf(Bd, Qa * sqrtf(ld_coh(NK + (4 * qb + i) * 32)) + Qb * sqrtf(ld_coh(NK + (4 * qb + i) * 32 + 1)));
        if (tid == 0) *JL = 4 * qb;
        __syncthreads();
        if (tid < 4 * qb) {
            const float Bj = Qa * sqrtf(ld_coh(NK + tid * 32)) + Qb * sqrtf(ld_coh(NK + tid * 32 + 1));
            const float Dj = ld_coh(fbase + 256 * qb) - ld_coh(fbase + 64 * tid + 63);
            if (!((Bj + Bd) * 0.125f + Dj < -PRUNE_NAT)) atomicMin(JL, tid);
        }
        __syncthreads();
        jlo = *JL;
        float* UW = (float*)(lds + L_UW) + w * 128;
        const float qa = sqrtf(ld_coh(NQ + cw * 32)), qbb = sqrtf(ld_coh(NQ + cw * 32 + 1));
        const float Fr0 = ld_coh(fbase + r0);
        for (int jr = lane; jr < cw - jlo; jr += 64) {
            const int j = jlo + jr;
            const float ka = sqrtf(ld_coh(NK + j * 32)), kb = sqrtf(ld_coh(NK + j * 32 + 1));
            UW[jr] = (qa * ka + qbb * kb) * SC + (Fr0 - ld_coh(fbase + 64 * j + 63)) * LOG2E;
        }
    }
    if (MODE == 0) { if (tid < 288) { int rl = 192 - tid; rl = rl < -128 ? -128 : (rl > 128 ? 128 : rl); ((float*)(lds + L_RELB))[tid] = aux[h * 257 + rl + 128] * LOG2E; } }

    f32x16 O0, O1;
#pragma unroll
    for (int i = 0; i < 16; ++i) { O0[i] = 0.f; O1[i] = 0.f; }
    float m_run = 0.f, l_run = 0.f, m_min = -1e30f;
    bool first = true;

    auto LOADT = [&](u32x4& kr, u32x4& vr, float& fr_, int jj) __attribute__((always_inline)) {
        if (jj >= jlo) {
            kr = *(const u32x4*)(kbase + (long)jj * 64 * 4096);
            vr = *(const u32x4*)(vbase + jj * 64);
            if (MODE == 1) { if (tid < 64) fr_ = fbase[jj * 64 + tid]; }
        }
    };
    auto STEP = [&](u32x4& kreg, u32x4& vreg, float& freg, int j) __attribute__((always_inline)) {
        const int buf = (jhi - j) & 1;
        unsigned char* KB = lds + L_KB + buf * 64 * KROW;
        unsigned char* VB = lds + L_VB + buf * 64 * VROW;
        float* FB = (float*)(lds + L_FB + buf * 256);
        *(u32x4*)(KB + lrow * KROW + lch * 16) = kreg;
        *(u32x2*)(VB + lrow * VROW + lch * 16) = (u32x2){vreg.x, vreg.y};
        *(u32x2*)(VB + lrow * VROW + lch * 16 + 8) = (u32x2){vreg.z, vreg.w};
        if (MODE == 1) { if (tid < 64) FB[tid] = freg * LOG2E; }
        __syncthreads();
        LOADT(kreg, vreg, freg, j - 3);
        bool active;
        if (MODE == 0) active = (j >= cw - 8 && j <= cw);
        else {
            active = (j <= cw);
            if (j < cw) { const float ub = ((const float*)(lds + L_UW))[w * 128 + (j - jlo)]; if (ub - m_min < -PRUNE_NAT * LOG2E) active = false; }
        }
        if (active) {
            f32x16 s0, s1;
#pragma unroll
            for (int i = 0; i < 16; ++i) { s0[i] = 0.f; s1[i] = 0.f; }
#pragma unroll
            for (int ks = 0; ks < 4; ++ks) {
                const bf16x8 k0 = *(const bf16x8*)(KB + q * KROW + (16 * ks + 8 * hh) * 2);
                const bf16x8 k1 = *(const bf16x8*)(KB + (32 + q) * KROW + (16 * ks + 8 * hh) * 2);
                s0 = __builtin_amdgcn_mfma_f32_32x32x16_bf16(k0, qf[ks], s0, 0, 0, 0);
                s1 = __builtin_amdgcn_mfma_f32_32x32x16_bf16(k1, qf[ks], s1, 0, 0, 0);
            }
            if (MODE == 0) {
                const float* RB = (const float*)(lds + L_RELB);
                if (r0 - (64 * j + 63) >= 128) {
                    const float cb = RB[64] - m_run;
#pragma unroll
                    for (int i = 0; i < 16; ++i) { s0[i] = s0[i] * SC + cb; s1[i] = s1[i] * SC + cb; }
                } else {
                    const float* Rp = RB + (192 - (t - 64 * j - 4 * hh));
#pragma unroll
                    for (int i = 0; i < 16; ++i) {
                        s0[i] = s0[i] * SC + (Rp[(i & 3) + 8 * (i >> 2)] - m_run);
                        s1[i] = s1[i] * SC + (Rp[(i & 3) + 8 * (i >> 2) + 32] - m_run);
                    }
                }
            } else {
                const bool diag = (j == cw);
                const float base = Ft - m_run;
#pragma unroll
                for (int g = 0; g < 4; ++g) {
                    const f32x4 f0 = *(const f32x4*)(FB + 8 * g + 4 * hh);
                    const f32x4 f1 = *(const f32x4*)(FB + 32 + 8 * g + 4 * hh);
#pragma unroll
                    for (int e = 0; e < 4; ++e) {
                        const int i = 4 * g + e;
                        float x0 = s0[i] * SC + (base - f0[e]);
                        float x1 = s1[i] * SC + (base - f1[e]);
                        if (diag) {
                            const int sp = 64 * j + 8 * g + 4 * hh + e;
                            if (sp > t) x0 = -1e30f;
                            if (sp + 32 > t) x1 = -1e30f;
                        }
                        s0[i] = x0; s1[i] = x1;
                    }
                }
            }
            float mx = s0[0];
#pragma unroll
            for (int i = 1; i < 16; ++i) mx = fmaxf(mx, s0[i]);
#pragma unroll
            for (int i = 0; i < 16; ++i) mx = fmaxf(mx, s1[i]);
            if (first || __any(mx > TH_DEFER)) {
                mx = fmaxf(mx, __shfl_xor(mx, 32));
                float d;
                if (first) { d = mx; }
                else {
                    d = fmaxf(mx, 0.f);
                    const float al = __builtin_amdgcn_exp2f(-d);
                    l_run *= al;
#pragma unroll
                    for (int i = 0; i < 16; ++i) { O0[i] *= al; O1[i] *= al; }
                }
                m_run += d;
#pragma unroll
                for (int i = 0; i < 16; ++i) { s0[i] -= d; s1[i] -= d; }
                first = false;
                if (MODE == 1) {
                    float mm = m_run;
#pragma unroll
                    for (int o = 32; o >= 1; o >>= 1) mm = fminf(mm, __shfl_xor(mm, o));
                    m_min = mm;
                }
            }
            float ps = 0.f;
#pragma unroll
            for (int i = 0; i < 16; ++i) { s0[i] = __builtin_amdgcn_exp2f(s0[i]); s1[i] = __builtin_amdgcn_exp2f(s1[i]); ps += s0[i] + s1[i]; }
            l_run += ps;
#pragma unroll
            for (int s = 0; s < 4; ++s) {
                u32x4 pw;
                if (s < 2) { pw.x = cvt_pk_bf16(s0[8 * s + 0], s0[8 * s + 1]); pw.y = cvt_pk_bf16(s0[8 * s + 2], s0[8 * s + 3]); pw.z = cvt_pk_bf16(s0[8 * s + 4], s0[8 * s + 5]); pw.w = cvt_pk_bf16(s0[8 * s + 6], s0[8 * s + 7]); }
                else { const int sp = s - 2; pw.x = cvt_pk_bf16(s1[8 * sp + 0], s1[8 * sp + 1]); pw.y = cvt_pk_bf16(s1[8 * sp + 2], s1[8 * sp + 3]); pw.z = cvt_pk_bf16(s1[8 * sp + 4], s1[8 * sp + 5]); pw.w = cvt_pk_bf16(s1[8 * sp + 6], s1[8 * sp + 7]); }
                const bf16x8 pf = __builtin_bit_cast(bf16x8, pw);
                {
                    const u32x2 lo = *(const u32x2*)(VB + q * VROW + (16 * s + 4 * hh) * 2);
                    const u32x2 hi = *(const u32x2*)(VB + q * VROW + (16 * s + 8 + 4 * hh) * 2);
                    const bf16x8 vf = __builtin_bit_cast(bf16x8, ((u32x4){lo.x, lo.y, hi.x, hi.y}));
                    O0 = __builtin_amdgcn_mfma_f32_32x32x16_bf16(vf, pf, O0, 0, 0, 0);
                }
                {
                    const u32x2 lo = *(const u32x2*)(VB + (32 + q) * VROW + (16 * s + 4 * hh) * 2);
                    const u32x2 hi = *(const u32x2*)(VB + (32 + q) * VROW + (16 * s + 8 + 4 * hh) * 2);
                    const bf16x8 vf = __builtin_bit_cast(bf16x8, ((u32x4){lo.x, lo.y, hi.x, hi.y}));
                    O1 = __builtin_amdgcn_mfma_f32_32x32x16_bf16(vf, pf, O1, 0, 0, 0);
                }
            }
        }
    };
    for (int j = jhi; j >= jlo; j -= 3) {
        STEP(k0r, v0r, f0r, j);
        if (j - 1 >= jlo) STEP(k1r, v1r, f1r, j - 1);
        if (j - 2 >= jlo) STEP(k2r, v2r, f2r, j - 2);
    }
    const float lt = l_run + __shfl_xor(l_run, 32);
    const float inv = 1.0f / lt;
    unsigned char* OST = lds + L_OST + w * 32 * KROW;
#pragma unroll
    for (int g = 0; g < 4; ++g) {
        u32x2 w0, w1;
        w0.x = cvt_pk_bf16(O0[4 * g + 0] * inv, O0[4 * g + 1] * inv); w0.y = cvt_pk_bf16(O0[4 * g + 2] * inv, O0[4 * g + 3] * inv);
        w1.x = cvt_pk_bf16(O1[4 * g + 0] * inv, O1[4 * g + 1] * inv); w1.y = cvt_pk_bf16(O1[4 * g + 2] * inv, O1[4 * g + 3] * inv);
        *(u32x2*)(OST + q * KROW + (8 * g + 4 * hh) * 2) = w0;
        *(u32x2*)(OST + q * KROW + (32 + 8 * g + 4 * hh) * 2) = w1;
    }
    __syncthreads();
#pragma unroll
    for (int i = 0; i < 4; ++i) {
        const int row = (lane >> 3) + 8 * i, ch = lane & 7;
        const u32x4 o8 = *(const u32x4*)(OST + row * KROW + ch * 16);
        const long tok = (long)(b * SEQ + r0 + row);
        const u32x4 z8 = zpre[i];
        u32x4 r8;
#pragma unroll
        for (int e = 0; e < 4; ++e) {
            const unsigned ou = o8[e], zu = z8[e];
            const float z0 = bf_lo(zu), z1 = bf_hi(zu);
            const float g0 = bf_lo(ou) * z0 / (1.0f + __expf(-z0));
            const float g1 = bf_hi(ou) * z1 / (1.0f + __expf(-z1));
            r8[e] = cvt_pk_bf16(g0, g1);
        }
        *(u32x4*)(G + tok * 1024 + h * 64 + ch * 8) = r8;
    }
}

__device__ __forceinline__ void transpose_w(const float* __restrict__ src, int N, bf16_t* __restrict__ dst, int tile) {
    float* T = (float*)g_shm;
    int tid = threadIdx.x; asm volatile("" : "+v"(tid));
    const int ntn = N / 64, kt = tile / ntn, ntl = tile % ntn, k0 = kt * 64, n0 = ntl * 64;
    __syncthreads();
#pragma unroll
    for (int e = 0; e < 8; ++e) { const int idx = tid + 512 * e, kk = idx >> 6, nn = idx & 63; T[kk * 65 + nn] = src[(long)(k0 + kk) * N + n0 + nn]; }
    __syncthreads();
#pragma unroll
    for (int e = 0; e < 4; ++e) { const int idx = tid + 512 * e, nn = idx >> 5, kp = idx & 31;
        *(unsigned*)(dst + (long)(n0 + nn) * 1024 + k0 + 2 * kp) = cvt_pk_bf16(T[(2 * kp) * 65 + nn], T[(2 * kp + 1) * 65 + nn]); }
}

__device__ __forceinline__ float log_sigmoid(float z) { return fminf(z, 0.f) - log1pf(expf(-fabsf(z))); }

__device__ __forceinline__ void ln_phase(float* __restrict__ io, bf16_t* __restrict__ XB, const float* __restrict__ g, const float* __restrict__ bta,
                                         const float* __restrict__ wf, const float* __restrict__ bf, float* __restrict__ LOGF,
                                         float* __restrict__ stats, const bool write_x) {
    int tid = threadIdx.x; asm volatile("" : "+v"(tid));
    const int w = tid >> 6, lane = tid & 63;
    f32x4* WF = (f32x4*)g_shm;
    if (wf) {
        __syncthreads();
        for (int idx = tid; idx < 4096; idx += 512) {
            const int ln = idx & 63, hq = (idx >> 6) & 3, ie = idx >> 8, k = 4 * (ln + 64 * (ie >> 2)) + (ie & 3);
            WF[idx] = *(const f32x4*)(wf + k * 16 + 4 * hq);
        }
        __syncthreads();
    }
    f32x4 gv[4], bv[4];
#pragma unroll
    for (int i = 0; i < 4; ++i) { gv[i] = *(const f32x4*)(g + 4 * (lane + 64 * i)); bv[i] = *(const f32x4*)(bta + 4 * (lane + 64 * i)); }
    const int G_ = gridDim.x, c_ = blockIdx.x;
    const int nri = (c_ < 256) ? ((256 - c_ + G_ - 1) / G_) * 32 : 0;
    auto row_of = [&](int ri) __attribute__((always_inline)) { return (c_ + (ri >> 5) * G_) * 256 + w + 8 * (ri & 31); };
    f32x4 nv[4];
    if (nri > 0) {
        const int row = row_of(0);
#pragma unroll
        for (int i = 0; i < 4; ++i) nv[i] = *(const f32x4*)(io + (long)row * 1024 + 4 * (lane + 64 * i));
    }
    for (int ri = 0; ri < nri; ++ri) {
        const int row = row_of(ri);
        float* rp = io + (long)row * 1024;
        f32x4 v[4];
#pragma unroll
        for (int i = 0; i < 4; ++i) v[i] = nv[i];
        if (ri + 1 < nri) {
            const int nrow = row_of(ri + 1);
#pragma unroll
            for (int i = 0; i < 4; ++i) nv[i] = *(const f32x4*)(io + (long)nrow * 1024 + 4 * (lane + 64 * i));
        }
        float s = 0.f;
#pragma unroll
        for (int i = 0; i < 4; ++i) s += (v[i][0] + v[i][1]) + (v[i][2] + v[i][3]);
#pragma unroll
        for (int o = 32; o >= 1; o >>= 1) s += __shfl_xor(s, o);
        const float mu = s * (1.0f / 1024.0f);
        float qs = 0.f;
#pragma unroll
        for (int i = 0; i < 4; ++i) { v[i] = v[i] - mu; qs += (v[i][0] * v[i][0] + v[i][1] * v[i][1]) + (v[i][2] * v[i][2] + v[i][3] * v[i][3]); }
#pragma unroll
        for (int o = 32; o >= 1; o >>= 1) qs += __shfl_xor(qs, o);
        const float rstd = 1.0f / sqrtf(qs * (1.0f / 1024.0f) + LN_EPS);
        if (!write_x && lane == 0) { stats[2 * row] = mu; stats[2 * row + 1] = rstd; }
#pragma unroll
        for (int i = 0; i < 4; ++i) {
            v[i] = v[i] * rstd * gv[i] + bv[i];
            if (write_x) *(f32x4*)(rp + 4 * (lane + 64 * i)) = v[i];
            if (XB) { u32x2 pk; pk.x = cvt_pk_bf16(v[i][0], v[i][1]); pk.y = cvt_pk_bf16(v[i][2], v[i][3]);
                *(u32x2*)(XB + (long)row * 1024 + 4 * (lane + 64 * i)) = pk; }
        }
        if (wf) {
            float a[16];
#pragma unroll
            for (int c = 0; c < 16; ++c) a[c] = 0.f;
#pragma unroll
            for (int i = 0; i < 4; ++i)
#pragma unroll
                for (int e = 0; e < 4; ++e) {
                    const float xv = v[i][e];
#pragma unroll
                    for (int hq = 0; hq < 4; ++hq) {
                        const f32x4 w4 = WF[((i * 4 + e) * 4 + hq) * 64 + lane];
                        a[4 * hq + 0] += xv * w4[0]; a[4 * hq + 1] += xv * w4[1]; a[4 * hq + 2] += xv * w4[2]; a[4 * hq + 3] += xv * w4[3];
                    }
                }
#pragma unroll
            for (int i = 0; i < 8; ++i) { const bool up = (lane & 32) != 0; const float send = up ? a[i] : a[i + 8], keep = up ? a[i + 8] : a[i]; a[i] = keep + __shfl_xor(send, 32); }
#pragma unroll
            for (int i = 0; i < 4; ++i) { const bool up = (lane & 16) != 0; const float send = up ? a[i] : a[i + 4], keep = up ? a[i + 4] : a[i]; a[i] = keep + __shfl_xor(send, 16); }
#pragma unroll
            for (int i = 0; i < 2; ++i) { const bool up = (lane & 8) != 0; const float send = up ? a[i] : a[i + 2], keep = up ? a[i + 2] : a[i]; a[i] = keep + __shfl_xor(send, 8); }
            { const bool up = (lane & 4) != 0; const float send = up ? a[0] : a[1], keep = up ? a[1] : a[0]; a[0] = keep + __shfl_xor(send, 4); }
            a[0] += __shfl_xor(a[0], 2); a[0] += __shfl_xor(a[0], 1);
            if ((lane & 3) == 0) {
                const int hd = ((lane >> 5) & 1) * 8 + ((lane >> 4) & 1) * 4 + ((lane >> 3) & 1) * 2 + ((lane >> 2) & 1);
                const int bb = row / SEQ, ss = row % SEQ;
                LOGF[((long)(bb * NH + hd)) * SEQ + ss] = log_sigmoid(a[0] + bf[hd]);
            }
        }
    }
}

__device__ __forceinline__ void scan_phase(float* __restrict__ F) {
    float* red = (float*)g_shm;
    int tid = threadIdx.x; asm volatile("" : "+v"(tid));
    const int w = tid >> 6, lane = tid & 63;
    for (int bh = blockIdx.x; bh < NB * NH; bh += gridDim.x) {
        float* p = F + (long)bh * SEQ + tid * 16;
        f32x4 v[4];
#pragma unroll
        for (int i = 0; i < 4; ++i) v[i] = *(const f32x4*)(p + 4 * i);
        float run = 0.f;
#pragma unroll
        for (int i = 0; i < 4; ++i)
#pragma unroll
            for (int e = 0; e < 4; ++e) { run += v[i][e]; v[i][e] = run; }
        float inc = run;
#pragma unroll
        for (int o = 1; o < 64; o <<= 1) { const float y = __shfl_up(inc, o); if (lane >= o) inc += y; }
        __syncthreads();
        if (lane == 63) red[w] = inc;
        __syncthreads();
        float base = inc - run;
        for (int ww = 0; ww < w; ++ww) base += red[ww];
#pragma unroll
        for (int i = 0; i < 4; ++i) { v[i] = v[i] + base; *(f32x4*)(p + 4 * i) = v[i]; }
    }
}

#define XB_TMO      128
#define XB_XCNT(j)  (256  + 64 * (j))
#define XB_XSUB(j)  (1280 + 64 * (j))
#define XB_XGEN(j)  (2304 + 64 * (j))
#define XB_TOP      3328
#define XB_TOPGEN   3392
#define XCD_BAR_WORDS 3456
#define XB_SPIN_CAP (1u << 18)
__device__ __forceinline__ unsigned xb_ld(unsigned* p)              { return __hip_atomic_load(p, __ATOMIC_RELAXED, __HIP_MEMORY_SCOPE_AGENT); }
__device__ __forceinline__ unsigned xb_add(unsigned* p, unsigned v) { return __hip_atomic_fetch_add(p, v, __ATOMIC_RELAXED, __HIP_MEMORY_SCOPE_AGENT); }
__device__ __forceinline__ unsigned xb_xcc_id() { return (unsigned)__builtin_amdgcn_s_getreg((3 << 11) | 20) & 0xFu; }
#define XB_SPIN(cond, bar) do { unsigned _sp = 0; while (cond) { __builtin_amdgcn_s_sleep(1); \
    if ((++_sp & 255u) == 0u) { if (xb_ld(&(bar)[XB_TMO])) break; if (_sp > XB_SPIN_CAP) { atomicAdd(&(bar)[XB_TMO], 1u); break; } } } } while (0)
struct XcdBarrier { unsigned* bar; unsigned x; volatile LAS unsigned* st; };
__device__ __forceinline__ XcdBarrier xcd_barrier_post(unsigned* bar, volatile LAS unsigned* st) {
    XcdBarrier b; b.bar = bar; b.x = xb_xcc_id(); b.st = st;
    if (threadIdx.x == 0) (void)xb_add(&bar[XB_XCNT(b.x)], 1u);
    return b;
}
__device__ __forceinline__ void xcd_barrier_complete(unsigned* bar, unsigned x, unsigned& nloc, unsigned& nx) {
    const unsigned G = gridDim.x * gridDim.y * gridDim.z;
    unsigned sum, cnt, mine, sp = 0u;
    for (;;) {
        sum = 0u; cnt = 0u; mine = 0u;
#pragma unroll
        for (unsigned j = 0; j < 16; ++j) { const unsigned c = xb_ld(&bar[XB_XCNT(j)]); sum += c; cnt += (c > 0u) ? 1u : 0u; mine = (j == x) ? c : mine; }
        if (sum == G) break;
        __builtin_amdgcn_s_sleep(1);
        if ((++sp & 255u) == 0u) { if (xb_ld(&bar[XB_TMO])) break; if (sp > XB_SPIN_CAP) { atomicAdd(&bar[XB_TMO], 1u); break; } }
    }
    nloc = mine > 0u ? mine : 1u; nx = cnt > 0u ? cnt : 1u;
}
__device__ __forceinline__ void xcd_barrier(const XcdBarrier& b) {
    asm volatile("s_waitcnt vmcnt(0)" ::: "memory");
    __syncthreads();
    if (threadIdx.x == 0) {
        unsigned* bar = b.bar;
        __builtin_amdgcn_s_waitcnt(0);
        unsigned nloc = b.st[0], nx = b.st[1];
        if (nloc == 0u) { xcd_barrier_complete(bar, b.x, nloc, nx); b.st[0] = nloc; b.st[1] = nx; }
        const unsigned old = xb_add(&bar[XB_XSUB(b.x)], 1u);
        const unsigned gen = old / nloc;
        if (old + 1u == (gen + 1u) * nloc) {
            __builtin_amdgcn_fence(__ATOMIC_RELEASE, "agent");
            asm volatile("s_waitcnt vmcnt(0)" ::: "memory");
            const unsigned og = xb_add(&bar[XB_TOP], 1u);
            const unsigned tg = og / nx;
            if (og + 1u == (tg + 1u) * nx) xb_add(&bar[XB_TOPGEN], 1u);
            else XB_SPIN(xb_ld(&bar[XB_TOPGEN]) == tg, bar);
            __builtin_amdgcn_fence(__ATOMIC_ACQUIRE, "agent");
            xb_add(&bar[XB_XGEN(b.x)], 1u);
            asm volatile("s_waitcnt vmcnt(0)" ::: "memory");
        } else {
            XB_SPIN(xb_ld(&bar[XB_XGEN(b.x)]) == gen, bar);
            __builtin_amdgcn_fence(__ATOMIC_ACQUIRE, "agent");
            asm volatile("s_waitcnt vmcnt(0)" ::: "memory");
        }
    }
    __syncthreads();
}

__device__ __forceinline__ void grid_bar(unsigned* ctr, unsigned target) {
    __syncthreads();
    if (threadIdx.x == 0) {
        __builtin_amdgcn_fence(__ATOMIC_RELEASE, "agent");
        __hip_atomic_fetch_add(ctr, 1u, __ATOMIC_RELAXED, __HIP_MEMORY_SCOPE_AGENT);
        while (__hip_atomic_load(ctr, __ATOMIC_RELAXED, __HIP_MEMORY_SCOPE_AGENT) < target) __builtin_amdgcn_s_sleep(4);
        __builtin_amdgcn_fence(__ATOMIC_ACQUIRE, "agent");
    }
    __syncthreads();
}

__global__ void __launch_bounds__(512, 2) fwd_megakernel(Params p) {
    cg::grid_group grid = cg::this_grid();
    bf16_t* XB = (bf16_t*)(p.ws + WS_XB);
    bf16_t* QKVZ = (bf16_t*)(p.ws + WS_QKVZ);
    bf16_t* VT = (bf16_t*)(p.ws + WS_VT);
    bf16_t* G = (bf16_t*)(p.ws + WS_G);
    bf16_t* WIN = (bf16_t*)(p.ws + WS_WIN);
    bf16_t* WOUT = (bf16_t*)(p.ws + WS_WOUT);
    float* F = (float*)(p.ws + WS_F);
    float* NRM = (float*)(p.ws + WS_NRM);
    unsigned* CTR = (unsigned*)(p.ws + WS_CTR);
    float* STATS = (float*)(p.ws + WS_STATS);
    unsigned bar_gen = 0;
#define GRID_BAR() xcd_barrier(xbar)
    const int tid = threadIdx.x;
    LAS unsigned char* lds = (LAS unsigned char*)g_shm;

    unsigned* XBAR = (unsigned*)(p.ws + WS_XBAR);
    volatile LAS unsigned* xb_st = (volatile LAS unsigned*)((LAS unsigned char*)g_shm + LDS_PHASE_BYTES);
    if (tid == 0) { xb_st[0] = 0u; xb_st[1] = 0u; }
    if (blockIdx.x == 0) { for (int u = tid; u < XCD_BAR_WORDS; u += 512) __hip_atomic_store(XBAR + u, 0u, __ATOMIC_RELAXED, __HIP_MEMORY_SCOPE_AGENT); }
    __syncthreads();
    {
        const long nvec = (long)MTOK * 1024 / 8;
#pragma unroll 4
        for (long i = (long)blockIdx.x * 512 + tid; i < nvec; i += (long)gridDim.x * 512) {
            const f32x4 a = *(const f32x4*)(p.x + i * 8), c = *(const f32x4*)(p.x + i * 8 + 4);
            u32x4 o; o.x = cvt_pk_bf16(a[0], a[1]); o.y = cvt_pk_bf16(a[2], a[3]); o.z = cvt_pk_bf16(c[0], c[1]); o.w = cvt_pk_bf16(c[2], c[3]);
            *(u32x4*)(XB + i * 8) = o;
        }
        for (int u = blockIdx.x; u < DEPTH * 1280; u += gridDim.x) {
            const int l = u / 1280, tl = u % 1280;
            if (tl < 1024) {
                const float* src = ((l & 1) ? p.w_in_b : p.w_in_a) + (long)(l >> 1) * 1024 * 4096;
                transpose_w(src, 4096, WIN + (long)l * 4096 * 1024, tl);
            } else {
                const float* src = ((l & 1) ? p.w_out_b : p.w_out_a) + (long)(l >> 1) * 1024 * 1024;
                transpose_w(src, 1024, WOUT + (long)l * 1024 * 1024, tl - 1024);
            }
        }
    }
    grid.sync();
    const XcdBarrier xbar = xcd_barrier_post(XBAR, xb_st);

#pragma unroll 1
    for (int layer = 0; layer < DEPTH; ++layer) {
        const bool isB = (layer & 1) != 0;
        const bf16_t* Wi = WIN + (long)layer * 4096 * 1024;
        const bf16_t* Wo = WOUT + (long)layer * 1024 * 1024;
        if (isB) scan_phase(F);
        {
            Sched S; S.mode = 0; S.XB = (const char*)XB; S.W = (const char*)Wi; S.G = gridDim.x; S.c = blockIdx.x;
            Epi E; E.mode = 0; E.QKVZ = QKVZ; E.VT = VT; E.xin = nullptr; E.of = nullptr; E.nrm = isB ? NRM : nullptr; E.stats = nullptr; E.gp = nullptr; E.bp = nullptr;
            __syncthreads();
            gemm_phase(lds, S, E);
        }
        GRID_BAR();
        for (int u = blockIdx.x; u < 4096; u += gridDim.x) {
            const int c = u & 255, i = u >> 8;
            int qb = c >> 3;
            if (isB && (i & 1)) qb = 31 - qb;
            const int b = c & 7, h = i;
            if (!isB) attn_unit<0>(QKVZ, VT, p.rel_bias_a + (long)(layer >> 1) * NH * 257, G, b, h, qb, (qb * 4 - 8) > 0 ? (qb * 4 - 8) : 0, nullptr);
            else attn_unit<1>(QKVZ, VT, F, G, b, h, qb, 0, NRM);
        }
        GRID_BAR();
        {
            Sched S; S.mode = 1; S.XB = (const char*)G; S.W = (const char*)Wo; S.G = gridDim.x; S.c = blockIdx.x;
            Epi E; E.mode = 1; E.QKVZ = nullptr; E.VT = nullptr; E.xin = (layer == 0) ? p.x : p.out; E.of = p.out; E.nrm = nullptr;
            E.stats = (layer == 0) ? nullptr : STATS; E.gp = p.ln_g + (layer > 0 ? layer - 1 : 0) * 1024; E.bp = p.ln_b + (layer > 0 ? layer - 1 : 0) * 1024;
            __syncthreads();
            gemm_phase(lds, S, E);
        }
        __syncthreads();
        {
            const bool nextB = (layer + 1 < DEPTH) && ((layer + 1) & 1);
            const int jn = (layer + 1) >> 1;
            ln_phase(p.out, (layer + 1 < DEPTH) ? XB : nullptr, p.ln_g + layer * 1024, p.ln_b + layer * 1024,
                     nextB ? p.w_f_b + (long)jn * 1024 * 16 : nullptr, nextB ? p.b_f_b + jn * 16 : nullptr, F, STATS, layer + 1 == DEPTH);
        }
        if (layer + 1 < DEPTH) GRID_BAR();
    }
}

extern "C" void kernel_launch(void* const* d_in, const int* in_sizes, int n_in, void* d_out, int out_size, void* d_ws, size_t ws_size, hipStream_t stream) {
    static int grid_blocks = 0;
    if (grid_blocks == 0) {
        if (ws_size < WS_END) { fprintf(stderr, "kernel_launch: workspace too small (%zu < %zu)\n", ws_size, (size_t)WS_END); grid_blocks = -1; return; }
        int dev = 0, cus = 0, per_cu = 0;
        hipGetDevice(&dev);
        hipDeviceGetAttribute(&cus, hipDeviceAttributeMultiprocessorCount, dev);
        hipFuncSetAttribute((const void*)fwd_megakernel, hipFuncAttributeMaxDynamicSharedMemorySize, LDS_BYTES);
        hipOccupancyMaxActiveBlocksPerMultiprocessor(&per_cu, (const void*)fwd_megakernel, 512, LDS_BYTES);
        if (per_cu < 1) { fprintf(stderr, "kernel_launch: occupancy query says %d blocks per CU\n", per_cu); per_cu = 1; }
        grid_blocks = cus * 1;
        (void)hipGetLastError();
    }
    if (grid_blocks < 0) return;
    Params p{};
    p.x = (const float*)d_in[0]; p.w_in_a = (const float*)d_in[1]; p.rel_bias_a = (const float*)d_in[2]; p.w_out_a = (const float*)d_in[3];
    p.w_in_b = (const float*)d_in[4]; p.w_f_b = (const float*)d_in[5]; p.b_f_b = (const float*)d_in[6]; p.w_out_b = (const float*)d_in[7];
    p.ln_g = (const float*)d_in[8]; p.ln_b = (const float*)d_in[9];
    p.out = (float*)d_out; p.ws = (unsigned char*)d_ws;
    void* args[] = {&p};
    hipError_t e = hipLaunchCooperativeKernel((const void*)fwd_megakernel, dim3(grid_blocks), dim3(512), args, LDS_BYTES, stream);
    if (e != hipSuccess) fprintf(stderr, "cooperative launch failed: %s (grid %d)\n", hipGetErrorString(e), grid_blocks);
}
```

```cpp
#include <hip/hip_runtime.h>
#include <hip/hip_cooperative_groups.h>
#include <cstdio>
#include <cstdint>
namespace cg = cooperative_groups;

typedef unsigned short bf16_t;
typedef short bf16x8 __attribute__((ext_vector_type(8)));
typedef float f32x4 __attribute__((ext_vector_type(4)));
typedef float f32x16 __attribute__((ext_vector_type(16)));
typedef unsigned u32x4 __attribute__((ext_vector_type(4)));
typedef unsigned u32x2 __attribute__((ext_vector_type(2)));

constexpr int DM = 1024, NB = 8, SEQ = 8192, MTOK = NB * SEQ, NH = 16, DEPTH = 4;
constexpr float LN_EPS = 1e-5f;
constexpr float ALPHA = 1.681792830507429f;
constexpr float LOG2E = 1.4426950408889634f;
constexpr int LDS_PHASE_BYTES = 131072;
constexpr int LDS_BYTES = LDS_PHASE_BYTES + 16;

constexpr size_t WS_XB = 0;
constexpr size_t WS_QKVZ = WS_XB + (size_t)MTOK * 1024 * 2;
constexpr size_t WS_VT = WS_QKVZ + (size_t)MTOK * 4096 * 2;
constexpr size_t WS_G = WS_VT + (size_t)MTOK * 1024 * 2;
constexpr size_t WS_WIN = WS_G + (size_t)MTOK * 1024 * 2;
constexpr size_t WS_WOUT = WS_WIN + (size_t)DEPTH * 4096 * 1024 * 2;
constexpr size_t WS_F = WS_WOUT + (size_t)DEPTH * 1024 * 1024 * 2;
constexpr size_t WS_NRM = WS_F + (size_t)NB * NH * SEQ * 4;
constexpr size_t WS_CTR = WS_NRM + (size_t)2 * 1024 * 128 * 4;
constexpr size_t WS_STATS = WS_CTR + 256;
constexpr size_t WS_XBAR = WS_STATS + (size_t)MTOK * 2 * 4;
constexpr size_t WS_END = WS_XBAR + 16384;

extern __shared__ __attribute__((aligned(16))) unsigned char g_shm[];

struct Params {
    const float* x; const float* w_in_a; const float* rel_bias_a; const float* w_out_a;
    const float* w_in_b; const float* w_f_b; const float* b_f_b; const float* w_out_b;
    const float* ln_g; const float* ln_b;
    float* out; unsigned char* ws;
};

typedef __bf16 bf16x2_t __attribute__((ext_vector_type(2)));
typedef float f32x2_t __attribute__((ext_vector_type(2)));
__device__ __forceinline__ unsigned cvt_pk_bf16(float lo, float hi) { const f32x2_t v = {lo, hi}; const bf16x2_t r = __builtin_convertvector(v, bf16x2_t); return __builtin_bit_cast(unsigned, r); }
__device__ __forceinline__ float ld_coh(const float* p) { return __hip_atomic_load(p, __ATOMIC_RELAXED, __HIP_MEMORY_SCOPE_AGENT); }
template <int CTRL> __device__ __forceinline__ float dpp_f(float v) { return __int_as_float(__builtin_amdgcn_update_dpp(0, __float_as_int(v), CTRL, 0xf, 0xf, false)); }
__device__ __forceinline__ float bf_lo(unsigned u) { return __uint_as_float(u << 16); }
__device__ __forceinline__ float bf_hi(unsigned u) { return __uint_as_float(u & 0xffff0000u); }

#define LAS __attribute__((address_space(3)))
constexpr int BK = 64, HALF = 128, HTB = HALF * BK * 2, GK = 1024;
__device__ __forceinline__ int lds_byte(int r, int c) { const int st = (r >> 4) * 2 + (c >> 5), rr = r & 15, cc = c & 31, ob = rr * 64 + cc * 2; return st * 1024 + (ob ^ (((ob >> 9) & 1) << 5)); }
__device__ __forceinline__ void stage_rc(int b, int& R, int& C) { const int st = b / 1024, sb = b % 1024, swz = sb ^ (((sb >> 9) & 1) << 5); R = (st >> 1) * 16 + swz / 64; C = (st & 1) * 32 + (swz % 64) / 2; }
__device__ __forceinline__ int perm32(int rho) { const int n = rho >> 4, i = rho & 15; return 8 * (i >> 2) + 4 * n + (i & 3); }

__device__ __forceinline__ void tile_map(int L, int nM, int nN, int& pm, int& pn) {
    const int nwg = nM * nN; int wgid = L;
    { const int q = nwg / 8, r = nwg % 8, xcd = wgid % 8, off = wgid / 8; wgid = (xcd < r ? xcd * (q + 1) : r * (q + 1) + (xcd - r) * q) + off; }
    const int nig = 8 * nN, gid = wgid / nig, fm = gid * 8, gsz = (nM - fm) < 8 ? (nM - fm) : 8;
    pm = fm + ((wgid % nig) % gsz); pn = (wgid % nig) / gsz;
}

struct Unit { int pm, pn; };
constexpr size_t TSTEP = (size_t)256 * GK * 2;
struct Sched {
    int mode;
    const char* XB; const char* W; int G, c;
    __device__ __forceinline__ bool next(int i, Unit& u) const {
        if (mode == 1) { const int panel = c + (i >> 2) * G; if (panel >= 256) return false; u.pm = panel; u.pn = i & 3; return true; }
        const long L = (long)i * G + c; if (L >= 4096) return false;
        tile_map((int)L, 256, 16, u.pm, u.pn); return true;
    }
    __device__ __forceinline__ bool vt(const Unit& u) const { return mode == 0 && u.pn >= 8 && u.pn < 12; }
    __device__ __forceinline__ const char* pA(const Unit& u) const { return vt(u) ? W + (size_t)u.pn * TSTEP : XB + (size_t)u.pm * TSTEP; }
    __device__ __forceinline__ const char* pB(const Unit& u) const { return vt(u) ? XB + (size_t)u.pm * TSTEP : W + (size_t)u.pn * TSTEP; }
};
struct Epi {
    int mode; bf16_t* QKVZ; bf16_t* VT; const float* xin; float* of; float* nrm;
    const float* stats; const float* gp; const float* bp;
    __device__ __forceinline__ void operator()(const f32x4 (&acc)[2][2][4][2], const Unit& u, int wr, int wc, int fr, int fq) const {
        if (mode == 0) {
            bf16_t* ob; long ldo;
            if (u.pn >= 8 && u.pn < 12) { ob = VT + ((long)((u.pm >> 5) * 1024 + (u.pn - 8) * 256)) * SEQ + (u.pm & 31) * 256; ldo = SEQ; }
            else { ob = QKVZ + (long)u.pm * 256 * 4096 + u.pn * 256; ldo = 4096; }
            if (nrm && u.pn < 8) {
                const int which = u.pn >> 2, pnl = u.pn & 3;
#pragma unroll
                for (int ai = 0; ai < 2; ++ai)
#pragma unroll
                    for (int bj = 0; bj < 2; ++bj) {
                        float mx = 0.f;
#pragma unroll
                        for (int m = 0; m < 4; ++m) {
                            const f32x4 v0 = acc[ai][bj][m][0], v1 = acc[ai][bj][m][1];
                            float s = (v0[0] * v0[0] + v0[1] * v0[1]) + (v0[2] * v0[2] + v0[3] * v0[3]) + (v1[0] * v1[0] + v1[1] * v1[1]) + (v1[2] * v1[2] + v1[3] * v1[3]);
                            s += __shfl_xor(s, 16); s += __shfl_xor(s, 32);
                            mx = fmaxf(mx, s);
                        }
                        mx = fmaxf(mx, dpp_f<0xB1>(mx)); mx = fmaxf(mx, dpp_f<0x4E>(mx)); mx = fmaxf(mx, dpp_f<0x141>(mx)); mx = fmaxf(mx, dpp_f<0x140>(mx));
                        if (fr == 0 && fq == 0) nrm[((long)which * 1024 + (u.pm * 4 + 2 * ai + wr)) * 32 + pnl * 8 + 4 * bj + wc] = mx * 1.02f;
                    }
            }
#pragma unroll
            for (int ai = 0; ai < 2; ++ai)
#pragma unroll
                for (int m = 0; m < 4; ++m) {
                    bf16_t* rp = ob + (long)(ai * HALF + wr * 64 + m * 16 + fr) * ldo + wc * 32 + fq * 8;
#pragma unroll
                    for (int bj = 0; bj < 2; ++bj) {
                        const f32x4 v0 = acc[ai][bj][m][0], v1 = acc[ai][bj][m][1];
                        u32x4 w; w.x = cvt_pk_bf16(v0[0], v0[1]); w.y = cvt_pk_bf16(v0[2], v0[3]); w.z = cvt_pk_bf16(v1[0], v1[1]); w.w = cvt_pk_bf16(v1[2], v1[3]);
                        *(u32x4*)(rp + bj * HALF) = w;
                    }
                }
        } else {
            const long o = (long)u.pm * 256 * 1024 + u.pn * 256;
            f32x4 gv[2][2], bv[2][2];
#pragma unroll
            for (int bj = 0; bj < 2; ++bj)
#pragma unroll
                for (int n = 0; n < 2; ++n) {
                    gv[bj][n] = (f32x4){1.f, 1.f, 1.f, 1.f}; bv[bj][n] = (f32x4){0.f, 0.f, 0.f, 0.f};
                    if (stats) { gv[bj][n] = *(const f32x4*)(gp + u.pn * 256 + wc * 32 + fq * 8 + bj * HALF + n * 4); bv[bj][n] = *(const f32x4*)(bp + u.pn * 256 + wc * 32 + fq * 8 + bj * HALF + n * 4); }
                }
#pragma unroll
            for (int ai = 0; ai < 2; ++ai)
#pragma unroll
                for (int m = 0; m < 4; ++m) {
                    const int row = u.pm * 256 + ai * HALF + wr * 64 + m * 16 + fr;
                    const long ro = o + (long)(ai * HALF + wr * 64 + m * 16 + fr) * 1024 + wc * 32 + fq * 8;
                    float mu = 0.f, rs = 1.f;
                    if (stats) { mu = stats[2 * row]; rs = stats[2 * row + 1]; }
#pragma unroll
                    for (int bj = 0; bj < 2; ++bj)
#pragma unroll
                        for (int n = 0; n < 2; ++n) {
                            f32x4 xv = *(const f32x4*)(xin + ro + bj * HALF + n * 4);
                            if (stats) xv = (xv - mu) * rs * gv[bj][n] + bv[bj][n];
                            const f32x4 r = xv * ALPHA + acc[ai][bj][m][n];
                            *(f32x4*)(of + ro + bj * HALF + n * 4) = r;
                        }
                }
        }
    }
};

__device__ __forceinline__ void gemm_phase(LAS unsigned char* lds, const Sched& S, const Epi& E) {
    int tid = threadIdx.x; asm volatile("" : "+v"(tid));
    const int wid = __builtin_amdgcn_readfirstlane(tid >> 6), lane = tid & 63, wr = wid >> 2, wc = wid & 3, fr = lane & 15, fq = lane >> 4;
    constexpr int K = GK, nt = K / BK;
    unsigned voffA[2], voffB[2];
#pragma unroll
    for (int i = 0; i < 2; ++i) { int R, C; stage_rc(tid * 16 + i * 8192, R, C); const int Rb = (R & ~31) + perm32(R & 31);
        voffA[i] = (unsigned)(R * K + C) * 2u; voffB[i] = (unsigned)(Rb * K + C) * 2u; }
    constexpr size_t kstep = (size_t)(BK * 2);
    constexpr size_t hstep = (size_t)HALF * K * 2;
    const unsigned ldsw = (unsigned)wid * 1024u;
    const int aoff = lds_byte(wr * 64 + fr, fq * 8), boff = lds_byte(wc * 32 + fr, fq * 8);
#define PG8_SA(b, h) (((b) * 2 + (h)) * HTB)
#define PG8_SB(b, h) ((4 + (b) * 2 + (h)) * HTB)
#define PG8_STAGE(bufoff, gbase, voff) do { _Pragma("unroll") for (int _i = 0; _i < 2; ++_i) \
        __builtin_amdgcn_global_load_lds((const unsigned*)((const char*)(gbase) + (voff)[_i]), (LAS unsigned*)(lds + (bufoff) + ldsw + _i * 8192), 16, 0, 0); } while (0)
#define PG8_LDA(dst, b, h) do { _Pragma("unroll") for (int m = 0; m < 4; ++m) _Pragma("unroll") for (int k = 0; k < 2; ++k) dst[m][k] = *(const LAS bf16x8*)(lds + PG8_SA(b, h) + aoff + m * 2048 + k * 1024); } while (0)
#define PG8_LDB(dst, b, h) do { _Pragma("unroll") for (int n = 0; n < 2; ++n) _Pragma("unroll") for (int k = 0; k < 2; ++k) dst[n][k] = *(const LAS bf16x8*)(lds + PG8_SB(b, h) + boff + n * 2048 + k * 1024); } while (0)
#define PG8_MMA(ai, bj, At, Bt) do { __builtin_amdgcn_s_setprio(1); _Pragma("unroll") for (int m = 0; m < 4; ++m) _Pragma("unroll") for (int n = 0; n < 2; ++n) _Pragma("unroll") for (int k = 0; k < 2; ++k) \
        acc[ai][bj][m][n] = __builtin_amdgcn_mfma_f32_16x16x32_bf16(Bt[n][k], At[m][k], acc[ai][bj][m][n], 0, 0, 0); __builtin_amdgcn_s_setprio(0); } while (0)
#define PG8_WAIT_V(n) asm volatile("s_waitcnt vmcnt(" #n ")" ::: "memory")
#define PG8_WAIT_L(n) asm volatile("s_waitcnt lgkmcnt(" #n ")" ::: "memory")
#define PG8_BAR __builtin_amdgcn_s_barrier()
#define PG8_SCHED __builtin_amdgcn_sched_barrier(0)
    Unit cur, nxt; int ui = 0;
    if (!S.next(0, cur)) return;
    f32x4 acc[2][2][4][2];
#pragma unroll
    for (int a = 0; a < 2; ++a)
#pragma unroll
        for (int b = 0; b < 2; ++b)
#pragma unroll
            for (int m = 0; m < 4; ++m)
#pragma unroll
                for (int n = 0; n < 2; ++n) acc[a][b][m][n] = (f32x4){0.f, 0.f, 0.f, 0.f};
    bf16x8 At[4][2], B0[2][2], B1[2][2];
    const char* cA = S.pA(cur); const char* cB = S.pB(cur);
    PG8_STAGE(PG8_SB(0, 0), cB, voffB); PG8_STAGE(PG8_SB(0, 1), cB + hstep, voffB); PG8_STAGE(PG8_SA(0, 0), cA, voffA); PG8_STAGE(PG8_SA(0, 1), cA + hstep, voffA);
    if (wr == 1) PG8_BAR;
    PG8_WAIT_V(2); PG8_BAR;
    PG8_STAGE(PG8_SB(1, 0), cB + kstep, voffB); PG8_STAGE(PG8_SA(1, 0), cA + kstep, voffA); PG8_STAGE(PG8_SB(1, 1), cB + hstep + kstep, voffB);
    PG8_WAIT_V(6); PG8_BAR;
    for (;;) {
        const bool has_next = S.next(ui + 1, nxt);
        const char* nA = has_next ? S.pA(nxt) : cA; const char* nB = has_next ? S.pB(nxt) : cB;
        for (int t = 0; t < nt; t += 2) {
            const bool last = (t == nt - 2);
            const char* a1 = cA + (size_t)(t + 1) * kstep;
            const char* a2 = last ? nA : cA + (size_t)(t + 2) * kstep; const char* b2 = last ? nB : cB + (size_t)(t + 2) * kstep;
            const char* a3 = a2 + kstep; const char* b3 = b2 + kstep;
            PG8_LDB(B0, 0, 0); PG8_LDB(B1, 0, 1); PG8_SCHED; PG8_LDA(At, 0, 0); PG8_STAGE(PG8_SA(1, 1), a1 + hstep, voffA);
            PG8_WAIT_V(8); PG8_WAIT_L(0); PG8_BAR; PG8_MMA(0, 0, At, B0); PG8_MMA(0, 1, At, B1); PG8_BAR; PG8_SCHED;
            PG8_LDA(At, 0, 1); PG8_STAGE(PG8_SB(0, 0), b2, voffB); PG8_STAGE(PG8_SB(0, 1), b2 + hstep, voffB); PG8_STAGE(PG8_SA(0, 0), a2, voffA);
            PG8_WAIT_V(8); PG8_WAIT_L(0); PG8_BAR; PG8_MMA(1, 0, At, B0); PG8_MMA(1, 1, At, B1); PG8_BAR; PG8_SCHED;
            PG8_LDB(B0, 1, 0); PG8_LDB(B1, 1, 1); PG8_SCHED; PG8_LDA(At, 1, 0); PG8_STAGE(PG8_SA(0, 1), a2 + hstep, voffA);
            PG8_WAIT_V(8); PG8_WAIT_L(0); PG8_BAR; PG8_MMA(0, 0, At, B0); PG8_MMA(0, 1, At, B1); PG8_BAR; PG8_SCHED;
            PG8_LDA(At, 1, 1); PG8_STAGE(PG8_SB(1, 0), b3, voffB); PG8_STAGE(PG8_SB(1, 1), b3 + hstep, voffB); PG8_STAGE(PG8_SA(1, 0), a3, voffA);
            PG8_WAIT_V(8); PG8_WAIT_L(0); PG8_BAR; PG8_MMA(1, 0, At, B0); PG8_MMA(1, 1, At, B1); PG8_BAR; PG8_SCHED;
        }
        if (wr == 0) PG8_BAR;
        E(acc, cur, wr, wc, fr, fq);
        if (!has_next) break;
#pragma unroll
        for (int a = 0; a < 2; ++a)
#pragma unroll
            for (int b = 0; b < 2; ++b)
#pragma unroll
                for (int m = 0; m < 4; ++m)
#pragma unroll
                    for (int n = 0; n < 2; ++n) acc[a][b][m][n] = (f32x4){0.f, 0.f, 0.f, 0.f};
        cur = nxt; cA = nA; cB = nB; ++ui;
        if (wr == 1) PG8_BAR;
    }
    PG8_WAIT_V(0);
    PG8_BAR;
#undef PG8_SA
#undef PG8_SB
#undef PG8_STAGE
#undef PG8_LDA
#undef PG8_LDB
#undef PG8_MMA
}

constexpr int KROW = 144, VROW = 136;
constexpr int L_KB = 0, L_VB = 4 * 64 * KROW, L_FB = L_VB + 4 * 64 * VROW, L_RELB = L_FB + 1024, L_OST = L_RELB + 1280, L_UW = L_OST + 8 * 32 * KROW, L_ATT_END = L_UW + 8 * 128 * 4;
static_assert(L_ATT_END <= LDS_PHASE_BYTES, "lds");
constexpr float TH_DEFER = 8.0f;
constexpr float PRUNE_NAT = 40.0f;

template <int MODE>
__device__ __forceinline__ void attn_unit(const bf16_t* __restrict__ QKVZ, const bf16_t* __restrict__ VT, const float* __restrict__ aux,
                                          bf16_t* __restrict__ G, int b, int h, int qb, int jlo, const float* __restrict__ nrm) {
    unsigned char* lds = g_shm;
    int tid = threadIdx.x; asm volatile("" : "+v"(tid));
    const int w = tid >> 6, lane = tid & 63, q = lane & 31, hh = lane >> 5;
    const int r0 = qb * 256 + w * 32, t = r0 + q;
    const int jhi = qb * 4 + 3, cw = qb * 4 + (w >> 1);
    const int lrow = tid >> 3, lch = tid & 7;
    const bf16_t* kbase = QKVZ + ((long)(b * SEQ + lrow)) * 4096 + 1024 + h * 64 + lch * 8;
    const bf16_t* vbase = VT + ((long)((b * NH + h) * 64 + lrow)) * SEQ + lch * 8;
    const float* fbase = aux + (long)(b * NH + h) * SEQ;
    constexpr float SC = 0.125f * LOG2E;

    __syncthreads();
    bf16x8 qf[4];
    {
        const bf16_t* qp = QKVZ + ((long)(b * SEQ + t)) * 4096 + h * 64 + hh * 8;
#pragma unroll
        for (int ks = 0; ks < 4; ++ks) qf[ks] = *(const bf16x8*)(qp + ks * 16);
    }
    float Ft = 0.f;
    if (MODE == 1) Ft = fbase[t] * LOG2E;
    u32x4 k0r, v0r, k1r, v1r; float f0r = 0.f, f1r = 0.f;
    k0r = *(const u32x4*)(kbase + (long)jhi * 64 * 4096);       v0r = *(const u32x4*)(vbase + jhi * 64);
    k1r = *(const u32x4*)(kbase + (long)(jhi - 1) * 64 * 4096); v1r = *(const u32x4*)(vbase + (jhi - 1) * 64);
    if (MODE == 1) { if (tid < 64) { f0r = fbase[jhi * 64 + tid]; f1r = fbase[(jhi - 1) * 64 + tid]; } }
    u32x4 zpre[4];
#pragma unroll
    for (int i = 0; i < 4; ++i) zpre[i] = *(const u32x4*)(QKVZ + (long)(b * SEQ + r0 + (lane >> 3) + 8 * i) * 4096 + 3072 + h * 64 + (lane & 7) * 8);
    if (MODE == 1) {
        int* JL = (int*)(lds + L_RELB);
        const float* NQ = nrm + ((long)(b * 128)) * 32 + 2 * h;
        const float* NK = nrm + ((long)(1024 + b * 128)) * 32 + 2 * h;
        float Qa = 0.f, Qb = 0.f, Bd = 0.f;
#pragma unroll
        for (int i = 0; i < 4; ++i) { Qa = fmaxf(Qa, sqrtf(ld_coh(NQ + (4 * qb + i) * 32))); Qb = fmaxf(Qb, sqrtf(ld_coh(NQ + (4 * qb + i) * 32 + 1))); }
#pragma unroll
        for (int i = 0; i < 4; ++i) Bd = fmaxf(Bd, Qa * sqrtf(ld_coh(NK + (4 * qb + i) * 32)) + Qb * sqrtf(ld_coh(NK + (4 * qb + i) * 32 + 1)));
        if (tid == 0) *JL = 4 * qb;
        __syncthreads();
        if (tid < 4 * qb) {
            const float Bj = Qa * sqrtf(ld_coh(NK + tid * 32)) + Qb * sqrtf(ld_coh(NK + tid * 32 + 1));
            const float Dj = ld_coh(fbase + 256 * qb) - ld_coh(fbase + 64 * tid + 63);
            if (!((Bj + Bd) * 0.125f + Dj < -PRUNE_NAT)) atomicMin(JL, tid);
        }
        __syncthreads();
        jlo = *JL;
        float* UW = (float*)(lds + L_UW) + w * 128;
        const float qa = sqrtf(ld_coh(NQ + cw * 32)), qbb = sqrtf(ld_coh(NQ + cw * 32 + 1));
        const float Fr0 = ld_coh(fbase + r0);
        for (int jr = lane; jr < cw - jlo; jr += 64) {
            const int j = jlo + jr;
            const float ka = sqrtf(ld_coh(NK + j * 32)), kb = sqrtf(ld_coh(NK + j * 32 + 1));
            UW[jr] = (qa * ka + qbb * kb) * SC + (Fr0 - ld_coh(fbase + 64 * j + 63)) * LOG2E;
        }
    }
    if (MODE == 0) { if (tid < 288) { int rl = 192 - tid; rl = rl < -128 ? -128 : (rl > 128 ? 128 : rl); ((float*)(lds + L_RELB))[tid] = aux[h * 257 + rl + 128] * LOG2E; } }

    f32x16 O0, O1;
#pragma unroll
    for (int i = 0; i < 16; ++i) { O0[i] = 0.f; O1[i] = 0.f; }
    float m_run = 0.f, l_run = 0.f, m_min = -1e30f;
    bool first = true;

    auto LOADT = [&](u32x4& kr, u32x4& vr, float& fr_, int jj) __attribute__((always_inline)) {
        if (jj >= jlo) {
            kr = *(const u32x4*)(kbase + (long)jj * 64 * 4096);
            vr = *(const u32x4*)(vbase + jj * 64);
            if (MODE == 1) { if (tid < 64) fr_ = fbase[jj * 64 + tid]; }
        }
    };
    auto STAGE = [&](const u32x4& kreg, const u32x4& vreg, const float freg, int slot) __attribute__((always_inline)) {
        unsigned char* KBw = lds + L_KB + slot * 64 * KROW;
        unsigned char* VBw = lds + L_VB + slot * 64 * VROW;
        *(u32x4*)(KBw + lrow * KROW + lch * 16) = kreg;
        *(u32x2*)(VBw + lrow * VROW + lch * 16) = (u32x2){vreg.x, vreg.y};
        *(u32x2*)(VBw + lrow * VROW + lch * 16 + 8) = (u32x2){vreg.z, vreg.w};
        if (MODE == 1) { if (tid < 64) ((float*)(lds + L_FB + slot * 256))[tid] = freg * LOG2E; }
    };
    auto STEP = [&](int j, int slot) __attribute__((always_inline)) {
        unsigned char* KB = lds + L_KB + slot * 64 * KROW;
        unsigned char* VB = lds + L_VB + slot * 64 * VROW;
        float* FB = (float*)(lds + L_FB + slot * 256);
        bool active;
        if (MODE == 0) active = (j >= cw - 8 && j <= cw);
        else {
            active = (j <= cw);
            if (j < cw) { const float ub = ((const float*)(lds + L_UW))[w * 128 + (j - jlo)]; if (ub - m_min < -PRUNE_NAT * LOG2E) active = false; }
        }
        if (active) {
            f32x16 s0, s1;
#pragma unroll
            for (int i = 0; i < 16; ++i) { s0[i] = 0.f; s1[i] = 0.f; }
#pragma unroll
            for (int ks = 0; ks < 4; ++ks) {
                const bf16x8 k0 = *(const bf16x8*)(KB + q * KROW + (16 * ks + 8 * hh) * 2);
                const bf16x8 k1 = *(const bf16x8*)(KB + (32 + q) * KROW + (16 * ks + 8 * hh) * 2);
                s0 = __builtin_amdgcn_mfma_f32_32x32x16_bf16(k0, qf[ks], s0, 0, 0, 0);
                s1 = __builtin_amdgcn_mfma_f32_32x32x16_bf16(k1, qf[ks], s1, 0, 0, 0);
            }
            if (MODE == 0) {
                const float* RB = (const float*)(lds + L_RELB);
                if (r0 - (64 * j + 63) >= 128) {
                    const float cb = RB[64] - m_run;
#pragma unroll
                    for (int i = 0; i < 16; ++i) { s0[i] = s0[i] * SC + cb; s1[i] = s1[i] * SC + cb; }
                } else {
                    const float* Rp = RB + (192 - (t - 64 * j - 4 * hh));
#pragma unroll
                    for (int i = 0; i < 16; ++i) {
                        s0[i] = s0[i] * SC + (Rp[(i & 3) + 8 * (i >> 2)] - m_run);
                        s1[i] = s1[i] * SC + (Rp[(i & 3) + 8 * (i >> 2) + 32] - m_run);
                    }
                }
            } else {
                const bool diag = (j == cw);
                const float base = Ft - m_run;
#pragma unroll
                for (int g = 0; g < 4; ++g) {
                    const f32x4 f0 = *(const f32x4*)(FB + 8 * g + 4 * hh);
                    const f32x4 f1 = *(const f32x4*)(FB + 32 + 8 * g + 4 * hh);
#pragma unroll
                    for (int e = 0; e < 4; ++e) {
                        const int i = 4 * g + e;
                        float x0 = s0[i] * SC + (base - f0[e]);
                        float x1 = s1[i] * SC + (base - f1[e]);
                        if (diag) {
                            const int sp = 64 * j + 8 * g + 4 * hh + e;
                            if (sp > t) x0 = -1e30f;
                            if (sp + 32 > t) x1 = -1e30f;
                        }
                        s0[i] = x0; s1[i] = x1;
                    }
                }
            }
            float mx = s0[0];
#pragma unroll
            for (int i = 1; i < 16; ++i) mx = fmaxf(mx, s0[i]);
#pragma unroll
            for (int i = 0; i < 16; ++i) mx = fmaxf(mx, s1[i]);
            if (first || __any(mx > TH_DEFER)) {
                mx = fmaxf(mx, __shfl_xor(mx, 32));
                float d;
                if (first) { d = mx; }
                else {
                    d = fmaxf(mx, 0.f);
                    const float al = __builtin_amdgcn_exp2f(-d);
                    l_run *= al;
#pragma unroll
                    for (int i = 0; i < 16; ++i) { O0[i] *= al; O1[i] *= al; }
                }
                m_run += d;
#pragma unroll
                for (int i = 0; i < 16; ++i) { s0[i] -= d; s1[i] -= d; }
                first = false;
                if (MODE == 1) {
                    float mm = m_run;
#pragma unroll
                    for (int o = 32; o >= 1; o >>= 1) mm = fminf(mm, __shfl_xor(mm, o));
                    m_min = mm;
                }
            }
            float ps = 0.f;
#pragma unroll
            for (int i = 0; i < 16; ++i) { s0[i] = __builtin_amdgcn_exp2f(s0[i]); s1[i] = __builtin_amdgcn_exp2f(s1[i]); ps += s0[i] + s1[i]; }
            l_run += ps;
#pragma unroll
            for (int s = 0; s < 4; ++s) {
                u32x4 pw;
                if (s < 2) { pw.x = cvt_pk_bf16(s0[8 * s + 0], s0[8 * s + 1]); pw.y = cvt_pk_bf16(s0[8 * s + 2], s0[8 * s + 3]); pw.z = cvt_pk_bf16(s0[8 * s + 4], s0[8 * s + 5]); pw.w = cvt_pk_bf16(s0[8 * s + 6], s0[8 * s + 7]); }
                else { const int sp = s - 2; pw.x = cvt_pk_bf16(s1[8 * sp + 0], s1[8 * sp + 1]); pw.y = cvt_pk_bf16(s1[8 * sp + 2], s1[8 * sp + 3]); pw.z = cvt_pk_bf16(s1[8 * sp + 4], s1[8 * sp + 5]); pw.w = cvt_pk_bf16(s1[8 * sp + 6], s1[8 * sp + 7]); }
                const bf16x8 pf = __builtin_bit_cast(bf16x8, pw);
                {
                    const u32x2 lo = *(const u32x2*)(VB + q * VROW + (16 * s + 4 * hh) * 2);
                    const u32x2 hi = *(const u32x2*)(VB + q * VROW + (16 * s + 8 + 4 * hh) * 2);
                    const bf16x8 vf = __builtin_bit_cast(bf16x8, ((u32x4){lo.x, lo.y, hi.x, hi.y}));
                    O0 = __builtin_amdgcn_mfma_f32_32x32x16_bf16(vf, pf, O0, 0, 0, 0);
                }
                {
                    const u32x2 lo = *(const u32x2*)(VB + (32 + q) * VROW + (16 * s + 4 * hh) * 2);
                    const u32x2 hi = *(const u32x2*)(VB + (32 + q) * VROW + (16 * s + 8 + 4 * hh) * 2);
                    const bf16x8 vf = __builtin_bit_cast(bf16x8, ((u32x4){lo.x, lo.y, hi.x, hi.y}));
                    O1 = __builtin_amdgcn_mfma_f32_32x32x16_bf16(vf, pf, O1, 0, 0, 0);
                }
            }
        }
    };
    for (int j = jhi; j >= jlo; j -= 2) {
        const int base = (((jhi - j) >> 1) & 1) * 2;
        const bool two = (j - 1 >= jlo);
        STAGE(k0r, v0r, f0r, base);
        if (two) STAGE(k1r, v1r, f1r, base + 1);
        __syncthreads();
        LOADT(k0r, v0r, f0r, j - 2);
        LOADT(k1r, v1r, f1r, j - 3);
        STEP(j, base);
        if (two) STEP(j - 1, base + 1);
    }
    const float lt = l_run + __shfl_xor(l_run, 32);
    const float inv = 1.0f / lt;
    unsigned char* OST = lds + L_OST + w * 32 * KROW;
#pragma unroll
    for (int g = 0; g < 4; ++g) {
        u32x2 w0, w1;
        w0.x = cvt_pk_bf16(O0[4 * g + 0] * inv, O0[4 * g + 1] * inv); w0.y = cvt_pk_bf16(O0[4 * g + 2] * inv, O0[4 * g + 3] * inv);
        w1.x = cvt_pk_bf16(O1[4 * g + 0] * inv, O1[4 * g + 1] * inv); w1.y = cvt_pk_bf16(O1[4 * g + 2] * inv, O1[4 * g + 3] * inv);
        *(u32x2*)(OST + q * KROW + (8 * g + 4 * hh) * 2) = w0;
        *(u32x2*)(OST + q * KROW + (32 + 8 * g + 4 * hh) * 2) = w1;
    }
    __syncthreads();
#pragma unroll
    for (int i = 0; i < 4; ++i) {
        const int row = (lane >> 3) + 8 * i, ch = lane & 7;
        const u32x4 o8 = *(const u32x4*)(OST + row * KROW + ch * 16);
        const long tok = (long)(b * SEQ + r0 + row);
        const u32x4 z8 = zpre[i];
        u32x4 r8;
#pragma unroll
        for (int e = 0; e < 4; ++e) {
            const unsigned ou = o8[e], zu = z8[e];
            const float z0 = bf_lo(zu), z1 = bf_hi(zu);
            const float g0 = bf_lo(ou) * z0 / (1.0f + __expf(-z0));
            const float g1 = bf_hi(ou) * z1 / (1.0f + __expf(-z1));
            r8[e] = cvt_pk_bf16(g0, g1);
        }
        *(u32x4*)(G + tok * 1024 + h * 64 + ch * 8) = r8;
    }
}

__device__ __forceinline__ void transpose_w(const float* __restrict__ src, int N, bf16_t* __restrict__ dst, int tile) {
    float* T = (float*)g_shm;
    int tid = threadIdx.x; asm volatile("" : "+v"(tid));
    const int ntn = N / 64, kt = tile / ntn, ntl = tile % ntn, k0 = kt * 64, n0 = ntl * 64;
    __syncthreads();
#pragma unroll
    for (int e = 0; e < 8; ++e) { const int idx = tid + 512 * e, kk = idx >> 6, nn = idx & 63; T[kk * 65 + nn] = src[(long)(k0 + kk) * N + n0 + nn]; }
    __syncthreads();
#pragma unroll
    for (int e = 0; e < 4; ++e) { const int idx = tid + 512 * e, nn = idx >> 5, kp = idx & 31;
        *(unsigned*)(dst + (long)(n0 + nn) * 1024 + k0 + 2 * kp) = cvt_pk_bf16(T[(2 * kp) * 65 + nn], T[(2 * kp + 1) * 65 + nn]); }
}

__device__ __forceinline__ float log_sigmoid(float z) { return fminf(z, 0.f) - log1pf(expf(-fabsf(z))); }

__device__ __forceinline__ void ln_phase(float* __restrict__ io, bf16_t* __restrict__ XB, const float* __restrict__ g, const float* __restrict__ bta,
                                         const float* __restrict__ wf, const float* __restrict__ bf, float* __restrict__ LOGF,
                                         float* __restrict__ stats, const bool write_x) {
    int tid = threadIdx.x; asm volatile("" : "+v"(tid));
    const int w = tid >> 6, lane = tid & 63;
    f32x4* WF = (f32x4*)g_shm;
    if (wf) {
        __syncthreads();
        for (int idx = tid; idx < 4096; idx += 512) {
            const int ln = idx & 63, hq = (idx >> 6) & 3, ie = idx >> 8, k = 4 * (ln + 64 * (ie >> 2)) + (ie & 3);
            WF[idx] = *(const f32x4*)(wf + k * 16 + 4 * hq);
        }
        __syncthreads();
    }
    f32x4 gv[4], bv[4];
#pragma unroll
    for (int i = 0; i < 4; ++i) { gv[i] = *(const f32x4*)(g + 4 * (lane + 64 * i)); bv[i] = *(const f32x4*)(bta + 4 * (lane + 64 * i)); }
    const int G_ = gridDim.x, c_ = blockIdx.x;
    const int nri = (c_ < 256) ? ((256 - c_ + G_ - 1) / G_) * 32 : 0;
    auto row_of = [&](int ri) __attribute__((always_inline)) { return (c_ + (ri >> 5) * G_) * 256 + w + 8 * (ri & 31); };
    f32x4 nv[4];
    if (nri > 0) {
        const int row = row_of(0);
#pragma unroll
        for (int i = 0; i < 4; ++i) nv[i] = *(const f32x4*)(io + (long)row * 1024 + 4 * (lane + 64 * i));
    }
    for (int ri = 0; ri < nri; ++ri) {
        const int row = row_of(ri);
        float* rp = io + (long)row * 1024;
        f32x4 v[4];
#pragma unroll
        for (int i = 0; i < 4; ++i) v[i] = nv[i];
        if (ri + 1 < nri) {
            const int nrow = row_of(ri + 1);
#pragma unroll
            for (int i = 0; i < 4; ++i) nv[i] = *(const f32x4*)(io + (long)nrow * 1024 + 4 * (lane + 64 * i));
        }
        float s = 0.f;
#pragma unroll
        for (int i = 0; i < 4; ++i) s += (v[i][0] + v[i][1]) + (v[i][2] + v[i][3]);
#pragma unroll
        for (int o = 32; o >= 1; o >>= 1) s += __shfl_xor(s, o);
        const float mu = s * (1.0f / 1024.0f);
        float qs = 0.f;
#pragma unroll
        for (int i = 0; i < 4; ++i) { v[i] = v[i] - mu; qs += (v[i][0] * v[i][0] + v[i][1] * v[i][1]) + (v[i][2] * v[i][2] + v[i][3] * v[i][3]); }
#pragma unroll
        for (int o = 32; o >= 1; o >>= 1) qs += __shfl_xor(qs, o);
        const float rstd = 1.0f / sqrtf(qs * (1.0f / 1024.0f) + LN_EPS);
        if (!write_x && lane == 0) { stats[2 * row] = mu; stats[2 * row + 1] = rstd; }
#pragma unroll
        for (int i = 0; i < 4; ++i) {
            v[i] = v[i] * rstd * gv[i] + bv[i];
            if (write_x) *(f32x4*)(rp + 4 * (lane + 64 * i)) = v[i];
            if (XB) { u32x2 pk; pk.x = cvt_pk_bf16(v[i][0], v[i][1]); pk.y = cvt_pk_bf16(v[i][2], v[i][3]);
                *(u32x2*)(XB + (long)row * 1024 + 4 * (lane + 64 * i)) = pk; }
        }
        if (wf) {
            float a[16];
#pragma unroll
            for (int c = 0; c < 16; ++c) a[c] = 0.f;
#pragma unroll
            for (int i = 0; i < 4; ++i)
#pragma unroll
                for (int e = 0; e < 4; ++e) {
                    const float xv = v[i][e];
#pragma unroll
                    for (int hq = 0; hq < 4; ++hq) {
                        const f32x4 w4 = WF[((i * 4 + e) * 4 + hq) * 64 + lane];
                        a[4 * hq + 0] += xv * w4[0]; a[4 * hq + 1] += xv * w4[1]; a[4 * hq + 2] += xv * w4[2]; a[4 * hq + 3] += xv * w4[3];
                    }
                }
#pragma unroll
            for (int i = 0; i < 8; ++i) { const bool up = (lane & 32) != 0; const float send = up ? a[i] : a[i + 8], keep = up ? a[i + 8] : a[i]; a[i] = keep + __shfl_xor(send, 32); }
#pragma unroll
            for (int i = 0; i < 4; ++i) { const bool up = (lane & 16) != 0; const float send = up ? a[i] : a[i + 4], keep = up ? a[i + 4] : a[i]; a[i] = keep + __shfl_xor(send, 16); }
#pragma unroll
            for (int i = 0; i < 2; ++i) { const bool up = (lane & 8) != 0; const float send = up ? a[i] : a[i + 2], keep = up ? a[i + 2] : a[i]; a[i] = keep + __shfl_xor(send, 8); }
            { const bool up = (lane & 4) != 0; const float send = up ? a[0] : a[1], keep = up ? a[1] : a[0]; a[0] = keep + __shfl_xor(send, 4); }
            a[0] += __shfl_xor(a[0], 2); a[0] += __shfl_xor(a[0], 1);
            if ((lane & 3) == 0) {
                const int hd = ((lane >> 5) & 1) * 8 + ((lane >> 4) & 1) * 4 + ((lane >> 3) & 1) * 2 + ((lane >> 2) & 1);
                const int bb = row / SEQ, ss = row % SEQ;
                LOGF[((long)(bb * NH + hd)) * SEQ + ss] = log_sigmoid(a[0] + bf[hd]);
            }
        }
    }
}

__device__ __forceinline__ void scan_phase(float* __restrict__ F) {
    float* red = (float*)g_shm;
    int tid = threadIdx.x; asm volatile("" : "+v"(tid));
    const int w = tid >> 6, lane = tid & 63;
    for (int bh = blockIdx.x; bh < NB * NH; bh += gridDim.x) {
        float* p = F + (long)bh * SEQ + tid * 16;
        f32x4 v[4];
#pragma unroll
        for (int i = 0; i < 4; ++i) v[i] = *(const f32x4*)(p + 4 * i);
        float run = 0.f;
#pragma unroll
        for (int i = 0; i < 4; ++i)
#pragma unroll
            for (int e = 0; e < 4; ++e) { run += v[i][e]; v[i][e] = run; }
        float inc = run;
#pragma unroll
        for (int o = 1; o < 64; o <<= 1) { const float y = __shfl_up(inc, o); if (lane >= o) inc += y; }
        __syncthreads();
        if (lane == 63) red[w] = inc;
        __syncthreads();
        float base = inc - run;
        for (int ww = 0; ww < w; ++ww) base += red[ww];
#pragma unroll
        for (int i = 0; i < 4; ++i) { v[i] = v[i] + base; *(f32x4*)(p + 4 * i) = v[i]; }
    }
}

#define XB_TMO      128
#define XB_XCNT(j)  (256  + 64 * (j))
#define XB_XSUB(j)  (1280 + 64 * (j))
#define XB_XGEN(j)  (2304 + 64 * (j))
#define XB_TOP      3328
#define XB_TOPGEN   3392
#define XCD_BAR_WORDS 3456
#define XB_SPIN_CAP (1u << 18)
__device__ __forceinline__ unsigned xb_ld(unsigned* p)              { return __hip_atomic_load(p, __ATOMIC_RELAXED, __HIP_MEMORY_SCOPE_AGENT); }
__device__ __forceinline__ unsigned xb_add(unsigned* p, unsigned v) { return __hip_atomic_fetch_add(p, v, __ATOMIC_RELAXED, __HIP_MEMORY_SCOPE_AGENT); }
__device__ __forceinline__ unsigned xb_xcc_id() { return (unsigned)__builtin_amdgcn_s_getreg((3 << 11) | 20) & 0xFu; }
#define XB_SPIN(cond, bar) do { unsigned _sp = 0; while (cond) { __builtin_amdgcn_s_sleep(1); \
    if ((++_sp & 255u) == 0u) { if (xb_ld(&(bar)[XB_TMO])) break; if (_sp > XB_SPIN_CAP) { atomicAdd(&(bar)[XB_TMO], 1u); break; } } } } while (0)
struct XcdBarrier { unsigned* bar; unsigned x; volatile LAS unsigned* st; };
__device__ __forceinline__ XcdBarrier xcd_barrier_post(unsigned* bar, volatile LAS unsigned* st) {
    XcdBarrier b; b.bar = bar; b.x = xb_xcc_id(); b.st = st;
    if (threadIdx.x == 0) (void)xb_add(&bar[XB_XCNT(b.x)], 1u);
    return b;
}
__device__ __forceinline__ void xcd_barrier_complete(unsigned* bar, unsigned x, unsigned& nloc, unsigned& nx) {
    const unsigned G = gridDim.x * gridDim.y * gridDim.z;
    unsigned sum, cnt, mine, sp = 0u;
    for (;;) {
        sum = 0u; cnt = 0u; mine = 0u;
#pragma unroll
        for (unsigned j = 0; j < 16; ++j) { const unsigned c = xb_ld(&bar[XB_XCNT(j)]); sum += c; cnt += (c > 0u) ? 1u : 0u; mine = (j == x) ? c : mine; }
        if (sum == G) break;
        __builtin_amdgcn_s_sleep(1);
        if ((++sp & 255u) == 0u) { if (xb_ld(&bar[XB_TMO])) break; if (sp > XB_SPIN_CAP) { atomicAdd(&bar[XB_TMO], 1u); break; } }
    }
    nloc = mine > 0u ? mine : 1u; nx = cnt > 0u ? cnt : 1u;
}
__device__ __forceinline__ void xcd_barrier(const XcdBarrier& b) {
    asm volatile("s_waitcnt vmcnt(0)" ::: "memory");
    __syncthreads();
    if (threadIdx.x == 0) {
        unsigned* bar = b.bar;
        __builtin_amdgcn_s_waitcnt(0);
        unsigned nloc = b.st[0], nx = b.st[1];
        if (nloc == 0u) { xcd_barrier_complete(bar, b.x, nloc, nx); b.st[0] = nloc; b.st[1] = nx; }
        const unsigned old = xb_add(&bar[XB_XSUB(b.x)], 1u);
        const unsigned gen = old / nloc;
        if (old + 1u == (gen + 1u) * nloc) {
            __builtin_amdgcn_fence(__ATOMIC_RELEASE, "agent");
            asm volatile("s_waitcnt vmcnt(0)" ::: "memory");
            const unsigned og = xb_add(&bar[XB_TOP], 1u);
            const unsigned tg = og / nx;
            if (og + 1u == (tg + 1u) * nx) xb_add(&bar[XB_TOPGEN], 1u);
            else XB_SPIN(xb_ld(&bar[XB_TOPGEN]) == tg, bar);
            __builtin_amdgcn_fence(__ATOMIC_ACQUIRE, "agent");
            xb_add(&bar[XB_XGEN(b.x)], 1u);
            asm volatile("s_waitcnt vmcnt(0)" ::: "memory");
        } else {
            XB_SPIN(xb_ld(&bar[XB_XGEN(b.x)]) == gen, bar);
            __builtin_amdgcn_fence(__ATOMIC_ACQUIRE, "agent");
            asm volatile("s_waitcnt vmcnt(0)" ::: "memory");
        }
    }
    __syncthreads();
}

__device__ __forceinline__ void grid_bar(unsigned* ctr, unsigned target) {
    __syncthreads();
    if (threadIdx.x == 0) {
        __builtin_amdgcn_fence(__ATOMIC_RELEASE, "agent");
        __hip_atomic_fetch_add(ctr, 1u, __ATOMIC_RELAXED, __HIP_MEMORY_SCOPE_AGENT);
        while (__hip_atomic_load(ctr, __ATOMIC_RELAXED, __HIP_MEMORY_SCOPE_AGENT) < target) __builtin_amdgcn_s_sleep(4);
        __builtin_amdgcn_fence(__ATOMIC_ACQUIRE, "agent");
    }
    __syncthreads();
}

__global__ void __launch_bounds__(512, 2) fwd_megakernel(Params p) {
    cg::grid_group grid = cg::this_grid();
    bf16_t* XB = (bf16_t*)(p.ws + WS_XB);
    bf16_t* QKVZ = (bf16_t*)(p.ws + WS_QKVZ);
    bf16_t* VT = (bf16_t*)(p.ws + WS_VT);
    bf16_t* G = (bf16_t*)(p.ws + WS_G);
    bf16_t* WIN = (bf16_t*)(p.ws + WS_WIN);
    bf16_t* WOUT = (bf16_t*)(p.ws + WS_WOUT);
    float* F = (float*)(p.ws + WS_F);
    float* NRM = (float*)(p.ws + WS_NRM);
    unsigned* CTR = (unsigned*)(p.ws + WS_CTR);
    float* STATS = (float*)(p.ws + WS_STATS);
    unsigned bar_gen = 0;
#define GRID_BAR() xcd_barrier(xbar)
    const int tid = threadIdx.x;
    LAS unsigned char* lds = (LAS unsigned char*)g_shm;

    unsigned* XBAR = (unsigned*)(p.ws + WS_XBAR);
    volatile LAS unsigned* xb_st = (volatile LAS unsigned*)((LAS unsigned char*)g_shm + LDS_PHASE_BYTES);
    if (tid == 0) { xb_st[0] = 0u; xb_st[1] = 0u; }
    if (blockIdx.x == 0) { for (int u = tid; u < XCD_BAR_WORDS; u += 512) __hip_atomic_store(XBAR + u, 0u, __ATOMIC_RELAXED, __HIP_MEMORY_SCOPE_AGENT); }
    __syncthreads();
    {
        const long nvec = (long)MTOK * 1024 / 8;
#pragma unroll 4
        for (long i = (long)blockIdx.x * 512 + tid; i < nvec; i += (long)gridDim.x * 512) {
            const f32x4 a = *(const f32x4*)(p.x + i * 8), c = *(const f32x4*)(p.x + i * 8 + 4);
            u32x4 o; o.x = cvt_pk_bf16(a[0], a[1]); o.y = cvt_pk_bf16(a[2], a[3]); o.z = cvt_pk_bf16(c[0], c[1]); o.w = cvt_pk_bf16(c[2], c[3]);
            *(u32x4*)(XB + i * 8) = o;
        }
        for (int u = blockIdx.x; u < DEPTH * 1280; u += gridDim.x) {
            const int l = u / 1280, tl = u % 1280;
            if (tl < 1024) {
                const float* src = ((l & 1) ? p.w_in_b : p.w_in_a) + (long)(l >> 1) * 1024 * 4096;
                transpose_w(src, 4096, WIN + (long)l * 4096 * 1024, tl);
            } else {
                const float* src = ((l & 1) ? p.w_out_b : p.w_out_a) + (long)(l >> 1) * 1024 * 1024;
                transpose_w(src, 1024, WOUT + (long)l * 1024 * 1024, tl - 1024);
            }
        }
    }
    grid.sync();
    const XcdBarrier xbar = xcd_barrier_post(XBAR, xb_st);

#pragma unroll 1
    for (int layer = 0; layer < DEPTH; ++layer) {
        const bool isB = (layer & 1) != 0;
        const bf16_t* Wi = WIN + (long)layer * 4096 * 1024;
        const bf16_t* Wo = WOUT + (long)layer * 1024 * 1024;
        if (isB) scan_phase(F);
        {
            Sched S; S.mode = 0; S.XB = (const char*)XB; S.W = (const char*)Wi; S.G = gridDim.x; S.c = blockIdx.x;
            Epi E; E.mode = 0; E.QKVZ = QKVZ; E.VT = VT; E.xin = nullptr; E.of = nullptr; E.nrm = isB ? NRM : nullptr; E.stats = nullptr; E.gp = nullptr; E.bp = nullptr;
            __syncthreads();
            gemm_phase(lds, S, E);
        }
        GRID_BAR();
        for (int u = blockIdx.x; u < 4096; u += gridDim.x) {
            const int c = u & 255, i = u >> 8;
            int qb = c >> 3;
            if (isB && (i & 1)) qb = 31 - qb;
            const int b = c & 7, h = i;
            if (!isB) attn_unit<0>(QKVZ, VT, p.rel_bias_a + (long)(layer >> 1) * NH * 257, G, b, h, qb, (qb * 4 - 8) > 0 ? (qb * 4 - 8) : 0, nullptr);
            else attn_unit<1>(QKVZ, VT, F, G, b, h, qb, 0, NRM);
        }
        GRID_BAR();
        {
            Sched S; S.mode = 1; S.XB = (const char*)G; S.W = (const char*)Wo; S.G = gridDim.x; S.c = blockIdx.x;
            Epi E; E.mode = 1; E.QKVZ = nullptr; E.VT = nullptr; E.xin = (layer == 0) ? p.x : p.out; E.of = p.out; E.nrm = nullptr;
            E.stats = (layer == 0) ? nullptr : STATS; E.gp = p.ln_g + (layer > 0 ? layer - 1 : 0) * 1024; E.bp = p.ln_b + (layer > 0 ? layer - 1 : 0) * 1024;
            __syncthreads();
            gemm_phase(lds, S, E);
        }
        __syncthreads();
        {
            const bool nextB = (layer + 1 < DEPTH) && ((layer + 1) & 1);
            const int jn = (layer + 1) >> 1;
            ln_phase(p.out, (layer + 1 < DEPTH) ? XB : nullptr, p.ln_g + layer * 1024, p.ln_b + layer * 1024,
                     nextB ? p.w_f_b + (long)jn * 1024 * 16 : nullptr, nextB ? p.b_f_b + jn * 16 : nullptr, F, STATS, layer + 1 == DEPTH);
        }
        if (layer + 1 < DEPTH) GRID_BAR();
    }
}

extern "C" void kernel_launch(void* const* d_in, const int* in_sizes, int n_in, void* d_out, int out_size, void* d_ws, size_t ws_size, hipStream_t stream) {
    static int grid_blocks = 0;
    if (grid_blocks == 0) {
        if (ws_size < WS_END) { fprintf(stderr, "kernel_launch: workspace too small (%zu < %zu)\n", ws_size, (size_t)WS_END); grid_blocks = -1; return; }
        int dev = 0, cus = 0, per_cu = 0;
        hipGetDevice(&dev);
        hipDeviceGetAttribute(&cus, hipDeviceAttributeMultiprocessorCount, dev);
        hipFuncSetAttribute((const void*)fwd_megakernel, hipFuncAttributeMaxDynamicSharedMemorySize, LDS_BYTES);
        hipOccupancyMaxActiveBlocksPerMultiprocessor(&per_cu, (const void*)fwd_megakernel, 512, LDS_BYTES);
        if (per_cu < 1) { fprintf(stderr, "kernel_launch: occupancy query says %d blocks per CU\n", per_cu); per_cu = 1; }
        grid_blocks = cus * 1;
        (void)hipGetLastError();
    }
    if (grid_blocks < 0) return;
    Params p{};
    p.x = (const float*)d_in[0]; p.w_in_a = (const float*)d_in[1]; p.rel_bias_a = (const float*)d_in[2]; p.w_out_a = (const float*)d_in[3];
    p.w_in_b = (const float*)d_in[4]; p.w_f_b = (const float*)d_in[5]; p.b_f_b = (const float*)d_in[6]; p.w_out_b = (const float*)d_in[7];
    p.ln_g = (const float*)d_in[8]; p.ln_b = (const float*)d_in[9];
    p.out = (float*)d_out; p.ws = (unsigned char*)d_ws;
    void* args[] = {&p};
    hipError_t e = hipLaunchCooperativeKernel((const void*)fwd_megakernel, dim3(grid_blocks), dim3(512), args, LDS_BYTES, stream);
    if (e != hipSuccess) fprintf(stderr, "cooperative launch failed: %s (grid %d)\n", hipGetErrorString(e), grid_blocks);
}
```
